# Optimizing an MI355X kernel written in HIP

```python
import math
import jax
import jax.numpy as jnp
from jax import lax
import numpy as np

D_MODEL = 2048
BATCH = 1
SEQ = 8192
DEPTH = 2

N_EVEN = (DEPTH + 1) // 2
N_ODD = DEPTH // 2

NSA_HEADS = 8
NSA_KV_HEADS = 2
NSA_HPG = NSA_HEADS // NSA_KV_HEADS
HEAD_DIM = 128
NSA_KV_W = NSA_KV_HEADS * HEAD_DIM
CMP_LEN = 32
CMP_STRIDE = 16
SLC_LEN = 64
SLC_TOPN = 16
WINDOW = 512
Q_BLOCK = 128

LRU_WIDTH = 1024
LRU_BLOCKS = 8
LRU_BW = LRU_WIDTH // LRU_BLOCKS
CONV_W = 4
LRU_C = 8.0

EVEN_COLS = NSA_HEADS * HEAD_DIM + 6 * NSA_KV_W + 3 * NSA_HEADS + 2 * LRU_WIDTH
EVEN_MIX_OUT = NSA_HEADS * HEAD_DIM + LRU_WIDTH

HG_HEADS = 16
HG_DK = 128
HG_DV = 128
HG_CHUNK = 64
HG_KW = HG_HEADS * HG_DK
HG_VW = HG_HEADS * HG_DV
ODD_COLS = 2 * HG_KW + 2 * HG_VW

N_BUCKETS = 32
MAX_DIST = 128

N_GROUPS = 8
EXP_PER_GROUP = 8
N_EXPERTS = N_GROUPS * EXP_PER_GROUP
TOPK_IN_GROUP = 2
D_EXPERT = 512
MOE_BLOCK = 128

EPS = 1e-6

kernel_name = 'hybrid_nsa_rglru_hgrn2_hmoe'


def rmsnorm(x, g):
    x32 = x.astype(jnp.float32)
    y = x32 * lax.rsqrt(jnp.mean(x32 * x32, axis=-1, keepdims=True) + EPS)
    return (y * g.astype(jnp.float32)).astype(x.dtype)


def t5_bucket(rel):
    n = jnp.maximum(rel, 0)
    max_exact = N_BUCKETS // 2
    nf = jnp.maximum(n, 1).astype(jnp.float32)
    large = max_exact + (jnp.log(nf / max_exact) / math.log(MAX_DIST / max_exact)
                         * (N_BUCKETS - max_exact)).astype(jnp.int32)
    large = jnp.minimum(large, N_BUCKETS - 1)
    return jnp.where(n < max_exact, n, large)


def masked_softmax(s, mask):
    s = jnp.where(mask, s.astype(jnp.float32), -jnp.inf)
    m = jnp.max(s, axis=-1, keepdims=True)
    m = jnp.where(jnp.isfinite(m), m, 0.0)
    e = jnp.exp(s - m)
    d = jnp.sum(e, axis=-1, keepdims=True)
    return e / jnp.where(d > 0, d, 1.0)


def compress_blocks(k, pe, w1, b1, w2, b2):
    B, G, T, hd = k.shape
    n_cmp = (T - CMP_LEN) // CMP_STRIDE + 1
    idx = jnp.arange(n_cmp)[:, None] * CMP_STRIDE + jnp.arange(CMP_LEN)[None, :]
    blocks = (k[:, :, idx] + pe).reshape(B, G, n_cmp, CMP_LEN * hd)
    hid = jax.nn.gelu(blocks @ w1 + b1)
    return hid @ w2 + b2


def nsa_rglru_mixer(h, rel_bias, w_in, w_out, cmp_pe, cmp_w1, cmp_b1, cmp_w2, cmp_b2,
                    conv_w, conv_b, lru_wa, lru_ba, lru_wi, lru_bi, lru_lambda):
    B, T, _ = h.shape
    G, HPG, HD = NSA_KV_HEADS, NSA_HPG, HEAD_DIM
    sizes = (NSA_HEADS * HD,) + (NSA_KV_W,) * 6 + (3 * NSA_HEADS, LRU_WIDTH, LRU_WIDTH)
    cuts = []
    acc = 0
    for s in sizes[:-1]:
        acc += s
        cuts.append(acc)
    q, k_c, v_c, k_s, v_s, k_w, v_w, gate_logit, y_br, x_br = jnp.split(h @ w_in, cuts, axis=-1)

    q = q.reshape(B, T, G, HPG, HD).transpose(0, 2, 3, 1, 4) * (HD ** -0.5)

    def kv_heads(t):
        return t.reshape(B, T, G, HD).transpose(0, 2, 1, 3)

    k_c, v_c, k_s, v_s, k_w, v_w = [kv_heads(t) for t in (k_c, v_c, k_s, v_s, k_w, v_w)]
    gates = jax.nn.sigmoid(gate_logit.reshape(B, T, G, HPG, 3).transpose(0, 2, 3, 1, 4))

    k_cmp = compress_blocks(k_c, cmp_pe[0], cmp_w1[0], cmp_b1[0], cmp_w2[0], cmp_b2[0])
    v_cmp = compress_blocks(v_c, cmp_pe[1], cmp_w1[1], cmp_b1[1], cmp_w2[1], cmp_b2[1])
    n_cmp = k_cmp.shape[2]
    n_slc = T // SLC_LEN
    n_top = min(SLC_TOPN, n_slc)
    ks_blk = k_s.reshape(B, G, n_slc, SLC_LEN, HD)
    vs_blk = v_s.reshape(B, G, n_slc, SLC_LEN, HD)
    pad = ((0, 0), (0, 0), (WINDOW, 0), (0, 0))
    kw_pad = jnp.pad(k_w, pad)
    vw_pad = jnp.pad(v_w, pad)

    cmp_start = jnp.arange(n_cmp) * CMP_STRIDE
    cmp_end = cmp_start + CMP_LEN - 1
    slc_start = jnp.arange(n_slc) * SLC_LEN
    cover = ((cmp_start[:, None] < slc_start[None, :] + SLC_LEN)
             & (cmp_start[:, None] + CMP_LEN > slc_start[None, :])).astype(jnp.float32)

    tbl = rel_bias.reshape(N_BUCKETS, G, HPG)
    tbl_g = tbl.transpose(1, 0, 2)
    g_idx = jnp.arange(G)[None, :, None, None]

    def static_bias(rel):
        return tbl[t5_bucket(rel)].transpose(2, 3, 0, 1)

    gather = jax.vmap(jax.vmap(lambda blocks, ix: blocks[ix]))

    def chunk(ci):
        s0 = ci * Q_BLOCK
        qc = lax.dynamic_slice_in_dim(q, s0, Q_BLOCK, axis=3)
        gc = lax.dynamic_slice_in_dim(gates, s0, Q_BLOCK, axis=3)
        t = s0 + jnp.arange(Q_BLOCK)
        rel_c = t[:, None] - cmp_end[None, :]
        sc = jnp.einsum('bghqd,bgnd->bghqn', qc, k_cmp) + static_bias(rel_c)
        p_cmp = masked_softmax(sc, rel_c >= 0)
        o_cmp = jnp.einsum('bghqn,bgnd->bghqd', p_cmp.astype(v_cmp.dtype), v_cmp)
        imp = jnp.einsum('bghqn,nj->bgqj', p_cmp, cover)
        cur = (t // SLC_LEN)[:, None]
        blk = jnp.arange(n_slc)[None, :]
        imp = jnp.where(blk == cur, jnp.inf, jnp.where(blk > cur, -jnp.inf, imp))
        _, sel = lax.top_k(imp, n_top)
        k_sel = gather(ks_blk, sel).reshape(B, G, Q_BLOCK, n_top * SLC_LEN, HD)
        v_sel = gather(vs_blk, sel).reshape(B, G, Q_BLOCK, n_top * SLC_LEN, HD)
        kpos = (sel[..., None] * SLC_LEN + jnp.arange(SLC_LEN)).reshape(B, G, Q_BLOCK, n_top * SLC_LEN)
        rel_s = t[None, None, :, None] - kpos
        bias_s = tbl_g[g_idx, t5_bucket(rel_s)].transpose(0, 1, 4, 2, 3)
        ss = jnp.einsum('bghqd,bgqkd->bghqk', qc, k_sel) + bias_s
        p_s = masked_softmax(ss, (rel_s >= 0)[:, :, None])
        o_slc = jnp.einsum('bghqk,bgqkd->bghqd', p_s.astype(v_sel.dtype), v_sel)
        kwc = lax.dynamic_slice_in_dim(kw_pad, s0, Q_BLOCK + WINDOW, axis=2)
        vwc = lax.dynamic_slice_in_dim(vw_pad, s0, Q_BLOCK + WINDOW, axis=2)
        kpos_w = s0 - WINDOW + jnp.arange(Q_BLOCK + WINDOW)
        rel_w = t[:, None] - kpos_w[None, :]
        mask_w = (rel_w >= 0) & (rel_w < WINDOW) & (kpos_w >= 0)[None, :]
        sw = jnp.einsum('bghqd,bgkd->bghqk', qc, kwc) + static_bias(rel_w)
        p_w = masked_softmax(sw, mask_w)
        o_win = jnp.einsum('bghqk,bgkd->bghqd', p_w.astype(vwc.dtype), vwc)
        return gc[..., 0:1] * o_cmp + gc[..., 1:2] * o_slc + gc[..., 2:3] * o_win

    o = lax.map(chunk, jnp.arange(T // Q_BLOCK))
    nsa_out = o.transpose(1, 0, 4, 2, 3, 5).reshape(B, T, NSA_HEADS * HD).astype(h.dtype)

    xc = lax.conv_general_dilated(x_br, conv_w[:, None, :], window_strides=(1,),
                                  padding=[(CONV_W - 1, 0)],
                                  dimension_numbers=('NWC', 'WIO', 'NWC'),
                                  feature_group_count=LRU_WIDTH) + conv_b
    xg = xc.reshape(B, T, LRU_BLOCKS, LRU_BW)
    r_gate = jax.nn.sigmoid((jnp.einsum('btnd,nde->btne', xg, lru_wa).reshape(B, T, LRU_WIDTH)
                             + lru_ba).astype(jnp.float32))
    i_gate = jax.nn.sigmoid((jnp.einsum('btnd,nde->btne', xg, lru_wi).reshape(B, T, LRU_WIDTH)
                             + lru_bi).astype(jnp.float32))
    log_a = -LRU_C * r_gate * jax.nn.softplus(-lru_lambda.astype(jnp.float32))
    a = jnp.exp(log_a)
    b = jnp.sqrt(-jnp.expm1(2.0 * log_a)) * (i_gate * xc.astype(jnp.float32))

    def combine(left, right):
        a1, b1 = left
        a2, b2 = right
        return a1 * a2, a2 * b1 + b2

    _, hseq = lax.associative_scan(combine, (a, b), axis=1)
    lru_out = (jax.nn.gelu(y_br.astype(jnp.float32)) * hseq).astype(h.dtype)

    return jnp.concatenate([nsa_out, lru_out], axis=-1) @ w_out


def hgrn2_chunked(q, k, v, log_f):
    B, T, H, DK = q.shape
    DV = v.shape[-1]
    C = HG_CHUNK
    nc = T // C

    def chunks(t):
        return t.reshape(B, nc, C, H, t.shape[-1]).transpose(1, 0, 3, 2, 4)

    causal = jnp.tril(jnp.ones((C, C), dtype=bool))[:, :, None]

    def step(S, inp):
        qc, kc, vc, gc = inp
        bcum = jnp.cumsum(gc, axis=2)
        o_inter = jnp.einsum('bhtd,bhde->bhte', qc * jnp.exp(bcum), S)
        diff = jnp.where(causal, bcum[:, :, :, None, :] - bcum[:, :, None, :, :], -jnp.inf)
        att = jnp.einsum('bhtd,bhsd,bhtsd->bhts', qc, kc, jnp.exp(diff))
        o_intra = jnp.einsum('bhts,bhse->bhte', att, vc)
        b_last = bcum[:, :, -1:, :]
        S = (jnp.exp(b_last[:, :, 0, :])[..., None] * S
             + jnp.einsum('bhsd,bhse->bhde', kc * jnp.exp(b_last - bcum), vc))
        return S, o_inter + o_intra

    S0 = jnp.zeros((B, H, DK, DV), jnp.float32)
    _, o = lax.scan(step, S0, (chunks(q), chunks(k), chunks(v), chunks(log_f)))
    return o.transpose(1, 0, 3, 2, 4).reshape(B, T, H, DV)


def hgrn2_mixer(h, lb, w_in, w_out, norm_g):
    B, T, _ = h.shape
    proj = h @ w_in
    q, fz, iv, g = jnp.split(proj, [HG_KW, 2 * HG_KW, 2 * HG_KW + HG_VW], axis=-1)
    q = jax.nn.silu(q.astype(jnp.float32)).reshape(B, T, HG_HEADS, HG_DK)
    lb = lb.reshape(HG_HEADS, HG_DK)
    f = lb + (1.0 - lb) * jax.nn.sigmoid(fz.astype(jnp.float32).reshape(B, T, HG_HEADS, HG_DK))
    log_f = jnp.log(jnp.maximum(f, 1e-30))
    v = iv.astype(jnp.float32).reshape(B, T, HG_HEADS, HG_DV)
    o = hgrn2_chunked(q, 1.0 - f, v, log_f)
    o = o * lax.rsqrt(jnp.mean(o * o, axis=-1, keepdims=True) + EPS)
    o = o * norm_g.astype(jnp.float32).reshape(HG_HEADS, HG_DV)
    o = o.reshape(B, T, HG_VW) * jax.nn.silu(g.astype(jnp.float32))
    return o.astype(h.dtype) @ w_out


def hier_moe(h, w_grp, b_grp, w_exp, b_exp, w_gate, w_up, w_down):
    B, T, D = h.shape
    xt = h.reshape(-1, D)
    N = xt.shape[0]
    glog = (xt @ w_grp + b_grp).astype(jnp.float32)
    gprob = jax.nn.softmax(glog, axis=-1)
    grp = jnp.argmax(glog, axis=-1)
    p_grp = jnp.take_along_axis(gprob, grp[:, None], axis=-1)
    elog = (xt @ w_exp + b_exp).astype(jnp.float32).reshape(N, N_GROUPS, EXP_PER_GROUP)
    elog = jnp.take_along_axis(elog, grp[:, None, None], axis=1)[:, 0]
    top_v, top_i = lax.top_k(elog, TOPK_IN_GROUP)
    gate = p_grp * jax.nn.softmax(top_v, axis=-1)
    eid = grp[:, None] * EXP_PER_GROUP + top_i

    A = N * TOPK_IN_GROUP
    e_flat = eid.reshape(-1)
    tok = jnp.repeat(jnp.arange(N, dtype=jnp.int32), TOPK_IN_GROUP)
    w_flat = gate.reshape(-1)
    order = jnp.argsort(e_flat)
    e_s, tok_s, w_s = e_flat[order], tok[order], w_flat[order]
    counts = jnp.zeros((N_EXPERTS,), jnp.int32).at[e_flat].add(1)
    start = jnp.cumsum(counts) - counts
    padded = (counts + MOE_BLOCK - 1) // MOE_BLOCK * MOE_BLOCK
    pad_end = jnp.cumsum(padded)
    pad_start = pad_end - padded
    dest = pad_start[e_s] + jnp.arange(A, dtype=jnp.int32) - start[e_s]
    n_blk = -(-(A + N_EXPERTS * MOE_BLOCK) // MOE_BLOCK)
    n_pad = n_blk * MOE_BLOCK
    buf_tok = jnp.full((n_pad,), N, jnp.int32).at[dest].set(tok_s)
    buf_w = jnp.zeros((n_pad,), jnp.float32).at[dest].set(w_s)
    blk_e = jnp.minimum(jnp.searchsorted(pad_end, jnp.arange(n_blk, dtype=jnp.int32) * MOE_BLOCK,
                                         side='right'), N_EXPERTS - 1)
    xpad = jnp.concatenate([xt, jnp.zeros((1, D), xt.dtype)], axis=0)
    xb = xpad[buf_tok].reshape(n_blk, MOE_BLOCK, D)

    def expert_block(args):
        xblk, e = args
        hid = jax.nn.silu(xblk @ w_gate[e]) * (xblk @ w_up[e])
        return hid @ w_down[e]

    yb = lax.map(expert_block, (xb, blk_e)).reshape(n_pad, D)
    out = jnp.zeros((N + 1, D), yb.dtype).at[buf_tok].add(yb * buf_w[:, None].astype(yb.dtype))
    return out[:N].reshape(B, T, D)


def setup_inputs(seed: int = 0) -> dict:
    key = jax.random.key(seed)
    keys = iter(jax.random.split(key, 40))

    def nrm(shape, scale):
        return jax.random.normal(next(keys), shape, jnp.float32) * scale

    D = D_MODEL
    E = N_EXPERTS
    u = jax.random.uniform(next(keys), (N_EVEN, LRU_WIDTH), jnp.float32, 0.9, 0.999)
    a_base = u ** (1.0 / LRU_C)
    return {
        'x': nrm((BATCH, SEQ, D), 1.0),
        'c': nrm((BATCH, D), 1.0),
        'rel_bias': nrm((N_BUCKETS, NSA_HEADS), 0.3),
        'ada_w': nrm((DEPTH, D, 6 * D), 0.5 * D ** -0.5),
        'ada_b': nrm((DEPTH, 6 * D), 0.01),
        'norm_mix_g': 1.0 + nrm((DEPTH, D), 0.01),
        'norm_ffn_g': 1.0 + nrm((DEPTH, D), 0.01),
        'ev_w_in': nrm((N_EVEN, D, EVEN_COLS), D ** -0.5),
        'ev_w_out': nrm((N_EVEN, EVEN_MIX_OUT, D), EVEN_MIX_OUT ** -0.5),
        'cmp_pe': nrm((N_EVEN, 2, CMP_LEN, HEAD_DIM), 0.1),
        'cmp_w1': nrm((N_EVEN, 2, CMP_LEN * HEAD_DIM, HEAD_DIM), (CMP_LEN * HEAD_DIM) ** -0.5),
        'cmp_b1': nrm((N_EVEN, 2, HEAD_DIM), 0.01),
        'cmp_w2': nrm((N_EVEN, 2, HEAD_DIM, HEAD_DIM), HEAD_DIM ** -0.5),
        'cmp_b2': nrm((N_EVEN, 2, HEAD_DIM), 0.01),
        'lru_conv_w': nrm((N_EVEN, CONV_W, LRU_WIDTH), CONV_W ** -0.5),
        'lru_conv_b': nrm((N_EVEN, LRU_WIDTH), 0.01),
        'lru_wa': nrm((N_EVEN, LRU_BLOCKS, LRU_BW, LRU_BW), LRU_BW ** -0.5),
        'lru_ba': nrm((N_EVEN, LRU_WIDTH), 0.01),
        'lru_wi': nrm((N_EVEN, LRU_BLOCKS, LRU_BW, LRU_BW), LRU_BW ** -0.5),
        'lru_bi': nrm((N_EVEN, LRU_WIDTH), 0.01),
        'lru_lambda': jnp.log(a_base) - jnp.log1p(-a_base),
        'od_w_in': nrm((N_ODD, D, ODD_COLS), D ** -0.5),
        'od_w_out': nrm((N_ODD, HG_VW, D), HG_VW ** -0.5),
        'hg_lb_logits': nrm((DEPTH, HG_KW), 1.0),
        'hg_norm_g': 1.0 + nrm((N_ODD, HG_VW), 0.01),
        'moe_w_grp': nrm((DEPTH, D, N_GROUPS), D ** -0.5),
        'moe_b_grp': nrm((DEPTH, N_GROUPS), 0.01),
        'moe_w_exp': nrm((DEPTH, D, E), D ** -0.5),
        'moe_b_exp': nrm((DEPTH, E), 0.01),
        'moe_w_gate': nrm((DEPTH, E, D, D_EXPERT), D ** -0.5),
        'moe_w_up': nrm((DEPTH, E, D, D_EXPERT), D ** -0.5),
        'moe_w_down': nrm((DEPTH, E, D_EXPERT, D), D_EXPERT ** -0.5),
        'final_g': 1.0 + nrm((D,), 0.01),
    }


def reference(x, c, rel_bias, ada_w, ada_b, norm_mix_g, norm_ffn_g, ev_w_in, ev_w_out,
              cmp_pe, cmp_w1, cmp_b1, cmp_w2, cmp_b2, lru_conv_w, lru_conv_b, lru_wa, lru_ba,
              lru_wi, lru_bi, lru_lambda, od_w_in, od_w_out, hg_lb_logits, hg_norm_g,
              moe_w_grp, moe_b_grp, moe_w_exp, moe_b_exp, moe_w_gate, moe_w_up, moe_w_down,
              final_g):
    lb_all = jnp.cumsum(jax.nn.softmax(hg_lb_logits.astype(jnp.float32), axis=0), axis=0)
    lb_all = lb_all - lb_all[0]
    c_act = jax.nn.silu(c)
    for l in range(DEPTH):
        mod = c_act @ ada_w[l] + ada_b[l]
        sh1, sc1, g1, sh2, sc2, g2 = [m[:, None, :] for m in jnp.split(mod, 6, axis=-1)]
        hmix = rmsnorm(x, norm_mix_g[l]) * (1.0 + sc1) + sh1
        j = l // 2
        if l % 2 == 0:
            y = nsa_rglru_mixer(hmix, rel_bias, ev_w_in[j], ev_w_out[j], cmp_pe[j], cmp_w1[j],
                                cmp_b1[j], cmp_w2[j], cmp_b2[j], lru_conv_w[j], lru_conv_b[j],
                                lru_wa[j], lru_ba[j], lru_wi[j], lru_bi[j], lru_lambda[j])
        else:
            y = hgrn2_mixer(hmix, lb_all[l], od_w_in[j], od_w_out[j], hg_norm_g[j])
        x = x + g1 * y
        hffn = rmsnorm(x, norm_ffn_g[l]) * (1.0 + sc2) + sh2
        x = x + g2 * hier_moe(hffn, moe_w_grp[l], moe_b_grp[l], moe_w_exp[l], moe_b_exp[l],
                              moe_w_gate[l], moe_w_up[l], moe_w_down[l])
    return rmsnorm(x, final_g)
```

```cpp
#include <hip/hip_runtime.h>
#include <cstdio>
#include <cstdint>

#define LAS __attribute__((address_space(3)))
typedef unsigned short bf16_t;
typedef short bf16x8 __attribute__((ext_vector_type(8)));
typedef float f32x4 __attribute__((ext_vector_type(4)));
typedef float f32x16 __attribute__((ext_vector_type(16)));
typedef unsigned u32x4 __attribute__((ext_vector_type(4)));
typedef unsigned u32x2 __attribute__((ext_vector_type(2)));
typedef unsigned char uchar;

constexpr int T = 8192, D = 2048;
constexpr int NTHREADS = 512, NWAVES = 8;
constexpr int LDS_BYTES = 147456;
constexpr int EVEN_COLS = 4632;
constexpr int KPAD = 64;
constexpr int TP = T + KPAD;
constexpr int MOE_ROWS = 32768;
constexpr int LOGIT_LD = 80;

constexpr size_t al256(size_t x) { return (x + 255) & ~(size_t)255; }
constexpr size_t WS_CTL = 0;
constexpr size_t CTL_BYTES = 16384;
constexpr size_t CTL_CNT_OFF = 13824;
constexpr size_t WS_MOD = WS_CTL + CTL_BYTES;
constexpr size_t WS_PEBP = WS_MOD + 2 * 12288 * 4;
constexpr size_t WS_WIN0T = WS_PEBP + 16 * 2 * 128 * 4;
constexpr size_t WS_WV0T = WS_WIN0T + (size_t)4352 * 2048 * 2;
constexpr size_t WS_WOUT0T = WS_WV0T + (size_t)512 * 2048 * 2;
constexpr size_t WS_WC1T = WS_WOUT0T + (size_t)2048 * 2048 * 2;
constexpr size_t WS_WC2T = WS_WC1T + (size_t)2 * 128 * 4096 * 2;
constexpr size_t WS_WAT = WS_WC2T + (size_t)2 * 128 * 128 * 2;
constexpr size_t WS_WIT = WS_WAT + (size_t)8 * 128 * 128 * 2;
constexpr size_t WS_WIN1T = WS_WIT + (size_t)8 * 128 * 128 * 2;
constexpr size_t WS_WOUT1T = WS_WIN1T + (size_t)8192 * 2048 * 2;
constexpr size_t WS_ROUTET = WS_WOUT1T + (size_t)2048 * 2048 * 2;
constexpr size_t WS_W1T = WS_ROUTET + (size_t)2 * 256 * 2048 * 2;
constexpr size_t WS_W2T = WS_W1T + (size_t)2 * 64 * 1024 * 2048 * 2;
constexpr size_t WS_HMIX = WS_W2T + (size_t)2 * 64 * 2048 * 512 * 2;
constexpr size_t WS_XA = WS_HMIX + (size_t)T * D * 2;
constexpr size_t WS_XB = WS_XA + (size_t)T * D * 4;
constexpr size_t WS_XG = WS_XB + (size_t)T * D * 4;
constexpr size_t WS_HID = WS_XG + (size_t)MOE_ROWS * 2048 * 2;
constexpr size_t WS_YB = WS_HID + (size_t)MOE_ROWS * 512 * 2;
constexpr size_t WS_LOGIT = WS_YB + (size_t)MOE_ROWS * 2048 * 2;
constexpr size_t WS_TOKE = WS_LOGIT + (size_t)T * LOGIT_LD * 4;
constexpr size_t WS_TOKPOS = WS_TOKE + (size_t)T * 2 * 4;
constexpr size_t WS_TOKW = WS_TOKPOS + (size_t)T * 2 * 4;
constexpr size_t WS_TOKROW = WS_TOKW + (size_t)T * 2 * 4;
constexpr size_t WS_TILEE = WS_TOKROW + (size_t)T * 2 * 4;
constexpr size_t WS_PARK = WS_TILEE + 1024;
constexpr size_t WS_U = WS_PARK + (size_t)256 * 64 * 512 * 4;
constexpr size_t U_Q = WS_U;
constexpr size_t U_KB = U_Q + (size_t)T * 1024 * 2;
constexpr size_t U_VT = U_KB + (size_t)4 * 2 * TP * 128 * 2;
constexpr size_t U_Y = U_VT + (size_t)2 * 2 * 128 * T * 2;
constexpr size_t U_XBR = U_Y + (size_t)T * 1024 * 2;
constexpr size_t U_GATE = U_XBR + (size_t)T * 1024 * 4;
constexpr size_t U_KCMP = U_GATE + (size_t)T * 24 * 4;
constexpr size_t U_VCMPT = U_KCMP + (size_t)2 * 512 * 128 * 2;
constexpr size_t U_HLOC = U_VCMPT + (size_t)2 * 128 * 512 * 2;
constexpr size_t U_PC = U_HLOC + (size_t)T * 1024 * 4;
constexpr size_t U_HEND = U_PC + (size_t)T * 1024 * 4;
constexpr size_t U_PEND = U_HEND + (size_t)128 * 1024 * 4;
constexpr size_t U_CAT = U_PEND + (size_t)128 * 1024 * 4;
constexpr size_t U_END0 = U_CAT + (size_t)T * 2048 * 2;
constexpr size_t V_QS = WS_U;
constexpr size_t V_LOGF = V_QS + (size_t)T * 2048 * 2;
constexpr size_t V_KK = V_LOGF + (size_t)T * 2048 * 4;
constexpr size_t V_V = V_KK + (size_t)T * 2048 * 2;
constexpr size_t V_GS = V_V + (size_t)T * 2048 * 2;
constexpr size_t V_OINTRA = V_GS + (size_t)T * 2048 * 2;
constexpr size_t V_QHAT = V_OINTRA + (size_t)T * 2048 * 4;
constexpr size_t V_ST = V_QHAT + (size_t)T * 2048 * 2;
constexpr size_t V_DEC = V_ST + (size_t)128 * 16 * 128 * 128 * 4;
constexpr size_t V_HGO = V_DEC + (size_t)128 * 16 * 128 * 4;
constexpr size_t U_END1 = V_HGO + (size_t)T * 2048 * 2;
constexpr size_t WS_END = (U_END0 > U_END1 ? U_END0 : U_END1);

struct Params {
    const float* in[33];
    float* out;
    uchar* ws;
    int ph_lo, ph_hi;
};
enum { I_X = 0, I_C, I_RELB, I_ADAW, I_ADAB, I_NMG, I_NFG, I_EWIN, I_EWOUT, I_PE, I_CW1, I_CB1, I_CW2, I_CB2, I_CONVW, I_CONVB, I_LWA, I_LBA, I_LWI, I_LBI,
       I_LAMBDA, I_OWIN, I_OWOUT, I_LBL, I_HNG, I_MWGRP, I_MBGRP, I_MWEXP, I_MBEXP, I_MWG, I_MWU, I_MWD, I_FG };

__device__ __forceinline__ int tid_opaque() { int t = threadIdx.x; asm volatile("" : "+v"(t)); return t; }
__device__ __forceinline__ unsigned cvt_pk_bf16(float lo, float hi) { unsigned r; asm volatile("v_cvt_pk_bf16_f32 %0, %1, %2" : "=v"(r) : "v"(lo), "v"(hi)); return r; }
__device__ __forceinline__ float bf_lo(unsigned u) { return __uint_as_float(u << 16); }
__device__ __forceinline__ float bf_hi(unsigned u) { return __uint_as_float(u & 0xffff0000u); }
__device__ __forceinline__ float bf2f(bf16_t b) { return __uint_as_float(((unsigned)b) << 16); }
__device__ __forceinline__ bf16_t f2bf(float f) { return (bf16_t)(cvt_pk_bf16(f, 0.f) & 0xffffu); }
__device__ __forceinline__ float sigmoidf_(float x) { return __builtin_amdgcn_rcpf(1.0f + __expf(-x)); }
__device__ __forceinline__ float siluf_(float x) { return x * __builtin_amdgcn_rcpf(1.0f + __expf(-x)); }
__device__ __forceinline__ float geluf_(float x) { const float u = 0.7978845608028654f * (x + 0.044715f * x * x * x); const float t = 1.0f - 2.0f * __builtin_amdgcn_rcpf(__expf(2.0f * u) + 1.0f); return 0.5f * x * (1.0f + t); }
__device__ __forceinline__ float wave_sum(float v) {
#pragma unroll
    for (int o = 32; o > 0; o >>= 1) v += __shfl_xor(v, o);
    return v;
}
__device__ __forceinline__ int t5_bucket(int n) {
    if (n < 16) return n;
    int b = 16;
    b += (n >= 19) + (n >= 21) + (n >= 24) + (n >= 27) + (n >= 31) + (n >= 35) + (n >= 40) + (n >= 46) + (n >= 52) + (n >= 59) + (n >= 67) + (n >= 77) + (n >= 87) + (n >= 99) + (n >= 113);
    return b;
}
#define XB_TMO      128
#define XB_XCNT(j)  (256  + 64 * (j))
#define XB_XSUB(j)  (1280 + 64 * (j))
#define XB_XGEN(j)  (2304 + 64 * (j))
#define XB_TOP      3328
#define XB_TOPGEN   3392
#define XCD_BAR_WORDS 3456
#define XB_SPIN_CAP (1u << 18)
#define LAS __attribute__((address_space(3)))

__device__ __forceinline__ unsigned xb_ld(unsigned* p)              { return __hip_atomic_load(p, __ATOMIC_RELAXED, __HIP_MEMORY_SCOPE_AGENT); }
__device__ __forceinline__ unsigned xb_add(unsigned* p, unsigned v) { return __hip_atomic_fetch_add(p, v, __ATOMIC_RELAXED, __HIP_MEMORY_SCOPE_AGENT); }
__device__ __forceinline__ unsigned xb_xcc_id() { return (unsigned)__builtin_amdgcn_s_getreg((3 << 11) | 20) & 0xFu; }
#define XB_SPIN(cond, bar) do { unsigned _sp = 0; while (cond) { __builtin_amdgcn_s_sleep(1); \
    if ((++_sp & 255u) == 0u) { if (xb_ld(&(bar)[XB_TMO])) break; if (_sp > XB_SPIN_CAP) { atomicAdd(&(bar)[XB_TMO], 1u); break; } } } } while (0)

struct XcdBarrier {
    unsigned* bar; unsigned x;
    volatile LAS unsigned* st;
};

__device__ __forceinline__ XcdBarrier xcd_barrier_post(unsigned* bar, volatile LAS unsigned* st) {
    XcdBarrier b; b.bar = bar; b.x = xb_xcc_id(); b.st = st;
    if (threadIdx.x == 0) (void)xb_add(&bar[XB_XCNT(b.x)], 1u);
    return b;
}
__device__ __forceinline__ void xcd_barrier_complete(unsigned* bar, unsigned x, unsigned& nloc, unsigned& nx) {
    const unsigned G = gridDim.x * gridDim.y * gridDim.z;
    unsigned sum, cnt, mine, sp = 0u;
    for (;;) {
        sum = 0u; cnt = 0u; mine = 0u;
#pragma unroll
        for (unsigned j = 0; j < 16; ++j) { const unsigned c = xb_ld(&bar[XB_XCNT(j)]); sum += c; cnt += (c > 0u) ? 1u : 0u; mine = (j == x) ? c : mine; }
        if (sum == G) break;
        __builtin_amdgcn_s_sleep(1);
        if ((++sp & 255u) == 0u) { if (xb_ld(&bar[XB_TMO])) break; if (sp > XB_SPIN_CAP) { atomicAdd(&bar[XB_TMO], 1u); break; } }
    }
    nloc = mine > 0u ? mine : 1u; nx = cnt > 0u ? cnt : 1u;
}

__device__ __forceinline__ void xcd_barrier(const XcdBarrier& b) {
    asm volatile("s_waitcnt vmcnt(0)" ::: "memory");
    __syncthreads();
    if (threadIdx.x == 0) {
        unsigned* bar = b.bar;
        __builtin_amdgcn_s_waitcnt(0);
        unsigned nloc = b.st[0], nx = b.st[1];
        if (nloc == 0u) { xcd_barrier_complete(bar, b.x, nloc, nx); b.st[0] = nloc; b.st[1] = nx; }
        const unsigned old = xb_add(&bar[XB_XSUB(b.x)], 1u);
        const unsigned gen = old / nloc;
        if (old + 1u == (gen + 1u) * nloc) {
            __builtin_amdgcn_fence(__ATOMIC_RELEASE, "agent");
            asm volatile("s_waitcnt vmcnt(0)" ::: "memory");
            const unsigned og = xb_add(&bar[XB_TOP], 1u);
            const unsigned tg = og / nx;
            if (og + 1u == (tg + 1u) * nx) xb_add(&bar[XB_TOPGEN], 1u);
            else XB_SPIN(xb_ld(&bar[XB_TOPGEN]) == tg, bar);
            __builtin_amdgcn_fence(__ATOMIC_ACQUIRE, "agent");
            xb_add(&bar[XB_XGEN(b.x)], 1u);
            asm volatile("s_waitcnt vmcnt(0)" ::: "memory");
        } else {
            XB_SPIN(xb_ld(&bar[XB_XGEN(b.x)]) == gen, bar);
            __builtin_amdgcn_fence(__ATOMIC_ACQUIRE, "agent");
            asm volatile("s_waitcnt vmcnt(0)" ::: "memory");
        }
    }
    __syncthreads();
}
namespace pg8 {
#define PG8_LAS __attribute__((address_space(3)))
constexpr int BM = 256, BK = 64, HALF = 128, HTB = HALF * BK * 2  , STAGE_BYTES = 8 * HTB, NXCD = 8, WGM = 8;
__host__ __device__ __forceinline__ int lds_byte(int r, int c) { const int st = (r >> 4) * 2 + (c >> 5), rr = r & 15, cc = c & 31, ob = rr * 64 + cc * 2; return st * 1024 + (ob ^ (((ob >> 9) & 1) << 5)); }
__host__ __device__ __forceinline__ void stage_rc(int b, int& R, int& C) { const int st = b / 1024, sb = b % 1024, swz = sb ^ (((sb >> 9) & 1) << 5); R = (st >> 1) * 16 + swz / 64; C = (st & 1) * 32 + (swz % 64) / 2; }
__host__ __device__ __forceinline__ int perm32(int rho) { const int n = rho >> 4, i = rho & 15; return 8 * (i >> 2) + 4 * n + (i & 3); }
struct Unit { int pm, pn; const char* a; const char* b; int aux; };
__host__ __device__ __forceinline__ void static_tile(int L, int nM, int nN, int& pm, int& pn) {
    const int nwg = nM * nN; int wgid = L; { const int q = nwg / NXCD, r = nwg % NXCD, xcd = wgid % NXCD, off = wgid / NXCD; wgid = (xcd < r ? xcd * (q + 1) : r * (q + 1) + (xcd - r) * q) + off; }
    const int nig = WGM * nN, gid = wgid / nig, fm = gid * WGM, gsz = (nM - fm) < WGM ? (nM - fm) : WGM;
    pm = fm + ((wgid % nig) % gsz); pn = (wgid % nig) / gsz;
}

template <class Epi, class Sched, bool STAMP = false>
__device__ __forceinline__ void gemm_phase(PG8_LAS unsigned char* lds, const int Kdim, const Sched& S, const Epi& E, unsigned long long* stamps) {
    const int tid = tid_opaque(), wid = __builtin_amdgcn_readfirstlane(tid >> 6), lane = tid & 63, wr = wid >> 2, wc = wid & 3, fr = lane & 15, fq = lane >> 4;
    const int K = Kdim, nt = K / BK;
    int ts_lo = 0, ts_hi = 0, nts = 0; const unsigned long long rt_entry = STAMP ? (unsigned long long)wall_clock64() : 0ull;
#define PG8_STAMP() do { if (STAMP && wid == 0 && nts < 64) { const unsigned long long _c = (unsigned long long)clock64(); \
        ts_lo = (lane == nts) ? (int)(unsigned)_c : ts_lo; ts_hi = (lane == nts) ? (int)(unsigned)(_c >> 32) : ts_hi; ++nts; } } while (0)
    PG8_STAMP();
    unsigned voffA[2], voffB[2];
#pragma unroll
    for (int i = 0; i < 2; ++i) { int R, C; stage_rc(tid * 16 + i * 8192, R, C); const int Rb = Epi::PERM ? ((R & ~31) + perm32(R & 31)) : R;
        voffA[i] = (unsigned)(R * K + C) * 2u; voffB[i] = (unsigned)(Rb * K + C) * 2u; }
    const size_t kstep = (size_t)(BK * 2);
    const size_t hstep = (size_t)HALF * K * 2;
        const unsigned ldsw = (unsigned)wid * 1024u;
    const int aoff = lds_byte(wr * 64 + fr, fq * 8), boff = lds_byte(wc * 32 + fr, fq * 8);
#define PG8_SA(b, h) (((b) * 2 + (h)) * HTB)
#define PG8_SB(b, h) ((4 + (b) * 2 + (h)) * HTB)
#define PG8_STAGE(bufoff, gbase, voff) do { _Pragma("unroll") for (int _i = 0; _i < 2; ++_i) \
        __builtin_amdgcn_global_load_lds((const unsigned*)((const char*)(gbase) + (voff)[_i]), (PG8_LAS unsigned*)(lds + (bufoff) + ldsw + _i * 8192), 16, 0, 0); } while (0)
#define PG8_LDA(dst, b, h) do { _Pragma("unroll") for (int m = 0; m < 4; ++m) _Pragma("unroll") for (int k = 0; k < 2; ++k) dst[m][k] = *(const PG8_LAS bf16x8*)(lds + PG8_SA(b, h) + aoff + m * 2048 + k * 1024); } while (0)
#define PG8_LDB(dst, b, h) do { _Pragma("unroll") for (int n = 0; n < 2; ++n) _Pragma("unroll") for (int k = 0; k < 2; ++k) dst[n][k] = *(const PG8_LAS bf16x8*)(lds + PG8_SB(b, h) + boff + n * 2048 + k * 1024); } while (0)
#define PG8_MMA(ai, bj, At, Bt) do { __builtin_amdgcn_s_setprio(1); _Pragma("unroll") for (int m = 0; m < 4; ++m) _Pragma("unroll") for (int n = 0; n < 2; ++n) _Pragma("unroll") for (int k = 0; k < 2; ++k) \
        acc[ai][bj][m][n] = __builtin_amdgcn_mfma_f32_16x16x32_bf16(Bt[n][k], At[m][k], acc[ai][bj][m][n], 0, 0, 0); __builtin_amdgcn_s_setprio(0); } while (0)
#define PG8_WAIT_V(n) asm volatile("s_waitcnt vmcnt(" #n ")" ::: "memory")
#define PG8_WAIT_L(n) asm volatile("s_waitcnt lgkmcnt(" #n ")" ::: "memory")
#define PG8_BAR __builtin_amdgcn_s_barrier()
#define PG8_SCHED __builtin_amdgcn_sched_barrier(0)
    Unit cur, nxt; int ui = 0;
    if (!S.next(0, cur)) return;
    f32x4 acc[2][2][4][2];
#pragma unroll
    for (int a = 0; a < 2; ++a)
#pragma unroll
        for (int b = 0; b < 2; ++b)
#pragma unroll
            for (int m = 0; m < 4; ++m)
#pragma unroll
                for (int n = 0; n < 2; ++n) acc[a][b][m][n] = (f32x4){0.f, 0.f, 0.f, 0.f};
    bf16x8 At[4][2], B0[2][2], B1[2][2];
    const char* cA = cur.a; const char* cB = cur.b;
    S.a_ready(cur);
    PG8_STAGE(PG8_SB(0, 0), cB, voffB); PG8_STAGE(PG8_SA(0, 0), cA, voffA); PG8_STAGE(PG8_SB(0, 1), cB + hstep, voffB); PG8_STAGE(PG8_SA(0, 1), cA + hstep, voffA);
    if (wr == 1) PG8_BAR;
    PG8_WAIT_V(4); PG8_BAR;
    PG8_STAGE(PG8_SB(1, 0), cB + kstep, voffB); PG8_STAGE(PG8_SA(1, 0), cA + kstep, voffA); PG8_STAGE(PG8_SB(1, 1), cB + hstep + kstep, voffB);
    PG8_WAIT_V(6); PG8_BAR;
    PG8_STAMP();
    for (;;) {
        const bool has_next = S.next(ui + 1, nxt);
        const char* nA = has_next ? nxt.a : cA; const char* nB = has_next ? nxt.b : cB;
        for (int t = 0; t < nt; t += 2) {
            const bool last = (t == nt - 2);
            const char* a1 = cA + (size_t)(t + 1) * kstep;
            const char* a2 = last ? nA : cA + (size_t)(t + 2) * kstep; const char* b2 = last ? nB : cB + (size_t)(t + 2) * kstep;
            const char* a3 = a2 + kstep; const char* b3 = b2 + kstep;
            if (last && has_next) S.a_ready(nxt);
            PG8_LDB(B0, 0, 0); PG8_SCHED; PG8_LDA(At, 0, 0); PG8_STAGE(PG8_SA(1, 1), a1 + hstep, voffA);
            PG8_WAIT_L(8); PG8_BAR; PG8_WAIT_L(0); PG8_MMA(0, 0, At, B0); PG8_BAR; PG8_SCHED;
            PG8_LDB(B1, 0, 1); PG8_STAGE(PG8_SB(0, 0), b2, voffB);
            PG8_BAR; PG8_WAIT_L(0); PG8_MMA(0, 1, At, B1); PG8_BAR;
            PG8_LDA(At, 0, 1); PG8_STAGE(PG8_SA(0, 0), a2, voffA);
            PG8_BAR; PG8_WAIT_L(0); PG8_MMA(1, 0, At, B0); PG8_BAR; PG8_SCHED;
            PG8_STAGE(PG8_SB(0, 1), b2 + hstep, voffB);
            PG8_WAIT_V(6); PG8_BAR; PG8_MMA(1, 1, At, B1); PG8_BAR;
            PG8_LDB(B0, 1, 0); PG8_SCHED; PG8_LDA(At, 1, 0); PG8_STAGE(PG8_SA(0, 1), a2 + hstep, voffA);
            PG8_WAIT_L(8); PG8_BAR; PG8_WAIT_L(0); PG8_MMA(0, 0, At, B0); PG8_BAR; PG8_SCHED;
            PG8_LDB(B1, 1, 1); PG8_STAGE(PG8_SB(1, 0), b3, voffB);
            PG8_BAR; PG8_WAIT_L(0); PG8_MMA(0, 1, At, B1); PG8_BAR;
            PG8_LDA(At, 1, 1); PG8_STAGE(PG8_SA(1, 0), a3, voffA);
            PG8_BAR; PG8_WAIT_L(0); PG8_MMA(1, 0, At, B0); PG8_BAR; PG8_SCHED;
            PG8_STAGE(PG8_SB(1, 1), b3 + hstep, voffB);
            PG8_WAIT_V(6); PG8_BAR; PG8_MMA(1, 1, At, B1); PG8_BAR;
        }
        PG8_STAMP();
        if constexpr (!Epi::AFTER_DRAIN) { E(acc, cur, wr, wc, fr, fq); S.done(cur); }
        PG8_STAMP();
        if (!has_next) break;
#pragma unroll
        for (int a = 0; a < 2; ++a)
#pragma unroll
            for (int b = 0; b < 2; ++b)
#pragma unroll
                for (int m = 0; m < 4; ++m)
#pragma unroll
                    for (int n = 0; n < 2; ++n) acc[a][b][m][n] = (f32x4){0.f, 0.f, 0.f, 0.f};
        cur = nxt; cA = nA; cB = nB; ++ui;
    }
    PG8_WAIT_V(0);
    if (wr == 0) PG8_BAR;
    PG8_BAR;
    if constexpr (Epi::AFTER_DRAIN) { E.fused(acc, cur, wr, wc, fr, fq, lds, wid, lane); S.done(cur); }
    PG8_STAMP();
    if (STAMP && wid == 0) { stamps[lane] = lane < nts ? (((unsigned long long)(unsigned)ts_hi << 32) | (unsigned)ts_lo) : 0ull;
        if (lane == 62) stamps[62] = rt_entry; if (lane == 63) stamps[63] = (unsigned long long)wall_clock64(); }
#undef PG8_STAMP
#undef PG8_SA
#undef PG8_SB
#undef PG8_STAGE
#undef PG8_LDA
#undef PG8_LDB
#undef PG8_MMA
#undef PG8_WAIT_V
#undef PG8_WAIT_L
#undef PG8_BAR
#undef PG8_SCHED
}
}
struct ConvJob { const float* src; int ld, K, c0, nc, cb, rb; bf16_t* dst; int r0; };

__device__ __forceinline__ void conv_tile_wave(const ConvJob& j, int kt, int ct, LAS float* tl, int lane) {
    const int k0 = kt * 64, cbase = ct * 64;
    const int ncv = (j.nc - cbase) < 64 ? (j.nc - cbase) : 64;
    const float* s = j.src + (size_t)k0 * j.ld + j.c0 + cbase;
    f32x4 v[16];
#pragma unroll
    for (int i = 0; i < 16; ++i) {
        const int id = lane + 64 * i, row = id >> 4, c4 = (id & 15) * 4;
        v[i] = (c4 < ncv) ? *(const f32x4*)(s + (size_t)row * j.ld + c4) : (f32x4){0.f, 0.f, 0.f, 0.f};
    }
#pragma unroll
    for (int i = 0; i < 16; ++i) {
        const int id = lane + 64 * i, row = id >> 4, c4 = (id & 15) * 4;
        tl[row * 65 + c4 + 0] = v[i][0]; tl[row * 65 + c4 + 1] = v[i][1]; tl[row * 65 + c4 + 2] = v[i][2]; tl[row * 65 + c4 + 3] = v[i][3];
    }
#pragma unroll
    for (int i = 0; i < 8; ++i) {
        const int id = lane + 64 * i, cc = id >> 3, kc = id & 7;
        if (cc < ncv) {
            const int c = cbase + cc, drow = j.r0 + (c / j.cb) * j.rb + (c % j.cb);
            float f[8];
#pragma unroll
            for (int q = 0; q < 8; ++q) f[q] = tl[(8 * kc + q) * 65 + cc];
            u32x4 o; o[0] = cvt_pk_bf16(f[0], f[1]); o[1] = cvt_pk_bf16(f[2], f[3]); o[2] = cvt_pk_bf16(f[4], f[5]); o[3] = cvt_pk_bf16(f[6], f[7]);
            *(u32x4*)(j.dst + (size_t)drow * j.K + k0 + 8 * kc) = o;
        }
    }
}

__device__ __forceinline__ bool small_job(int idx, const Params& p, ConvJob& o) {
    uchar* ws = p.ws;
    o.rb = 0; o.r0 = 0;
    if (idx < 10) {
        o.src = p.in[I_EWIN]; o.ld = EVEN_COLS; o.K = 2048; o.nc = 256;
        switch (idx) {
            case 0: o.c0 = 0; o.nc = 1024; o.r0 = 0; break;
            case 1: o.c0 = 1024; o.r0 = 1024; break;
            case 2: o.c0 = 1280; o.r0 = 1280; break;
            case 3: o.c0 = 1536; o.r0 = 1536; break;
            case 4: o.c0 = 2048; o.r0 = 1792; break;
            case 5: o.c0 = 2584; o.nc = 1024; o.r0 = 2048; break;
            case 6: o.c0 = 3608; o.nc = 1024; o.r0 = 3072; break;
            case 7: o.c0 = 2560; o.nc = 24; o.r0 = 4096; break;
            case 8: o.c0 = 1792; o.r0 = 0; break;
            default: o.c0 = 2304; o.r0 = 256; break;
        }
        o.cb = o.nc;
        o.dst = (bf16_t*)(ws + (idx < 8 ? WS_WIN0T : WS_WV0T));
        return true;
    }
    o.c0 = 0;
    if (idx == 10) { o.src = p.in[I_EWOUT]; o.ld = 2048; o.K = 2048; o.nc = 2048; o.cb = 2048; o.dst = (bf16_t*)(ws + WS_WOUT0T); return true; }
    if (idx < 13) { const int k = idx - 11; o.src = p.in[I_CW1] + (size_t)k * 4096 * 128; o.ld = 128; o.K = 4096; o.nc = 128; o.cb = 128; o.dst = (bf16_t*)(ws + WS_WC1T) + (size_t)k * 128 * 4096; return true; }
    if (idx < 15) { const int k = idx - 13; o.src = p.in[I_CW2] + (size_t)k * 128 * 128; o.ld = 128; o.K = 128; o.nc = 128; o.cb = 128; o.dst = (bf16_t*)(ws + WS_WC2T) + (size_t)k * 128 * 128; return true; }
    if (idx < 23) { const int k = idx - 15; o.src = p.in[I_LWA] + (size_t)k * 128 * 128; o.ld = 128; o.K = 128; o.nc = 128; o.cb = 128; o.dst = (bf16_t*)(ws + WS_WAT) + (size_t)k * 128 * 128; return true; }
    if (idx < 31) { const int k = idx - 23; o.src = p.in[I_LWI] + (size_t)k * 128 * 128; o.ld = 128; o.K = 128; o.nc = 128; o.cb = 128; o.dst = (bf16_t*)(ws + WS_WIT) + (size_t)k * 128 * 128; return true; }
    if (idx == 31) { o.src = p.in[I_OWIN]; o.ld = 8192; o.K = 2048; o.nc = 8192; o.cb = 8192; o.dst = (bf16_t*)(ws + WS_WIN1T); return true; }
    if (idx == 32) { o.src = p.in[I_OWOUT]; o.ld = 2048; o.K = 2048; o.nc = 2048; o.cb = 2048; o.dst = (bf16_t*)(ws + WS_WOUT1T); return true; }
    if (idx < 35) { const int l = idx - 33; o.src = p.in[I_MWGRP] + (size_t)l * 2048 * 8; o.ld = 8; o.K = 2048; o.nc = 8; o.cb = 8; o.dst = (bf16_t*)(ws + WS_ROUTET) + (size_t)l * 256 * 2048; return true; }
    if (idx < 37) { const int l = idx - 35; o.src = p.in[I_MWEXP] + (size_t)l * 2048 * 64; o.ld = 64; o.K = 2048; o.nc = 64; o.cb = 64; o.r0 = 8; o.dst = (bf16_t*)(ws + WS_ROUTET) + (size_t)l * 256 * 2048; return true; }
    return false;
}
constexpr int N_SMALL_JOBS = 37;

__device__ __forceinline__ void phase_prologue(const Params& p, LAS uchar* lds) {
    const int tid = tid_opaque(), lane = tid & 63, wave = tid >> 6;
    const int gw = blockIdx.x * NWAVES + wave, nw = gridDim.x * NWAVES;
    uchar* ws = p.ws;
    {
        LAS float* cact = (LAS float*)lds; LAS float* red = (LAS float*)(lds + 8192);
        for (int i = tid; i < D; i += NTHREADS) cact[i] = siluf_(p.in[I_C][i]);
        __syncthreads();
        float* mod = (float*)(ws + WS_MOD);
        for (int u = blockIdx.x; u < 384; u += gridDim.x) {
            const int l = u / 192, col = (u % 192) * 64 + lane;
            const float* w = p.in[I_ADAW] + (size_t)l * 2048 * 12288 + col;
            float acc = 0.f;
#pragma unroll 16
            for (int kk = 0; kk < 256; ++kk) { const int k = wave * 256 + kk; acc += cact[k] * w[(size_t)k * 12288]; }
            red[wave * 64 + lane] = acc;
            __syncthreads();
            if (wave == 0) { float s = p.in[I_ADAB][l * 12288 + col];
#pragma unroll
                for (int q = 0; q < 8; ++q) s += red[q * 64 + lane];
                mod[l * 12288 + col] = s; }
            __syncthreads();
        }
    }
    for (int u = gw; u < 64; u += nw) {
        const int kind = u >> 5, half = (u >> 4) & 1, ks = u & 15, col = half * 64 + lane;
        const float* pe = p.in[I_PE] + (size_t)kind * 4096 + ks * 256;
        const float* w = p.in[I_CW1] + ((size_t)kind * 4096 + ks * 256) * 128 + col;
        float acc = 0.f;
#pragma unroll 8
        for (int k = 0; k < 256; ++k) acc += pe[k] * w[(size_t)k * 128];
        ((float*)(ws + WS_PEBP))[(ks * 2 + kind) * 128 + col] = acc;
    }
    LAS float* tl = (LAS float*)(lds + wave * 16640);
    for (int jx = 0; jx < N_SMALL_JOBS; ++jx) {
        ConvJob j; small_job(jx, p, j);
        const int tk = j.K >> 6, tc = (j.nc + 63) >> 6, nt = tk * tc;
        for (int t = gw; t < nt; t += nw) conv_tile_wave(j, t % tk, t / tk, tl, lane);
    }
    for (int m = gw; m < 2 * 64 * 768; m += nw) {
        const int le = m / 768, r2 = m % 768, which = r2 >> 8, tt = r2 & 255;
        ConvJob j; j.c0 = 0; j.r0 = 0;
        if (which < 2) {
            j.src = p.in[which == 0 ? I_MWG : I_MWU] + (size_t)le * 2048 * 512; j.ld = 512; j.K = 2048; j.nc = 512; j.cb = 128; j.rb = 256; j.r0 = which * 128;
            j.dst = (bf16_t*)(ws + WS_W1T) + (size_t)le * 1024 * 2048;
            conv_tile_wave(j, tt & 31, tt >> 5, tl, lane);
        } else {
            j.src = p.in[I_MWD] + (size_t)le * 512 * 2048; j.ld = 2048; j.K = 512; j.nc = 2048; j.cb = 2048; j.rb = 0;
            j.dst = (bf16_t*)(ws + WS_W2T) + (size_t)le * 2048 * 512;
            conv_tile_wave(j, tt & 7, tt >> 3, tl, lane);
        }
    }
    __syncthreads();
}

template <bool COMBINE, bool FINAL>
__device__ __forceinline__ void phase_norm(const float* xin, const float* gain, const float* sh, const float* sc, bf16_t* out_bf, float* out_f32,
                                           const bf16_t* yb, const int* tokrow, const float* tokw, const float* g2, float* xout) {
    const int tid = tid_opaque(), lane = tid & 63, wave = tid >> 6;
    for (int r = blockIdx.x * NWAVES + wave; r < T; r += gridDim.x * NWAVES) {
        f32x4 v[8];
#pragma unroll
        for (int i = 0; i < 8; ++i) v[i] = *(const f32x4*)(xin + (size_t)r * D + (i * 64 + lane) * 4);
        if (COMBINE) {
            const int r0 = tokrow[2 * r], r1 = tokrow[2 * r + 1]; const float w0 = tokw[2 * r], w1 = tokw[2 * r + 1];
#pragma unroll
            for (int i = 0; i < 8; ++i) {
                const int c = (i * 64 + lane) * 4;
                const u32x2 a = *(const u32x2*)(yb + (size_t)r0 * D + c), b = *(const u32x2*)(yb + (size_t)r1 * D + c);
                const f32x4 g = *(const f32x4*)(g2 + c);
                v[i][0] += g[0] * (w0 * bf_lo(a[0]) + w1 * bf_lo(b[0])); v[i][1] += g[1] * (w0 * bf_hi(a[0]) + w1 * bf_hi(b[0]));
                v[i][2] += g[2] * (w0 * bf_lo(a[1]) + w1 * bf_lo(b[1])); v[i][3] += g[3] * (w0 * bf_hi(a[1]) + w1 * bf_hi(b[1]));
                if (xout) *(f32x4*)(xout + (size_t)r * D + c) = v[i];
            }
        }
        float ss = 0.f;
#pragma unroll
        for (int i = 0; i < 8; ++i) ss += v[i][0] * v[i][0] + v[i][1] * v[i][1] + v[i][2] * v[i][2] + v[i][3] * v[i][3];
        ss = wave_sum(ss);
        const float inv = rsqrtf(ss * (1.0f / D) + 1e-6f);
#pragma unroll
        for (int i = 0; i < 8; ++i) {
            const int c = (i * 64 + lane) * 4;
            const f32x4 g = *(const f32x4*)(gain + c);
            f32x4 y; y[0] = v[i][0] * inv * g[0]; y[1] = v[i][1] * inv * g[1]; y[2] = v[i][2] * inv * g[2]; y[3] = v[i][3] * inv * g[3];
            if (FINAL) { *(f32x4*)(out_f32 + (size_t)r * D + c) = y; }
            else {
                const f32x4 s1 = *(const f32x4*)(sc + c), s0 = *(const f32x4*)(sh + c);
                u32x2 o; o[0] = cvt_pk_bf16(y[0] * (1.0f + s1[0]) + s0[0], y[1] * (1.0f + s1[1]) + s0[1]); o[1] = cvt_pk_bf16(y[2] * (1.0f + s1[2]) + s0[2], y[3] * (1.0f + s1[3]) + s0[3]);
                *(u32x2*)(out_bf + (size_t)r * D + c) = o;
            }
        }
    }
}
struct SchedNoHooks {
    __device__ __forceinline__ void a_ready(const pg8::Unit&) const {}
    __device__ __forceinline__ void done(const pg8::Unit&) const {}
};
struct SchedDense2 : SchedNoHooks {
    const char* A1; const char* B1; const char* A2; const char* B2; int nM1, nN1, nM2, nN2, G, c; size_t tstep;
    __device__ __forceinline__ bool next(int i, pg8::Unit& u) const {
        int L = i * G + c; const int n1 = nM1 * nN1, n2 = nM2 * nN2;
        if (L >= n1 + n2) return false;
        if (L < n1) { pg8::static_tile(L, nM1, nN1, u.pm, u.pn); u.a = A1 + (size_t)u.pm * tstep; u.b = B1 + (size_t)u.pn * tstep; u.aux = 0; }
        else { L -= n1; pg8::static_tile(L, nM2, nN2, u.pm, u.pn); u.a = A2 + (size_t)u.pm * tstep; u.b = B2 + (size_t)u.pn * tstep; u.aux = 1; }
        return true;
    }
};
struct SchedMoe : SchedNoHooks {
    const char* A; const char* B; const LAS int* tile_e; int ntiles, npn, G, c; size_t tstep, estride;
    __device__ __forceinline__ bool next(int i, pg8::Unit& u) const {
        const int L = i * G + c;
        if (L >= ntiles * npn) return false;
        const int tile = L / npn, pn = L - tile * npn, e = __builtin_amdgcn_readfirstlane(tile_e[tile]);
        u.pm = tile; u.pn = pn; u.aux = e; u.a = A + (size_t)tile * tstep; u.b = B + (size_t)e * estride + (size_t)pn * tstep;
        return true;
    }
};

#define EPI_LOOP_ROWS _Pragma("unroll") for (int ai = 0; ai < 2; ++ai) _Pragma("unroll") for (int m = 0; m < 4; ++m)
#define EPI_LOOP_COLS _Pragma("unroll") for (int bj = 0; bj < 2; ++bj) _Pragma("unroll") for (int n = 0; n < 2; ++n)

struct EpiWin0 {
    static constexpr bool PERM = false, AFTER_DRAIN = false;
    bf16_t* q; bf16_t* kb; bf16_t* vt; bf16_t* y; float* xbr; float* gate;
    __device__ __forceinline__ void operator()(const f32x4 (&acc)[2][2][4][2], const pg8::Unit& u, int wr, int wc, int fr, int fq) const {
        const int row0 = u.pm * 256 + wr * 64 + fr, cl0 = wc * 32 + 4 * fq;
        if (u.aux == 1) {
            EPI_LOOP_ROWS { bf16_t* rowp = vt + (size_t)(row0 + ai * 128 + m * 16) * T + u.pn * 256 + cl0;
                EPI_LOOP_COLS { const f32x4 v = acc[ai][bj][m][n]; u32x2 o; o[0] = cvt_pk_bf16(v[0], v[1]); o[1] = cvt_pk_bf16(v[2], v[3]); *(u32x2*)(rowp + bj * 128 + n * 16) = o; } }
            return;
        }
        const int pn = u.pn;
        if (pn < 4) {
            EPI_LOOP_ROWS { bf16_t* rowp = q + (size_t)(row0 + ai * 128 + m * 16) * 1024 + pn * 256 + cl0;
                EPI_LOOP_COLS { const f32x4 v = acc[ai][bj][m][n] * 0.08838834764831845f; u32x2 o; o[0] = cvt_pk_bf16(v[0], v[1]); o[1] = cvt_pk_bf16(v[2], v[3]); *(u32x2*)(rowp + bj * 128 + n * 16) = o; } }
        } else if (pn < 8) {
            EPI_LOOP_ROWS {
                EPI_LOOP_COLS { bf16_t* dst = kb + ((size_t)((pn - 4) * 2 + bj) * TP + (row0 + ai * 128 + m * 16)) * 128 + cl0 + n * 16;
                    const f32x4 v = acc[ai][bj][m][n]; u32x2 o; o[0] = cvt_pk_bf16(v[0], v[1]); o[1] = cvt_pk_bf16(v[2], v[3]); *(u32x2*)dst = o; } }
        } else if (pn < 12) {
            EPI_LOOP_ROWS { bf16_t* rowp = y + (size_t)(row0 + ai * 128 + m * 16) * 1024 + (pn - 8) * 256 + cl0;
                EPI_LOOP_COLS { const f32x4 v = acc[ai][bj][m][n]; u32x2 o; o[0] = cvt_pk_bf16(geluf_(v[0]), geluf_(v[1])); o[1] = cvt_pk_bf16(geluf_(v[2]), geluf_(v[3])); *(u32x2*)(rowp + bj * 128 + n * 16) = o; } }
        } else if (pn < 16) {
            EPI_LOOP_ROWS { float* rowp = xbr + (size_t)(row0 + ai * 128 + m * 16) * 1024 + (pn - 12) * 256 + cl0;
                EPI_LOOP_COLS *(f32x4*)(rowp + bj * 128 + n * 16) = acc[ai][bj][m][n]; }
        } else {
            EPI_LOOP_ROWS { float* rowp = gate + (size_t)(row0 + ai * 128 + m * 16) * 24;
#pragma unroll
                for (int n = 0; n < 2; ++n) { const int c = cl0 + n * 16; if (c < 24) { const f32x4 v = acc[ai][0][m][n]; f32x4 o; o[0] = sigmoidf_(v[0]); o[1] = sigmoidf_(v[1]); o[2] = sigmoidf_(v[2]); o[3] = sigmoidf_(v[3]); *(f32x4*)(rowp + c) = o; } } }
        }
    }
};
struct EpiResid {
    static constexpr bool PERM = false, AFTER_DRAIN = false;
    const float* xin; const float* g; float* xout;
    __device__ __forceinline__ void operator()(const f32x4 (&acc)[2][2][4][2], const pg8::Unit& u, int wr, int wc, int fr, int fq) const {
        const int row0 = u.pm * 256 + wr * 64 + fr, col0 = u.pn * 256 + wc * 32 + 4 * fq;
        f32x4 gv[2][2];
        EPI_LOOP_COLS gv[bj][n] = *(const f32x4*)(g + col0 + bj * 128 + n * 16);
        EPI_LOOP_ROWS { const size_t ro = (size_t)(row0 + ai * 128 + m * 16) * D + col0;
            EPI_LOOP_COLS { const f32x4 xi = *(const f32x4*)(xin + ro + bj * 128 + n * 16); *(f32x4*)(xout + ro + bj * 128 + n * 16) = xi + gv[bj][n] * acc[ai][bj][m][n]; } }
    }
};
struct EpiLogit {
    static constexpr bool PERM = false, AFTER_DRAIN = false;
    float* logit;
    __device__ __forceinline__ void operator()(const f32x4 (&acc)[2][2][4][2], const pg8::Unit& u, int wr, int wc, int fr, int fq) const {
        const int row0 = u.pm * 256 + wr * 64 + fr, cl0 = wc * 32 + 4 * fq;
        EPI_LOOP_ROWS { float* rowp = logit + (size_t)(row0 + ai * 128 + m * 16) * LOGIT_LD;
#pragma unroll
            for (int n = 0; n < 2; ++n) { const int c = cl0 + n * 16; if (c < 72) *(f32x4*)(rowp + c) = acc[ai][0][m][n]; } }
    }
};
struct EpiMoe1 {
    static constexpr bool PERM = false, AFTER_DRAIN = false;
    bf16_t* hid;
    __device__ __forceinline__ void operator()(const f32x4 (&acc)[2][2][4][2], const pg8::Unit& u, int wr, int wc, int fr, int fq) const {
        const int row0 = u.pm * 256 + wr * 64 + fr, col0 = u.pn * 128 + wc * 32 + 4 * fq;
        EPI_LOOP_ROWS { bf16_t* rowp = hid + (size_t)(row0 + ai * 128 + m * 16) * 512 + col0;
#pragma unroll
            for (int n = 0; n < 2; ++n) { const f32x4 a = acc[ai][0][m][n], b = acc[ai][1][m][n];
                u32x2 o; o[0] = cvt_pk_bf16(siluf_(a[0]) * b[0], siluf_(a[1]) * b[1]); o[1] = cvt_pk_bf16(siluf_(a[2]) * b[2], siluf_(a[3]) * b[3]); *(u32x2*)(rowp + n * 16) = o; } }
    }
};
struct EpiBf16Plain {
    static constexpr bool PERM = false, AFTER_DRAIN = false;
    bf16_t* out; int ld;
    __device__ __forceinline__ void operator()(const f32x4 (&acc)[2][2][4][2], const pg8::Unit& u, int wr, int wc, int fr, int fq) const {
        const int row0 = u.pm * 256 + wr * 64 + fr, col0 = u.pn * 256 + wc * 32 + 4 * fq;
        EPI_LOOP_ROWS { bf16_t* rowp = out + (size_t)(row0 + ai * 128 + m * 16) * ld + col0;
            EPI_LOOP_COLS { const f32x4 v = acc[ai][bj][m][n]; u32x2 o; o[0] = cvt_pk_bf16(v[0], v[1]); o[1] = cvt_pk_bf16(v[2], v[3]); *(u32x2*)(rowp + bj * 128 + n * 16) = o; } }
    }
};
struct EpiWin1 {
    static constexpr bool PERM = false, AFTER_DRAIN = false;
    uchar* ws; const float* lbl;
    __device__ __forceinline__ void operator()(const f32x4 (&acc)[2][2][4][2], const pg8::Unit& u, int wr, int wc, int fr, int fq) const {
        const int row0 = u.pm * 256 + wr * 64 + fr, sec = u.pn >> 3, col0 = (u.pn & 7) * 256 + wc * 32 + 4 * fq;
        if (sec == 1) {
            float* logf = (float*)(ws + V_LOGF); bf16_t* kk = (bf16_t*)(ws + V_KK);
            EPI_LOOP_COLS { const int c = col0 + bj * 128 + n * 16; const f32x4 l0 = *(const f32x4*)(lbl + c), l1 = *(const f32x4*)(lbl + 2048 + c);
                f32x4 lb;
#pragma unroll
                for (int i = 0; i < 4; ++i) lb[i] = sigmoidf_(l1[i] - l0[i]);
                EPI_LOOP_ROWS { const size_t ro = (size_t)(row0 + ai * 128 + m * 16) * 2048 + c;
                    const f32x4 z = acc[ai][bj][m][n]; f32x4 lf; float kv[4];
#pragma unroll
                    for (int i = 0; i < 4; ++i) { const float l = lb[i], sg = sigmoidf_(z[i]); const float f = l + (1.0f - l) * sg; lf[i] = __logf(fmaxf(f, 1e-30f)); kv[i] = (1.0f - l) * (1.0f - sg); }
                    *(f32x4*)(logf + ro) = lf;
                    u32x2 o; o[0] = cvt_pk_bf16(kv[0], kv[1]); o[1] = cvt_pk_bf16(kv[2], kv[3]); *(u32x2*)(kk + ro) = o; } }
            return;
        }
        const size_t doff = sec == 0 ? V_QS : (sec == 2 ? V_V : V_GS);
        bf16_t* dst = (bf16_t*)(ws + doff);
        EPI_LOOP_ROWS { bf16_t* rowp = dst + (size_t)(row0 + ai * 128 + m * 16) * 2048 + col0;
            EPI_LOOP_COLS { f32x4 z = acc[ai][bj][m][n];
                if (sec != 2) { z[0] = siluf_(z[0]); z[1] = siluf_(z[1]); z[2] = siluf_(z[2]); z[3] = siluf_(z[3]); }
                u32x2 o; o[0] = cvt_pk_bf16(z[0], z[1]); o[1] = cvt_pk_bf16(z[2], z[3]); *(u32x2*)(rowp + bj * 128 + n * 16) = o; } }
    }
};
__device__ __forceinline__ void compress_unit(const Params& p, LAS uchar* lds, int u) {
    const int tid = tid_opaque(), lane = tid & 63, wave = tid >> 6, fr = lane & 15, fq = lane >> 4;
    const int kind = u >> 5, g = (u >> 4) & 1, mt = u & 15;
    uchar* ws = p.ws;
    const bf16_t* src = (const bf16_t*)(ws + U_KB) + (size_t)(kind * 2 + g) * TP * 128;
    const bf16_t* W1 = (const bf16_t*)(ws + WS_WC1T) + (size_t)kind * 128 * 4096;
    const bf16_t* W2 = (const bf16_t*)(ws + WS_WC2T) + (size_t)kind * 128 * 128;
    LAS float* slab = (LAS float*)lds;
    LAS bf16_t* hidl = (LAS bf16_t*)(lds + 131072);
    f32x4 acc[2][8];
#pragma unroll
    for (int m = 0; m < 2; ++m)
#pragma unroll
        for (int n = 0; n < 8; ++n) acc[m][n] = (f32x4){0.f, 0.f, 0.f, 0.f};
    const int kbeg = wave * 512;
    for (int ks = 0; ks < 16; ++ks) {
        const int k0 = kbeg + ks * 32 + 8 * fq;
        bf16x8 a[2], b[8];
#pragma unroll
        for (int m = 0; m < 2; ++m) a[m] = *(const bf16x8*)(src + (size_t)(mt * 32 + m * 16 + fr) * 2048 + k0);
#pragma unroll
        for (int n = 0; n < 8; ++n) b[n] = *(const bf16x8*)(W1 + (size_t)(n * 16 + fr) * 4096 + k0);
#pragma unroll
        for (int m = 0; m < 2; ++m)
#pragma unroll
            for (int n = 0; n < 8; ++n) acc[m][n] = __builtin_amdgcn_mfma_f32_16x16x32_bf16(a[m], b[n], acc[m][n], 0, 0, 0);
    }
#pragma unroll
    for (int m = 0; m < 2; ++m)
#pragma unroll
        for (int n = 0; n < 8; ++n)
#pragma unroll
            for (int j = 0; j < 4; ++j) slab[(wave * 32 + m * 16 + fq * 4 + j) * 128 + n * 16 + fr] = acc[m][n][j];
    __syncthreads();
    {
        const float* pebp = (const float*)(ws + WS_PEBP);
        for (int e = tid; e < 32 * 128; e += NTHREADS) {
            const int r = e >> 7, c = e & 127;
            float s = p.in[I_CB1][kind * 128 + c];
#pragma unroll
            for (int q = 0; q < 16; ++q) s += pebp[(q * 2 + kind) * 128 + c];
#pragma unroll
            for (int w = 0; w < 8; ++w) s += slab[(w * 32 + r) * 128 + c];
            hidl[r * 136 + c] = f2bf(geluf_(s));
        }
    }
    __syncthreads();
    {
        f32x4 o[2] = {(f32x4){0.f, 0.f, 0.f, 0.f}, (f32x4){0.f, 0.f, 0.f, 0.f}};
#pragma unroll
        for (int ks = 0; ks < 4; ++ks) {
            const bf16x8 b = *(const bf16x8*)(W2 + (size_t)(wave * 16 + fr) * 128 + ks * 32 + 8 * fq);
#pragma unroll
            for (int m = 0; m < 2; ++m) { const bf16x8 a = *(const LAS bf16x8*)(hidl + (m * 16 + fr) * 136 + ks * 32 + 8 * fq); o[m] = __builtin_amdgcn_mfma_f32_16x16x32_bf16(a, b, o[m], 0, 0, 0); }
        }
        const int col = wave * 16 + fr; const float b2 = p.in[I_CB2][kind * 128 + col];
#pragma unroll
        for (int m = 0; m < 2; ++m)
#pragma unroll
            for (int j = 0; j < 4; ++j) {
                const int n = mt * 32 + m * 16 + fq * 4 + j; const float v = (n < 511) ? o[m][j] + b2 : 0.f;
                if (kind == 0) ((bf16_t*)(ws + U_KCMP))[((size_t)g * 512 + n) * 128 + col] = f2bf(v);
                else ((bf16_t*)(ws + U_VCMPT))[((size_t)g * 128 + col) * 512 + n] = f2bf(v);
            }
    }
    __syncthreads();
}

__device__ __forceinline__ void lru_local_unit(const Params& p, LAS uchar* lds, int u) {
    const int tid = tid_opaque(), lane = tid & 63, wave = tid >> 6, fr = lane & 15, fq = lane >> 4;
    const int cc = u >> 3, nb = u & 7, t0 = cc * 64, ch0 = nb * 128;
    uchar* ws = p.ws;
    LAS float* xc = (LAS float*)lds;
    LAS bf16_t* xcb = (LAS bf16_t*)(lds + 32768);
    LAS float* la = (LAS float*)(lds + 50176);
    LAS float* bb = (LAS float*)(lds + 82944);
    LAS float* segh = (LAS float*)(lds + 115712);
    LAS float* segl = (LAS float*)(lds + 117760);
    const float* xbr = (const float*)(ws + U_XBR);
    {
        const int ch = tid & 127, r0 = tid >> 7;
        const float w0 = p.in[I_CONVW][0 * 1024 + ch0 + ch], w1 = p.in[I_CONVW][1 * 1024 + ch0 + ch], w2 = p.in[I_CONVW][2 * 1024 + ch0 + ch], w3 = p.in[I_CONVW][3 * 1024 + ch0 + ch];
        const float cb = p.in[I_CONVB][ch0 + ch];
        for (int r = r0; r < 64; r += 4) {
            const int t = t0 + r;
            const float x3 = xbr[(size_t)t * 1024 + ch0 + ch];
            const float x2 = t >= 1 ? xbr[(size_t)(t - 1) * 1024 + ch0 + ch] : 0.f;
            const float x1 = t >= 2 ? xbr[(size_t)(t - 2) * 1024 + ch0 + ch] : 0.f;
            const float x0 = t >= 3 ? xbr[(size_t)(t - 3) * 1024 + ch0 + ch] : 0.f;
            const float v = x0 * w0 + x1 * w1 + x2 * w2 + x3 * w3 + cb;
            xc[r * 128 + ch] = v; xcb[r * 136 + ch] = f2bf(v);
        }
    }
    __syncthreads();
    {
        const bf16_t* WA = (const bf16_t*)(ws + WS_WAT) + (size_t)nb * 16384, * WI = (const bf16_t*)(ws + WS_WIT) + (size_t)nb * 16384;
        f32x4 ra[4], ia[4];
#pragma unroll
        for (int m = 0; m < 4; ++m) { ra[m] = (f32x4){0.f, 0.f, 0.f, 0.f}; ia[m] = (f32x4){0.f, 0.f, 0.f, 0.f}; }
#pragma unroll
        for (int ks = 0; ks < 4; ++ks) {
            const bf16x8 ba = *(const bf16x8*)(WA + (size_t)(wave * 16 + fr) * 128 + ks * 32 + 8 * fq), bi = *(const bf16x8*)(WI + (size_t)(wave * 16 + fr) * 128 + ks * 32 + 8 * fq);
#pragma unroll
            for (int m = 0; m < 4; ++m) { const bf16x8 a = *(const LAS bf16x8*)(xcb + (m * 16 + fr) * 136 + ks * 32 + 8 * fq);
                ra[m] = __builtin_amdgcn_mfma_f32_16x16x32_bf16(a, ba, ra[m], 0, 0, 0); ia[m] = __builtin_amdgcn_mfma_f32_16x16x32_bf16(a, bi, ia[m], 0, 0, 0); }
        }
        const int e = wave * 16 + fr;
        const float bav = p.in[I_LBA][ch0 + e], biv = p.in[I_LBI][ch0 + e];
        const float sp = log1pf(__expf(-p.in[I_LAMBDA][ch0 + e]));
#pragma unroll
        for (int m = 0; m < 4; ++m)
#pragma unroll
            for (int j = 0; j < 4; ++j) {
                const int r = m * 16 + fq * 4 + j;
                const float rg = sigmoidf_(ra[m][j] + bav), ig = sigmoidf_(ia[m][j] + biv);
                const float lg = -8.0f * rg * sp;
                la[r * 128 + e] = lg;
                bb[r * 128 + e] = sqrtf(-expm1f(2.0f * lg)) * (ig * xc[r * 128 + e]);
            }
    }
    __syncthreads();
    {
        const int ch = tid & 127, sg = tid >> 7;
        float h = 0.f, cl = 0.f;
        for (int r = sg * 16; r < sg * 16 + 16; ++r) { const float lg = la[r * 128 + ch]; h = __expf(lg) * h + bb[r * 128 + ch]; cl += lg; bb[r * 128 + ch] = h; la[r * 128 + ch] = cl; }
        segh[sg * 128 + ch] = h; segl[sg * 128 + ch] = cl;
        __syncthreads();
        float carry = 0.f, lpre = 0.f;
        for (int s = 0; s < sg; ++s) { carry = segh[s * 128 + ch] + __expf(segl[s * 128 + ch]) * carry; lpre += segl[s * 128 + ch]; }
        float* hloc = (float*)(ws + U_HLOC); float* pc = (float*)(ws + U_PC);
        float hl = 0.f, pl = 0.f;
        for (int r = sg * 16; r < sg * 16 + 16; ++r) {
            const float pw = __expf(la[r * 128 + ch]);
            hl = bb[r * 128 + ch] + pw * carry; pl = pw * __expf(lpre);
            hloc[(size_t)(t0 + r) * 1024 + ch0 + ch] = hl; pc[(size_t)(t0 + r) * 1024 + ch0 + ch] = pl;
        }
        if (sg == 3) { ((float*)(ws + U_HEND))[cc * 1024 + ch0 + ch] = hl; ((float*)(ws + U_PEND))[cc * 1024 + ch0 + ch] = pl; }
    }
    __syncthreads();
}

__device__ __forceinline__ void lru_fix_unit(const Params& p, int cc) {
    const int tid = tid_opaque();
    uchar* ws = p.ws;
    const float* hend = (const float*)(ws + U_HEND); const float* pend = (const float*)(ws + U_PEND);
    const int ch = 2 * tid;
    float c0 = 0.f, c1 = 0.f;
    for (int c = 0; c < cc; ++c) {
        const float2 he = *(const float2*)(hend + c * 1024 + ch), pe = *(const float2*)(pend + c * 1024 + ch);
        c0 = he.x + pe.x * c0; c1 = he.y + pe.y * c1;
    }
    const float* hloc = (const float*)(ws + U_HLOC); const float* pc = (const float*)(ws + U_PC);
    const bf16_t* y = (const bf16_t*)(ws + U_Y); bf16_t* cat = (bf16_t*)(ws + U_CAT);
    for (int r = 0; r < 64; ++r) {
        const size_t t = (size_t)cc * 64 + r;
        const float2 h = *(const float2*)(hloc + t * 1024 + ch), pw = *(const float2*)(pc + t * 1024 + ch);
        const unsigned yy = *(const unsigned*)(y + t * 1024 + ch);
        *(unsigned*)(cat + t * 2048 + 1024 + ch) = cvt_pk_bf16(bf_lo(yy) * (h.x + pw.x * c0), bf_hi(yy) * (h.y + pw.y * c1));
    }
}
constexpr int A_K = 0;
constexpr int A_V = 16384;
constexpr int A_IMP = 33792;
constexpr int A_SEL = 66816;
constexpr int A_UNI = 67840;
constexpr int A_LUT = 67856;
constexpr int A_Q = 69968;
constexpr int A_END = 135504;
constexpr int IMP_LD = 129;

__device__ __forceinline__ void attn_load_k(LAS uchar* lds, const bf16_t* krow0, int tid) {
#pragma unroll
    for (int rep = 0; rep < 2; ++rep) {
        const int id = tid + NTHREADS * rep, row = id >> 4, ch = id & 15;
        const u32x4 v = *(const u32x4*)(krow0 + (size_t)row * 128 + ch * 8);
        *(LAS u32x4*)(lds + A_K + row * 256 + ((ch ^ (row & 15)) << 4)) = v;
    }
}
__device__ __forceinline__ void attn_load_vt(LAS uchar* lds, const bf16_t* v0, int ldv, int tid) {
#pragma unroll
    for (int rep = 0; rep < 2; ++rep) {
        const int id = tid + NTHREADS * rep, d = id >> 3, ch = id & 7;
        const u32x4 v = *(const u32x4*)(v0 + (size_t)d * ldv + ch * 8);
        LAS u32x2* q = (LAS u32x2*)(lds + A_V + d * 136 + ch * 16);
        q[0] = (u32x2){v[0], v[1]}; q[1] = (u32x2){v[2], v[3]};
    }
}
__device__ __forceinline__ void attn_qk(LAS uchar* lds, int qrow, f32x16 (&s)[2], int r, int hh) {
    s[0] = (f32x16){0.f, 0.f, 0.f, 0.f, 0.f, 0.f, 0.f, 0.f, 0.f, 0.f, 0.f, 0.f, 0.f, 0.f, 0.f, 0.f}; s[1] = s[0];
#pragma unroll
    for (int ks = 0; ks < 8; ++ks) {
        const bf16x8 qf = *(const LAS bf16x8*)(lds + A_Q + qrow * 256 + (((2 * ks + hh) ^ (qrow & 15)) << 4));
#pragma unroll
        for (int kt = 0; kt < 2; ++kt) {
            const int row = 32 * kt + r;
            const bf16x8 kf = *(const LAS bf16x8*)(lds + A_K + row * 256 + (((2 * ks + hh) ^ (row & 15)) << 4));
            s[kt] = __builtin_amdgcn_mfma_f32_32x32x16_bf16(kf, qf, s[kt], 0, 0, 0);
        }
    }
}
__device__ __forceinline__ void attn_pv(LAS uchar* lds, const f32x16 (&p)[2], f32x16 (&o)[4], int r, int hh) {
    bf16x8 pb[2][2];
#pragma unroll
    for (int kt = 0; kt < 2; ++kt)
#pragma unroll
        for (int sx = 0; sx < 2; ++sx) {
            u32x4 w;
#pragma unroll
            for (int q = 0; q < 4; ++q) w[q] = cvt_pk_bf16(p[kt][8 * sx + 2 * q], p[kt][8 * sx + 2 * q + 1]);
            pb[kt][sx] = __builtin_bit_cast(bf16x8, w);
        }
#pragma unroll
    for (int dt = 0; dt < 4; ++dt) {
        const LAS uchar* vrow = lds + A_V + (32 * dt + r) * 136;
#pragma unroll
        for (int kt = 0; kt < 2; ++kt)
#pragma unroll
            for (int sx = 0; sx < 2; ++sx) {
                const int col = 32 * kt + 16 * sx + 4 * hh;
                const u32x2 lo = *(const LAS u32x2*)(vrow + col * 2), hi = *(const LAS u32x2*)(vrow + (col + 8) * 2);
                const u32x4 w = {lo[0], lo[1], hi[0], hi[1]};
                o[dt] = __builtin_amdgcn_mfma_f32_32x32x16_bf16(__builtin_bit_cast(bf16x8, w), pb[kt][sx], o[dt], 0, 0, 0);
            }
    }
}
__device__ __forceinline__ void attn_online(f32x16 (&s)[2], f32x16 (&o)[4], float& m, float& l) {
    float mx = -INFINITY;
#pragma unroll
    for (int kt = 0; kt < 2; ++kt)
#pragma unroll
        for (int i = 0; i < 16; ++i) mx = fmaxf(mx, s[kt][i]);
    mx = fmaxf(mx, __shfl_xor(mx, 32));
    const float mn = fmaxf(m, mx), mu = (mn == -INFINITY) ? 0.f : mn;
    const float alpha = __expf(m - mu);
    float sum = 0.f;
#pragma unroll
    for (int kt = 0; kt < 2; ++kt)
#pragma unroll
        for (int i = 0; i < 16; ++i) { const float e = __expf(s[kt][i] - mu); s[kt][i] = e; sum += e; }
    l = l * alpha + sum; m = mn;
#pragma unroll
    for (int dt = 0; dt < 4; ++dt) o[dt] *= alpha;
}

__device__ __forceinline__ void attn_unit(const Params& p, LAS uchar* lds, int g, int c) {
    const int tid = tid_opaque(), lane = tid & 63, wave = tid >> 6, r = lane & 31, hh = lane >> 5;
    const int hl = wave & 3, th = wave >> 2, tl = 32 * th + r, t0 = c * 64, t = t0 + tl, head = g * 4 + hl;
    uchar* ws = p.ws;
    LAS unsigned* imp = (LAS unsigned*)(lds + A_IMP); LAS unsigned* sel = (LAS unsigned*)(lds + A_SEL); LAS unsigned* uni = (LAS unsigned*)(lds + A_UNI);
    LAS float* lut = (LAS float*)(lds + A_LUT);
    for (int i = tid; i < 4 * 129; i += NTHREADS) { const int h = i / 129, rel = i % 129; lut[h * 132 + rel] = p.in[I_RELB][(rel >= 128 ? 31 : t5_bucket(rel)) * 8 + g * 4 + h]; }
    for (int i = tid; i < 64 * IMP_LD; i += NTHREADS) imp[i] = 0u;
    if (tid < 4) uni[tid] = 0u;
    {
        const bf16_t* qg = (const bf16_t*)(ws + U_Q);
#pragma unroll
        for (int rep = 0; rep < 8; ++rep) {
            const int id = tid + NTHREADS * rep, row = id >> 4, ch = id & 15;
            const u32x4 v = *(const u32x4*)(qg + (size_t)(t0 + (row & 63)) * 1024 + (g * 4 + (row >> 6)) * 128 + ch * 8);
            *(LAS u32x4*)(lds + A_Q + row * 256 + ((ch ^ (row & 15)) << 4)) = v;
        }
    }
    const int qrow = hl * 64 + tl;
    const float* gp = (const float*)(ws + U_GATE) + (size_t)t * 24 + head * 3;
    const float g_cmp = gp[0], g_slc = gp[1], g_win = gp[2];
    const LAS float* mylut = lut + hl * 132;
    const float b31 = p.in[I_RELB][31 * 8 + head];
    f32x16 o[4];
#pragma unroll
    for (int dt = 0; dt < 4; ++dt) o[dt] = (f32x16){0.f, 0.f, 0.f, 0.f, 0.f, 0.f, 0.f, 0.f, 0.f, 0.f, 0.f, 0.f, 0.f, 0.f, 0.f, 0.f};
    f32x4* park = (f32x4*)((float*)(ws + WS_PARK) + ((size_t)blockIdx.x * NTHREADS + tid) * 64);
    __syncthreads();

    const bf16_t* kcmp = (const bf16_t*)(ws + U_KCMP) + (size_t)g * 512 * 128;
    const bf16_t* vcmpt = (const bf16_t*)(ws + U_VCMPT) + (size_t)g * 128 * 512;
    const int ntc = (4 * c + 2) / 64 + 1;
    float m = -INFINITY, l = 0.f;
    for (int nt = 0; nt < ntc; ++nt) {
        attn_load_k(lds, kcmp + (size_t)nt * 64 * 128, tid);
        __syncthreads();
        f32x16 s[2]; attn_qk(lds, qrow, s, r, hh);
        float mx = -INFINITY;
#pragma unroll
        for (int kt = 0; kt < 2; ++kt)
#pragma unroll
            for (int i = 0; i < 16; ++i) {
                const int n = nt * 64 + 32 * kt + (i & 3) + 8 * (i >> 2) + 4 * hh, rel = t - (16 * n + 31);
                const float bv = mylut[min(max(rel, 0), 128)]; const float v = rel >= 0 ? s[kt][i] + bv : -INFINITY;
                s[kt][i] = v; mx = fmaxf(mx, v);
            }
        mx = fmaxf(mx, __shfl_xor(mx, 32));
        const float mn = fmaxf(m, mx), mu = (mn == -INFINITY) ? 0.f : mn;
        float sum = 0.f;
#pragma unroll
        for (int kt = 0; kt < 2; ++kt)
#pragma unroll
            for (int i = 0; i < 16; ++i) sum += __expf(s[kt][i] - mu);
        l = l * __expf(m - mu) + sum; m = mn;
        __syncthreads();
    }
    {
        const float lt = l + __shfl_xor(l, 32);
        const float inv = lt > 0.f ? 1.0f / lt : 0.f, mu = (m == -INFINITY) ? 0.f : m;
        for (int nt = 0; nt < ntc; ++nt) {
            attn_load_k(lds, kcmp + (size_t)nt * 64 * 128, tid);
            attn_load_vt(lds, vcmpt + nt * 64, 512, tid);
            __syncthreads();
            f32x16 s[2]; attn_qk(lds, qrow, s, r, hh);
#pragma unroll
            for (int kt = 0; kt < 2; ++kt) {
#pragma unroll
                for (int i = 0; i < 16; ++i) {
                    const int n = nt * 64 + 32 * kt + (i & 3) + 8 * (i >> 2) + 4 * hh, rel = t - (16 * n + 31);
                    const float bv = mylut[min(max(rel, 0), 128)]; s[kt][i] = rel >= 0 ? __expf(s[kt][i] + bv - mu) * inv : 0.f;
                }
#pragma unroll
                for (int c4 = 0; c4 < 4; ++c4) {
                    const int j = nt * 16 + 8 * kt + 2 * c4 + hh;
                    const float s4 = s[kt][4 * c4] + s[kt][4 * c4 + 1] + s[kt][4 * c4 + 2] + s[kt][4 * c4 + 3];
                    const unsigned q4 = (unsigned)(s4 * 67108864.f + 0.5f), q3 = (unsigned)(s[kt][4 * c4 + 3] * 67108864.f + 0.5f);
                    (void)__hip_atomic_fetch_add(imp + tl * IMP_LD + j, q4, __ATOMIC_RELAXED, __HIP_MEMORY_SCOPE_WORKGROUP);
                    (void)__hip_atomic_fetch_add(imp + tl * IMP_LD + (j + 1 < 128 ? j + 1 : 128), q3, __ATOMIC_RELAXED, __HIP_MEMORY_SCOPE_WORKGROUP);
                }
#pragma unroll
                for (int i = 0; i < 16; ++i) s[kt][i] *= g_cmp;
            }
            attn_pv(lds, s, o, r, hh);
            __syncthreads();
        }
#pragma unroll
        for (int dt = 0; dt < 4; ++dt)
#pragma unroll
            for (int c4 = 0; c4 < 4; ++c4) park[dt * 4 + c4] = (f32x4){o[dt][4 * c4], o[dt][4 * c4 + 1], o[dt][4 * c4 + 2], o[dt][4 * c4 + 3]};
    }
    __syncthreads();
    {
        unsigned long long u0 = 0ull, u1 = 0ull;
        for (int tq = 0; tq < 8; ++tq) {
            const int tok = 8 * wave + tq;
            const LAS unsigned* row = imp + tok * IMP_LD;
            unsigned long long b0, b1;
            if (c <= 15) { b0 = (2ull << c) - 1ull; b1 = 0ull; }
            else {
                const int v0 = lane < c ? (int)row[lane] : -1, v1 = (lane + 64 < c) ? (int)row[lane + 64] : -1;
                int c0 = 0, c1 = 0;
                for (int j = 0; j < c; ++j) { const int vj = (int)row[j]; c0 += (vj > v0 || (vj == v0 && j < lane)) ? 1 : 0; c1 += (vj > v1 || (vj == v1 && j < lane + 64)) ? 1 : 0; }
                b0 = __ballot(lane < c && c0 < 15); b1 = __ballot(lane + 64 < c && c1 < 15);
                if (c < 64) b0 |= 1ull << c; else b1 |= 1ull << (c - 64);
            }
            if (lane == 0) { sel[tok * 4 + 0] = (unsigned)b0; sel[tok * 4 + 1] = (unsigned)(b0 >> 32); sel[tok * 4 + 2] = (unsigned)b1; sel[tok * 4 + 3] = (unsigned)(b1 >> 32); }
            u0 |= b0; u1 |= b1;
        }
        if (lane == 0) { (void)__hip_atomic_fetch_or(uni + 0, (unsigned)u0, __ATOMIC_RELAXED, __HIP_MEMORY_SCOPE_WORKGROUP); (void)__hip_atomic_fetch_or(uni + 1, (unsigned)(u0 >> 32), __ATOMIC_RELAXED, __HIP_MEMORY_SCOPE_WORKGROUP); (void)__hip_atomic_fetch_or(uni + 2, (unsigned)u1, __ATOMIC_RELAXED, __HIP_MEMORY_SCOPE_WORKGROUP); (void)__hip_atomic_fetch_or(uni + 3, (unsigned)(u1 >> 32), __ATOMIC_RELAXED, __HIP_MEMORY_SCOPE_WORKGROUP); }
    }
    __syncthreads();
    {
        const unsigned sm0 = sel[tl * 4 + 0], sm1 = sel[tl * 4 + 1], sm2 = sel[tl * 4 + 2], sm3 = sel[tl * 4 + 3];
        const unsigned un0 = uni[0], un1 = uni[1], un2 = uni[2], un3 = uni[3];
        const bf16_t* kslc = (const bf16_t*)(ws + U_KB) + (size_t)(2 * 2 + g) * TP * 128;
        const bf16_t* vslc = (const bf16_t*)(ws + U_VT) + (size_t)(0 * 2 + g) * 128 * T;
#pragma unroll
        for (int dt = 0; dt < 4; ++dt) o[dt] = (f32x16){0.f, 0.f, 0.f, 0.f, 0.f, 0.f, 0.f, 0.f, 0.f, 0.f, 0.f, 0.f, 0.f, 0.f, 0.f, 0.f};
        m = -INFINITY; l = 0.f;
        for (int j = 0; j <= c; ++j) {
            const unsigned uw = (j < 32) ? un0 : (j < 64) ? un1 : (j < 96) ? un2 : un3;
            if (!((uw >> (j & 31)) & 1u)) continue;
            attn_load_k(lds, kslc + (size_t)j * 64 * 128, tid);
            attn_load_vt(lds, vslc + j * 64, T, tid);
            __syncthreads();
            f32x16 s[2]; attn_qk(lds, qrow, s, r, hh);
            const unsigned mw = (j < 32) ? sm0 : (j < 64) ? sm1 : (j < 96) ? sm2 : sm3;
            const bool mine = (mw >> (j & 31)) & 1u;
            if (c - j >= 3) {
#pragma unroll
                for (int kt = 0; kt < 2; ++kt)
#pragma unroll
                    for (int i = 0; i < 16; ++i) s[kt][i] = mine ? s[kt][i] + b31 : -INFINITY;
            } else {
#pragma unroll
                for (int kt = 0; kt < 2; ++kt)
#pragma unroll
                    for (int i = 0; i < 16; ++i) {
                        const int key = j * 64 + 32 * kt + (i & 3) + 8 * (i >> 2) + 4 * hh, rel = t - key;
                        const float bv = mylut[min(max(rel, 0), 128)]; s[kt][i] = (mine && rel >= 0) ? s[kt][i] + bv : -INFINITY;
                    }
            }
            attn_online(s, o, m, l);
            attn_pv(lds, s, o, r, hh);
            __syncthreads();
        }
        const float lt = l + __shfl_xor(l, 32), sc = lt > 0.f ? g_slc / lt : 0.f;
#pragma unroll
        for (int dt = 0; dt < 4; ++dt)
#pragma unroll
            for (int c4 = 0; c4 < 4; ++c4) { const f32x4 pv = park[dt * 4 + c4]; park[dt * 4 + c4] = (f32x4){pv[0] + o[dt][4 * c4] * sc, pv[1] + o[dt][4 * c4 + 1] * sc, pv[2] + o[dt][4 * c4 + 2] * sc, pv[3] + o[dt][4 * c4 + 3] * sc}; }
        const bf16_t* kwin = (const bf16_t*)(ws + U_KB) + (size_t)(3 * 2 + g) * TP * 128;
        const bf16_t* vwin = (const bf16_t*)(ws + U_VT) + (size_t)(1 * 2 + g) * 128 * T;
#pragma unroll
        for (int dt = 0; dt < 4; ++dt) o[dt] = (f32x16){0.f, 0.f, 0.f, 0.f, 0.f, 0.f, 0.f, 0.f, 0.f, 0.f, 0.f, 0.f, 0.f, 0.f, 0.f, 0.f};
        m = -INFINITY; l = 0.f;
        for (int j = (c >= 8 ? c - 8 : 0); j <= c; ++j) {
            attn_load_k(lds, kwin + (size_t)j * 64 * 128, tid);
            attn_load_vt(lds, vwin + j * 64, T, tid);
            __syncthreads();
            f32x16 s[2]; attn_qk(lds, qrow, s, r, hh);
#pragma unroll
            for (int kt = 0; kt < 2; ++kt)
#pragma unroll
                for (int i = 0; i < 16; ++i) {
                    const int key = j * 64 + 32 * kt + (i & 3) + 8 * (i >> 2) + 4 * hh, rel = t - key;
                    const float bv = mylut[min(max(rel, 0), 128)]; s[kt][i] = (rel >= 0 && rel < 512) ? s[kt][i] + bv : -INFINITY;
                }
            attn_online(s, o, m, l);
            attn_pv(lds, s, o, r, hh);
            __syncthreads();
        }
        const float lt2 = l + __shfl_xor(l, 32), sc2 = lt2 > 0.f ? g_win / lt2 : 0.f;
#pragma unroll
        for (int dt = 0; dt < 4; ++dt)
#pragma unroll
            for (int c4 = 0; c4 < 4; ++c4) { const f32x4 pv = park[dt * 4 + c4];
#pragma unroll
                for (int q = 0; q < 4; ++q) o[dt][4 * c4 + q] = pv[q] + o[dt][4 * c4 + q] * sc2; }
    }
    {
        bf16_t* op = (bf16_t*)(ws + U_CAT) + (size_t)t * 2048 + head * 128 + 4 * hh;
#pragma unroll
        for (int dt = 0; dt < 4; ++dt)
#pragma unroll
            for (int c4 = 0; c4 < 4; ++c4) {
                u32x2 w; w[0] = cvt_pk_bf16(o[dt][4 * c4], o[dt][4 * c4 + 1]); w[1] = cvt_pk_bf16(o[dt][4 * c4 + 2], o[dt][4 * c4 + 3]);
                *(u32x2*)(op + 32 * dt + 8 * c4) = w;
            }
    }
    __syncthreads();
}
constexpr int H_BC = 0;
constexpr int H_QT = 32768;
constexpr int H_KT = 50176;
constexpr int H_VT = 93696;
constexpr int H_KH = 112128;
constexpr int H_ATT = 130560;
constexpr int H_SEG = 139776;
constexpr int H_END = 141824;
__device__ __forceinline__ int kt_row0(int i) { return i == 0 ? 0 : (i == 1 ? 16 : (i == 2 ? 48 : 96)); }

__device__ __forceinline__ void hgrn_local_unit(const Params& p, LAS uchar* lds, int u) {
    const int tid = tid_opaque(), lane = tid & 63, wave = tid >> 6, fr = lane & 15, fq = lane >> 4;
    const int h = u & 15, c = u >> 4, t0 = c * 64, col0 = h * 128;
    uchar* ws = p.ws;
    LAS float* bc = (LAS float*)(lds + H_BC); LAS bf16_t* qt = (LAS bf16_t*)(lds + H_QT); LAS bf16_t* kt = (LAS bf16_t*)(lds + H_KT);
    LAS bf16_t* vt = (LAS bf16_t*)(lds + H_VT); LAS bf16_t* kh = (LAS bf16_t*)(lds + H_KH); LAS bf16_t* att = (LAS bf16_t*)(lds + H_ATT); LAS float* seg = (LAS float*)(lds + H_SEG);
    {
        const int d = tid & 127, sg = tid >> 7;
        const float* lf = (const float*)(ws + V_LOGF) + (size_t)(t0 + sg * 16) * 2048 + col0 + d;
        float v[16];
#pragma unroll
        for (int r = 0; r < 16; ++r) v[r] = lf[(size_t)r * 2048];
        float a = 0.f;
#pragma unroll
        for (int r = 0; r < 16; ++r) { a += v[r]; v[r] = a; }
        seg[sg * 128 + d] = a;
        __syncthreads();
        float off = 0.f;
        for (int s = 0; s < sg; ++s) off += seg[s * 128 + d];
#pragma unroll
        for (int r = 0; r < 16; ++r) bc[(sg * 16 + r) * 128 + d] = v[r] + off;
        for (int i = tid; i < 64 * 72 / 2; i += NTHREADS) ((LAS unsigned*)att)[i] = 0u;
    }
    __syncthreads();
    {
#pragma unroll
        for (int rep = 0; rep < 2; ++rep) {
            const int id = tid + NTHREADS * rep, row = id >> 4, ch = id & 15, d0 = ch * 8, si = row >> 4;
            const size_t go = (size_t)(t0 + row) * 2048 + col0 + d0;
            const u32x4 qv = *(const u32x4*)((const bf16_t*)(ws + V_QS) + go), kv = *(const u32x4*)((const bf16_t*)(ws + V_KK) + go), vv = *(const u32x4*)((const bf16_t*)(ws + V_V) + go);
            float qf[8], kf[8], bcv[8], bref[8], bl[8];
#pragma unroll
            for (int q = 0; q < 4; ++q) { qf[2 * q] = bf_lo(qv[q]); qf[2 * q + 1] = bf_hi(qv[q]); kf[2 * q] = bf_lo(kv[q]); kf[2 * q + 1] = bf_hi(kv[q]); }
#pragma unroll
            for (int q = 0; q < 8; ++q) { bcv[q] = bc[row * 128 + d0 + q]; bref[q] = si > 0 ? bc[(16 * si - 1) * 128 + d0 + q] : 0.f; bl[q] = bc[63 * 128 + d0 + q]; }
            u32x4 w;
#pragma unroll
            for (int q = 0; q < 4; ++q) w[q] = cvt_pk_bf16(qf[2 * q] * __expf(bcv[2 * q] - bref[2 * q]), qf[2 * q + 1] * __expf(bcv[2 * q + 1] - bref[2 * q + 1]));
            *(LAS u32x4*)(qt + row * 136 + d0) = w;
#pragma unroll
            for (int q = 0; q < 4; ++q) w[q] = cvt_pk_bf16(qf[2 * q] * __expf(bcv[2 * q]), qf[2 * q + 1] * __expf(bcv[2 * q + 1]));
            *(u32x4*)((bf16_t*)(ws + V_QHAT) + go) = w;
#pragma unroll
            for (int i = 0; i < 4; ++i) {
                if (i >= si) {
                    float br[8];
#pragma unroll
                    for (int q = 0; q < 8; ++q) br[q] = i > 0 ? bc[(16 * i - 1) * 128 + d0 + q] : 0.f;
#pragma unroll
                    for (int q = 0; q < 4; ++q) w[q] = cvt_pk_bf16(kf[2 * q] * __expf(fminf(br[2 * q] - bcv[2 * q], 80.f)), kf[2 * q + 1] * __expf(fminf(br[2 * q + 1] - bcv[2 * q + 1], 80.f)));
                    *(LAS u32x4*)(kt + (kt_row0(i) + row) * 136 + d0) = w;
                }
            }
#pragma unroll
            for (int q = 0; q < 8; ++q) {
                kh[(d0 + q) * 72 + row] = f2bf(kf[q] * __expf(bl[q] - bcv[q]));
                vt[(d0 + q) * 72 + row] = (bf16_t)((q & 1) ? (vv[q >> 1] >> 16) : (vv[q >> 1] & 0xffffu));
            }
        }
        if (tid < 128) ((float*)(ws + V_DEC))[((size_t)c * 16 + h) * 128 + tid] = __expf(bc[63 * 128 + tid]);
    }
    __syncthreads();
    {
        for (int tix = wave; tix < 10; tix += 8) {
            int i = 0, j = tix;
            if (tix >= 6) { i = 3; j = tix - 6; } else if (tix >= 3) { i = 2; j = tix - 3; } else if (tix >= 1) { i = 1; j = tix - 1; }
            f32x4 a = {0.f, 0.f, 0.f, 0.f};
#pragma unroll
            for (int ks = 0; ks < 4; ++ks) {
                const bf16x8 af = *(const LAS bf16x8*)(qt + (16 * i + fr) * 136 + ks * 32 + 8 * fq);
                const bf16x8 bf = *(const LAS bf16x8*)(kt + (kt_row0(i) + 16 * j + fr) * 136 + ks * 32 + 8 * fq);
                a = __builtin_amdgcn_mfma_f32_16x16x32_bf16(af, bf, a, 0, 0, 0);
            }
#pragma unroll
            for (int q = 0; q < 4; ++q) {
                const int tq = fq * 4 + q;
                const float v = (j < i || fr <= tq) ? a[q] : 0.f;
                att[(16 * i + tq) * 72 + 16 * j + fr] = f2bf(v);
            }
        }
    }
    __syncthreads();
    {
        f32x4 oi[4];
#pragma unroll
        for (int m = 0; m < 4; ++m) oi[m] = (f32x4){0.f, 0.f, 0.f, 0.f};
#pragma unroll
        for (int ks = 0; ks < 2; ++ks) {
            const bf16x8 bv = *(const LAS bf16x8*)(vt + (wave * 16 + fr) * 72 + ks * 32 + 8 * fq);
#pragma unroll
            for (int m = 0; m < 4; ++m) { const bf16x8 af = *(const LAS bf16x8*)(att + (m * 16 + fr) * 72 + ks * 32 + 8 * fq); oi[m] = __builtin_amdgcn_mfma_f32_16x16x32_bf16(af, bv, oi[m], 0, 0, 0); }
        }
        float* oint = (float*)(ws + V_OINTRA);
#pragma unroll
        for (int m = 0; m < 4; ++m)
#pragma unroll
            for (int q = 0; q < 4; ++q) oint[(size_t)(t0 + m * 16 + fq * 4 + q) * 2048 + col0 + wave * 16 + fr] = oi[m][q];
        f32x4 kvv[8];
#pragma unroll
        for (int n = 0; n < 8; ++n) kvv[n] = (f32x4){0.f, 0.f, 0.f, 0.f};
#pragma unroll
        for (int ks = 0; ks < 2; ++ks) {
            const bf16x8 af = *(const LAS bf16x8*)(vt + (wave * 16 + fr) * 72 + ks * 32 + 8 * fq);
#pragma unroll
            for (int n = 0; n < 8; ++n) { const bf16x8 bf = *(const LAS bf16x8*)(kh + (n * 16 + fr) * 72 + ks * 32 + 8 * fq); kvv[n] = __builtin_amdgcn_mfma_f32_16x16x32_bf16(af, bf, kvv[n], 0, 0, 0); }
        }
        float* st = (float*)(ws + V_ST) + ((size_t)c * 16 + h) * 16384;
#pragma unroll
        for (int n = 0; n < 8; ++n)
#pragma unroll
            for (int q = 0; q < 4; ++q) st[(wave * 16 + fq * 4 + q) * 128 + n * 16 + fr] = kvv[n][q];
    }
    __syncthreads();
}

__device__ __forceinline__ void hgrn_scan(const Params& p) {
    uchar* ws = p.ws;
    const int gt = blockIdx.x * NTHREADS + tid_opaque(), nthr = gridDim.x * NTHREADS;
    for (int idx = gt; idx < 16 * 128 * 64; idx += nthr) {
        const int h = idx >> 13, e = (idx >> 6) & 127, d = (idx & 63) * 2;
        float* st = (float*)(ws + V_ST) + (size_t)h * 16384 + e * 128 + d;
        const float* dec = (const float*)(ws + V_DEC) + h * 128 + d;
        float s0 = 0.f, s1 = 0.f;
#pragma unroll 8
        for (int c = 0; c < 128; ++c) {
            const float2 kv = *(const float2*)(st + (size_t)c * 16 * 16384), dc = *(const float2*)(dec + (size_t)c * 16 * 128);
            *(float2*)(st + (size_t)c * 16 * 16384) = make_float2(s0, s1);
            s0 = dc.x * s0 + kv.x; s1 = dc.y * s1 + kv.y;
        }
    }
}

__device__ __forceinline__ void hgrn_out_unit(const Params& p, LAS uchar* lds, int u) {
    const int tid = tid_opaque(), lane = tid & 63, wave = tid >> 6, fr = lane & 15, fq = lane >> 4;
    const int h = u & 15, c = u >> 4, t0 = c * 64, col0 = h * 128;
    uchar* ws = p.ws;
    LAS float* ssq = (LAS float*)lds;
    const bf16_t* qh = (const bf16_t*)(ws + V_QHAT);
    const float* st = (const float*)(ws + V_ST) + ((size_t)c * 16 + h) * 16384;
    f32x4 o[4];
#pragma unroll
    for (int m = 0; m < 4; ++m) o[m] = (f32x4){0.f, 0.f, 0.f, 0.f};
#pragma unroll
    for (int ks = 0; ks < 4; ++ks) {
        const float* sp = st + (wave * 16 + fr) * 128 + ks * 32 + 8 * fq;
        const f32x4 s0 = *(const f32x4*)sp, s1 = *(const f32x4*)(sp + 4);
        u32x4 w; w[0] = cvt_pk_bf16(s0[0], s0[1]); w[1] = cvt_pk_bf16(s0[2], s0[3]); w[2] = cvt_pk_bf16(s1[0], s1[1]); w[3] = cvt_pk_bf16(s1[2], s1[3]);
        const bf16x8 bf = __builtin_bit_cast(bf16x8, w);
#pragma unroll
        for (int m = 0; m < 4; ++m) { const bf16x8 af = *(const bf16x8*)(qh + (size_t)(t0 + m * 16 + fr) * 2048 + col0 + ks * 32 + 8 * fq); o[m] = __builtin_amdgcn_mfma_f32_16x16x32_bf16(af, bf, o[m], 0, 0, 0); }
    }
    const float* oint = (const float*)(ws + V_OINTRA);
    const int e = wave * 16 + fr;
#pragma unroll
    for (int m = 0; m < 4; ++m)
#pragma unroll
        for (int q = 0; q < 4; ++q) {
            const int row = m * 16 + fq * 4 + q;
            o[m][q] += oint[(size_t)(t0 + row) * 2048 + col0 + e];
            float s = o[m][q] * o[m][q];
            s += __shfl_xor(s, 1); s += __shfl_xor(s, 2); s += __shfl_xor(s, 4); s += __shfl_xor(s, 8);
            if (fr == 0) ssq[wave * 64 + row] = s;
        }
    __syncthreads();
    const float ng = p.in[I_HNG][col0 + e];
    const bf16_t* gs = (const bf16_t*)(ws + V_GS); bf16_t* out = (bf16_t*)(ws + V_HGO);
#pragma unroll
    for (int m = 0; m < 4; ++m)
#pragma unroll
        for (int q = 0; q < 4; ++q) {
            const int row = m * 16 + fq * 4 + q;
            float tot = 0.f;
#pragma unroll
            for (int w = 0; w < 8; ++w) tot += ssq[w * 64 + row];
            const float inv = rsqrtf(tot * (1.0f / 128.0f) + 1e-6f);
            const size_t go = (size_t)(t0 + row) * 2048 + col0 + e;
            out[go] = f2bf(o[m][q] * inv * ng * bf2f(gs[go]));
        }
    __syncthreads();
}
__device__ __forceinline__ void moe_route(const Params& p, int layer) {
    uchar* ws = p.ws;
    const float* logit = (const float*)(ws + WS_LOGIT);
    const float* bg = p.in[I_MBGRP] + layer * 8; const float* be = p.in[I_MBEXP] + layer * 64;
    unsigned* cnt = (unsigned*)(ws + WS_CTL + CTL_CNT_OFF) + layer * 64;
    int* toke = (int*)(ws + WS_TOKE); int* tokpos = (int*)(ws + WS_TOKPOS); float* tokw = (float*)(ws + WS_TOKW);
    for (int t = blockIdx.x * NTHREADS + tid_opaque(); t < T; t += gridDim.x * NTHREADS) {
        const float* lr = logit + (size_t)t * LOGIT_LD;
        float gl[8]; float gm = -INFINITY; int grp = 0;
#pragma unroll
        for (int i = 0; i < 8; ++i) { gl[i] = lr[i] + bg[i]; if (gl[i] > gm) { gm = gl[i]; grp = i; } }
        float den = 0.f;
#pragma unroll
        for (int i = 0; i < 8; ++i) den += __expf(gl[i] - gm);
        const float pg = 1.0f / den;
        float v0 = -INFINITY, v1 = -INFINITY; int i0 = 0, i1 = 0;
#pragma unroll
        for (int i = 0; i < 8; ++i) {
            const float v = lr[8 + grp * 8 + i] + be[grp * 8 + i];
            if (v > v0) { v1 = v0; i1 = i0; v0 = v; i0 = i; } else if (v > v1) { v1 = v; i1 = i; }
        }
        const float e0 = 1.0f / (1.0f + __expf(v1 - v0));
        const int ea = grp * 8 + i0, eb = grp * 8 + i1;
        const int pa = (int)atomicAdd(cnt + ea, 1u), pb = (int)atomicAdd(cnt + eb, 1u);
        toke[2 * t] = ea; toke[2 * t + 1] = eb; tokpos[2 * t] = pa; tokpos[2 * t + 1] = pb; tokw[2 * t] = pg * e0; tokw[2 * t + 1] = pg * (1.0f - e0);
    }
}
__device__ __forceinline__ int moe_tiles(const Params& p, int layer, LAS int* tab  , bool publish) {
    uchar* ws = p.ws;
    const unsigned* cnt = (const unsigned*)(ws + WS_CTL + CTL_CNT_OFF) + layer * 64;
    const int tid = tid_opaque();
    if (tid == 0) {
        int nt = 0;
        for (int e = 0; e < 64; ++e) { const int n = ((int)cnt[e] + 255) >> 8; tab[128 + e] = nt; for (int q = 0; q < n; ++q) tab[nt + q] = e; nt += n; }
        tab[192] = nt;
    }
    __syncthreads();
    const int nt = tab[192];
    if (publish && blockIdx.x == 0) { int* g = (int*)(ws + WS_TILEE); for (int i = tid; i < nt; i += NTHREADS) g[i] = tab[i]; if (tid == 0) g[128] = nt; }
    return nt;
}
__device__ __forceinline__ void moe_gather(const Params& p, LAS uchar* lds, int layer) {
    uchar* ws = p.ws;
    LAS int* tab = (LAS int*)lds;
    moe_tiles(p, layer, tab, true);
    const int tid = tid_opaque(), lane = tid & 63, wave = tid >> 6;
    const int* toke = (const int*)(ws + WS_TOKE); const int* tokpos = (const int*)(ws + WS_TOKPOS); int* tokrow = (int*)(ws + WS_TOKROW);
    const bf16_t* h = (const bf16_t*)(ws + WS_HMIX); bf16_t* xg = (bf16_t*)(ws + WS_XG);
    for (int a = blockIdx.x * NWAVES + wave; a < 2 * T; a += gridDim.x * NWAVES) {
        const int e = toke[a], row = tab[128 + e] * 256 + tokpos[a], t = a >> 1;
        if (lane == 0) tokrow[a] = row;
        const u32x4* src = (const u32x4*)(h + (size_t)t * D); u32x4* dst = (u32x4*)(xg + (size_t)row * D);
#pragma unroll
        for (int i = 0; i < 4; ++i) dst[i * 64 + lane] = src[i * 64 + lane];
    }
    __syncthreads();
}
constexpr int N_PHASES = 25;
#ifndef MK_N_LAUNCHES
#define MK_N_LAUNCHES 1
#endif
#ifndef EN_MIX0
#define EN_MIX0 1
#endif
#ifndef EN_MIX1
#define EN_MIX1 1
#endif
#ifndef EN_MOE
#define EN_MOE 1
#endif
constexpr int LDS_TAB = 131072;
constexpr int LDS_XB = LDS_BYTES - 16;
#define PHASE_FN static __device__ __forceinline__ void
#define KPARAMS const Params* kp_ = (const Params*)__builtin_amdgcn_kernarg_segment_ptr(); asm volatile("" : "+s"(kp_)); const Params& p = *kp_; uchar* ws = p.ws; (void)ws
constexpr size_t TS2048 = (size_t)256 * 2048 * 2, TS512 = (size_t)256 * 512 * 2;

PHASE_FN ph_prologue(LAS uchar* lds) { KPARAMS; phase_prologue(p, lds); }
PHASE_FN ph_copy(int which) {
    KPARAMS; const float* src = which == 0 ? p.in[I_X] : (which == 1 ? (const float*)(ws + WS_XB) : (const float*)(ws + WS_XA)); float* dst = which == 2 ? (float*)(ws + WS_XB) : (float*)(ws + WS_XA);
    const size_t n4 = (size_t)T * D / 4;
    for (size_t i = (size_t)blockIdx.x * NTHREADS + tid_opaque(); i < n4; i += (size_t)gridDim.x * NTHREADS) ((f32x4*)dst)[i] = ((const f32x4*)src)[i];
}
PHASE_FN ph_norm_plain(int which) {
    KPARAMS; float* mod = (float*)(ws + WS_MOD); bf16_t* hmix = (bf16_t*)(ws + WS_HMIX);
    if (which == 0) phase_norm<false, false>(p.in[I_X], p.in[I_NMG], mod, mod + 2048, hmix, nullptr, nullptr, nullptr, nullptr, nullptr, nullptr);
    else if (which == 3) phase_norm<false, false>((const float*)(ws + WS_XA), p.in[I_NMG] + 2048, mod + 12288, mod + 12288 + 2048, hmix, nullptr, nullptr, nullptr, nullptr, nullptr, nullptr);
    else { const int layer = which - 1; phase_norm<false, false>((const float*)(ws + WS_XA), p.in[I_NFG] + layer * 2048, mod + layer * 12288 + 3 * 2048, mod + layer * 12288 + 4 * 2048, hmix, nullptr, nullptr, nullptr, nullptr, nullptr, nullptr); }
}
PHASE_FN ph_norm_combine() {
    KPARAMS; float* mod = (float*)(ws + WS_MOD);
    phase_norm<true, false>((const float*)(ws + WS_XA), p.in[I_NMG] + 2048, mod + 12288, mod + 12288 + 2048, (bf16_t*)(ws + WS_HMIX), nullptr, (const bf16_t*)(ws + WS_YB), (const int*)(ws + WS_TOKROW), (const float*)(ws + WS_TOKW), mod + 5 * 2048, (float*)(ws + WS_XB));
}
PHASE_FN ph_final(int with_moe) {
    KPARAMS; float* mod = (float*)(ws + WS_MOD);
    if (with_moe) phase_norm<true, true>((const float*)(ws + WS_XA), p.in[I_FG], nullptr, nullptr, nullptr, p.out, (const bf16_t*)(ws + WS_YB), (const int*)(ws + WS_TOKROW), (const float*)(ws + WS_TOKW), mod + 12288 + 5 * 2048, nullptr);
    else phase_norm<false, true>((const float*)(ws + WS_XA), p.in[I_FG], nullptr, nullptr, nullptr, p.out, nullptr, nullptr, nullptr, nullptr, nullptr);
}
PHASE_FN ph_win0(LAS uchar* lds) {
    KPARAMS; const char* hmix = (const char*)(ws + WS_HMIX);
    SchedDense2 S; S.A1 = hmix; S.B1 = (const char*)(ws + WS_WIN0T); S.nM1 = 32; S.nN1 = 17; S.A2 = (const char*)(ws + WS_WV0T); S.B2 = hmix; S.nM2 = 2; S.nN2 = 32; S.G = gridDim.x; S.c = blockIdx.x; S.tstep = TS2048;
    EpiWin0 E{(bf16_t*)(ws + U_Q), (bf16_t*)(ws + U_KB), (bf16_t*)(ws + U_VT), (bf16_t*)(ws + U_Y), (float*)(ws + U_XBR), (float*)(ws + U_GATE)};
    pg8::gemm_phase<EpiWin0, SchedDense2>(lds, 2048, S, E, nullptr);
}
PHASE_FN ph_l0_local(LAS uchar* lds) { KPARAMS; for (int u = blockIdx.x; u < 64 + 1024; u += gridDim.x) { if (u < 64) compress_unit(p, lds, u); else lru_local_unit(p, lds, u - 64); } }
PHASE_FN ph_attn(LAS uchar* lds) { KPARAMS; for (int u = blockIdx.x; u < 256; u += gridDim.x) attn_unit(p, lds, u & 1, u >> 1); }
PHASE_FN ph_lru_fix() { KPARAMS; for (int u = blockIdx.x; u < 128; u += gridDim.x) lru_fix_unit(p, u); }
PHASE_FN ph_wout(LAS uchar* lds, int layer) {
    KPARAMS; float* mod = (float*)(ws + WS_MOD) + layer * 12288;
    SchedDense2 S; S.A1 = (const char*)(ws + (layer ? V_HGO : U_CAT)); S.B1 = (const char*)(ws + (layer ? WS_WOUT1T : WS_WOUT0T)); S.nM1 = 32; S.nN1 = 8; S.A2 = nullptr; S.B2 = nullptr; S.nM2 = 0; S.nN2 = 0; S.G = gridDim.x; S.c = blockIdx.x; S.tstep = TS2048;
    EpiResid E{layer ? (const float*)(ws + WS_XB) : p.in[I_X], mod + 2 * 2048, (float*)(ws + WS_XA)};
    pg8::gemm_phase<EpiResid, SchedDense2>(lds, 2048, S, E, nullptr);
}
PHASE_FN ph_win1(LAS uchar* lds) {
    KPARAMS;
    SchedDense2 S; S.A1 = (const char*)(ws + WS_HMIX); S.B1 = (const char*)(ws + WS_WIN1T); S.nM1 = 32; S.nN1 = 32; S.A2 = nullptr; S.B2 = nullptr; S.nM2 = 0; S.nN2 = 0; S.G = gridDim.x; S.c = blockIdx.x; S.tstep = TS2048;
    EpiWin1 E{ws, p.in[I_LBL]};
    pg8::gemm_phase<EpiWin1, SchedDense2>(lds, 2048, S, E, nullptr);
}
PHASE_FN ph_hgrn_local(LAS uchar* lds) { KPARAMS; for (int u = blockIdx.x; u < 2048; u += gridDim.x) hgrn_local_unit(p, lds, u); }
PHASE_FN ph_hgrn_scan() { KPARAMS; hgrn_scan(p); }
PHASE_FN ph_hgrn_out(LAS uchar* lds) { KPARAMS; for (int u = blockIdx.x; u < 2048; u += gridDim.x) hgrn_out_unit(p, lds, u); }
PHASE_FN ph_logit(LAS uchar* lds, int layer) {
    KPARAMS;
    SchedDense2 S; S.A1 = (const char*)(ws + WS_HMIX); S.B1 = (const char*)(ws + WS_ROUTET) + (size_t)layer * 256 * 2048 * 2; S.nM1 = 32; S.nN1 = 1; S.A2 = nullptr; S.B2 = nullptr; S.nM2 = 0; S.nN2 = 0; S.G = gridDim.x; S.c = blockIdx.x; S.tstep = TS2048;
    EpiLogit E{(float*)(ws + WS_LOGIT)};
    pg8::gemm_phase<EpiLogit, SchedDense2>(lds, 2048, S, E, nullptr);
}
PHASE_FN ph_route(int layer) { KPARAMS; moe_route(p, layer); }
PHASE_FN ph_gather(LAS uchar* lds, int layer) { KPARAMS; moe_gather(p, lds + LDS_TAB, layer); }
PHASE_FN ph_moe1(LAS uchar* lds, int layer) {
    KPARAMS; LAS int* tab = (LAS int*)(lds + LDS_TAB);
    const int nt = moe_tiles(p, layer, tab, false);
    SchedMoe S; S.A = (const char*)(ws + WS_XG); S.B = (const char*)(ws + WS_W1T) + (size_t)layer * 64 * 1024 * 2048 * 2; S.tile_e = tab; S.ntiles = nt; S.npn = 4; S.G = gridDim.x; S.c = blockIdx.x; S.tstep = TS2048; S.estride = (size_t)1024 * 2048 * 2;
    EpiMoe1 E{(bf16_t*)(ws + WS_HID)};
    pg8::gemm_phase<EpiMoe1, SchedMoe>(lds, 2048, S, E, nullptr);
}
PHASE_FN ph_moe2(LAS uchar* lds, int layer) {
    KPARAMS; LAS int* tab = (LAS int*)(lds + LDS_TAB);
    const int nt = moe_tiles(p, layer, tab, false);
    SchedMoe S; S.A = (const char*)(ws + WS_HID); S.B = (const char*)(ws + WS_W2T) + (size_t)layer * 64 * 2048 * 512 * 2; S.tile_e = tab; S.ntiles = nt; S.npn = 8; S.G = gridDim.x; S.c = blockIdx.x; S.tstep = TS512; S.estride = (size_t)2048 * 512 * 2;
    EpiBf16Plain E{(bf16_t*)(ws + WS_YB), 2048};
    pg8::gemm_phase<EpiBf16Plain, SchedMoe>(lds, 512, S, E, nullptr);
}

__global__ void __launch_bounds__(NTHREADS, 2) fwd_kernel(Params p) {
    extern __shared__ __attribute__((aligned(16))) uchar smem[];
    LAS uchar* lds = (LAS uchar*)smem;
    if (threadIdx.x == 0) *(LAS u32x4*)(lds + LDS_XB) = (u32x4){0u, 0u, 0u, 0u};
    __syncthreads();
    XcdBarrier bar; bar.bar = (unsigned*)(p.ws + WS_CTL); bar.x = 0; bar.st = (volatile LAS unsigned*)(lds + LDS_XB);
    const int lo = p.ph_lo, hi = p.ph_hi;
    if (hi - lo > 1) bar = xcd_barrier_post((unsigned*)(p.ws + WS_CTL), (volatile LAS unsigned*)(lds + LDS_XB));
#define PH(k) if (lo <= (k) && (k) < hi)
#define SEAM(k) do { if (lo <= (k) && (k) + 1 < hi) xcd_barrier(bar); } while (0)
    PH(0) ph_prologue(lds); SEAM(0);
    PH(1) ph_norm_plain(0); SEAM(1);
#if EN_MIX0
    PH(2) ph_win0(lds); SEAM(2);
    PH(3) ph_l0_local(lds); SEAM(3);
    PH(4) { ph_attn(lds); ph_lru_fix(); } SEAM(4);
    PH(5) ph_wout(lds, 0); SEAM(5);
#else
    SEAM(2); SEAM(3); SEAM(4); PH(5) ph_copy(0); SEAM(5);
#endif
    for (int layer = 0; layer < 2; ++layer) {
        const int fb = layer ? 18 : 6;
#if EN_MOE
        PH(fb) ph_norm_plain(1 + layer); SEAM(fb);
        PH(fb + 1) ph_logit(lds, layer); SEAM(fb + 1);
        PH(fb + 2) ph_route(layer); SEAM(fb + 2);
        PH(fb + 3) ph_gather(lds, layer); SEAM(fb + 3);
        PH(fb + 4) ph_moe1(lds, layer); SEAM(fb + 4);
        PH(fb + 5) ph_moe2(lds, layer); SEAM(fb + 5);
#else
        SEAM(fb); SEAM(fb + 1); SEAM(fb + 2); SEAM(fb + 3); SEAM(fb + 4); SEAM(fb + 5);
#endif
        if (layer == 0) {
#if EN_MOE
            PH(12) ph_norm_combine(); SEAM(12);
#else
            PH(12) { ph_copy(2); ph_norm_plain(3); } SEAM(12);
#endif
#if EN_MIX1
            PH(13) ph_win1(lds); SEAM(13);
            PH(14) ph_hgrn_local(lds); SEAM(14);
            PH(15) ph_hgrn_scan(); SEAM(15);
            PH(16) ph_hgrn_out(lds); SEAM(16);
            PH(17) ph_wout(lds, 1); SEAM(17);
#else
            SEAM(13); SEAM(14); SEAM(15); SEAM(16); PH(17) ph_copy(1); SEAM(17);
#endif
        }
    }
    PH(24) ph_final(EN_MOE);
}

extern "C" void kernel_launch(void* const* d_in, const int* in_sizes, int n_in, void* d_out, int out_size, void* d_ws, size_t ws_size, hipStream_t stream) {
    static int grid = 0;
    if (grid == 0) {
        if (n_in != 33 || out_size != T * D || ws_size < WS_END) { fprintf(stderr, "kernel_launch: unexpected problem (n_in %d, out %d, ws %zu < %zu)\n", n_in, out_size, ws_size, (size_t)WS_END); grid = -1; return; }
        int dev = 0, cus = 0, per_cu = 0;
        if (hipGetDevice(&dev) != hipSuccess || hipDeviceGetAttribute(&cus, hipDeviceAttributeMultiprocessorCount, dev) != hipSuccess) { grid = -1; return; }
        if (hipFuncSetAttribute((const void*)fwd_kernel, hipFuncAttributeMaxDynamicSharedMemorySize, LDS_BYTES) != hipSuccess) { fprintf(stderr, "kernel_launch: hipFuncSetAttribute failed\n"); grid = -1; return; }
        if (hipOccupancyMaxActiveBlocksPerMultiprocessor(&per_cu, (const void*)fwd_kernel, NTHREADS, LDS_BYTES) != hipSuccess || per_cu < 1) { fprintf(stderr, "kernel_launch: occupancy query says %d blocks per CU\n", per_cu); grid = -1; (void)hipGetLastError(); return; }
        grid = cus;
    }
    if (grid < 0) return;
    (void)hipMemsetAsync((char*)d_ws + WS_CTL, 0, CTL_BYTES, stream);
    Params p{};
    for (int i = 0; i < 33; ++i) p.in[i] = (const float*)d_in[i];
    p.out = (float*)d_out; p.ws = (uchar*)d_ws;
#if MK_N_LAUNCHES == 1
    p.ph_lo = 0; p.ph_hi = N_PHASES;
    hipLaunchKernelGGL(fwd_kernel, dim3(grid), dim3(NTHREADS), LDS_BYTES, stream, p);
#else
    for (int k = 0; k < N_PHASES; ++k) { p.ph_lo = k; p.ph_hi = k + 1; hipLaunchKernelGGL(fwd_kernel, dim3(grid), dim3(NTHREADS), LDS_BYTES, stream, p); }
#endif
}
```

```cpp
#include <hip/hip_runtime.h>
#include <cstdio>
#include <cstdint>

#define LAS __attribute__((address_space(3)))
typedef unsigned short bf16_t;
typedef short bf16x8 __attribute__((ext_vector_type(8)));
typedef float f32x4 __attribute__((ext_vector_type(4)));
typedef float f32x16 __attribute__((ext_vector_type(16)));
typedef unsigned u32x4 __attribute__((ext_vector_type(4)));
typedef int i32x4 __attribute__((ext_vector_type(4)));
typedef unsigned u32x2 __attribute__((ext_vector_type(2)));
typedef unsigned char uchar;

constexpr int T = 8192, D = 2048;
constexpr int NTHREADS = 512, NWAVES = 8;
constexpr int LDS_BYTES = 147456;
constexpr int EVEN_COLS = 4632;
constexpr int KPAD = 64;
constexpr int TP = T + KPAD;
constexpr int TV = T + 64;
constexpr int MOE_TILE = 256;
constexpr int MOE_ROWS = 32768;
constexpr int LOGIT_LD = 80;

constexpr size_t al256(size_t x) { return (x + 255) & ~(size_t)255; }
constexpr size_t WS_CTL = 0;
constexpr size_t CTL_BYTES = 16384;
constexpr size_t CTL_CNT_OFF = 13824;
constexpr size_t CTL_LRUQ_OFF = 14400;
constexpr size_t WS_MOD = WS_CTL + CTL_BYTES;
constexpr size_t WS_PEBP = WS_MOD + 2 * 12288 * 4;
constexpr size_t WS_WIN0T = WS_PEBP + 16 * 2 * 128 * 4;
constexpr size_t WS_WV0T = WS_WIN0T + (size_t)4352 * 2048 * 2;
constexpr size_t WS_WOUT0T = WS_WV0T + (size_t)512 * 2048 * 2;
constexpr size_t WS_WC1T = WS_WOUT0T + (size_t)2048 * 2048 * 2;
constexpr size_t WS_WC2T = WS_WC1T + (size_t)2 * 128 * 4096 * 2;
constexpr size_t WS_WAT = WS_WC2T + (size_t)2 * 128 * 128 * 2;
constexpr size_t WS_WIT = WS_WAT + (size_t)8 * 128 * 128 * 2;
constexpr size_t WS_WIN1T = WS_WIT + (size_t)8 * 128 * 128 * 2;
constexpr size_t WS_WOUT1T = WS_WIN1T + (size_t)8192 * 2048 * 2;
constexpr size_t WS_ROUTET = WS_WOUT1T + (size_t)2048 * 2048 * 2;
constexpr size_t WS_W1T = WS_ROUTET + (size_t)2 * 256 * 2048 * 2;
constexpr size_t WS_ETOK = WS_W1T + (size_t)1048576;
constexpr size_t WS_SC_TOK = WS_W1T, WS_SC_W0 = WS_SC_TOK + (size_t)T * 4, WS_SC_WV = WS_SC_W0 + 4352 * 4, WS_SC_W1 = WS_SC_WV + 512 * 4;
constexpr size_t WS_W2T = WS_W1T + (size_t)2 * 64 * 1024 * 2048 * 2;
constexpr size_t WS_HMIX = WS_W2T + (size_t)2 * 64 * 2048 * 512 * 2;
constexpr size_t WS_XA = WS_HMIX + (size_t)T * D * 2;
constexpr size_t WS_XB = WS_XA + (size_t)T * D * 4;
constexpr size_t WS_XG = WS_XB + (size_t)T * D * 4;
constexpr size_t WS_HID = WS_XG + (size_t)MOE_ROWS * 2048 * 2;
constexpr size_t WS_YB = WS_HID + (size_t)MOE_ROWS * 512 * 2;
constexpr size_t WS_LOGIT = WS_YB + (size_t)MOE_ROWS * 2048 * 2;
constexpr size_t WS_TOKE = WS_LOGIT + (size_t)8 * T * LOGIT_LD * 4;
constexpr size_t WS_TOKPOS = WS_TOKE + (size_t)T * 2 * 4;
constexpr size_t WS_TOKW = WS_TOKPOS + (size_t)T * 2 * 4;
constexpr size_t WS_TOKROW = WS_TOKW + (size_t)T * 2 * 4;
constexpr size_t WS_TILEE = WS_TOKROW + (size_t)T * 2 * 4;
constexpr size_t WS_PARK = WS_TILEE + 1024;
constexpr size_t WS_U = WS_PARK + (size_t)256 * 64 * 512 * 4;
constexpr size_t U_Q = WS_U;
constexpr size_t U_KB = U_Q + (size_t)T * 1024 * 2;
constexpr size_t U_VT = U_KB + (size_t)4 * 2 * TP * 128 * 2;
constexpr size_t U_Y = U_VT + (size_t)2 * 2 * 128 * TV * 2;
constexpr size_t U_XBR = U_Y + (size_t)T * 1024 * 2;
constexpr size_t U_GATE = U_XBR + (size_t)T * 1024 * 4;
constexpr size_t U_KCMP = U_GATE + (size_t)T * 24 * 4;
constexpr size_t U_VCMPT = U_KCMP + (size_t)2 * 512 * 128 * 2;
constexpr size_t U_HLOC = U_VCMPT + (size_t)2 * 128 * 512 * 2;
constexpr size_t U_PC = U_HLOC + (size_t)T * 1024 * 4;
constexpr size_t U_HEND = U_PC + (size_t)T * 1024 * 4;
constexpr size_t U_PEND = U_HEND + (size_t)128 * 1024 * 4;
constexpr size_t U_CAT = U_PEND + (size_t)128 * 1024 * 4;
constexpr size_t U_END0 = U_CAT + (size_t)T * 2048 * 2;
constexpr size_t V_QS = WS_U;
constexpr size_t V_LOGF = V_QS + (size_t)T * 2048 * 2;
constexpr size_t V_KK = V_LOGF + (size_t)T * 2048 * 4;
constexpr size_t V_V = V_KK + (size_t)T * 2048 * 2;
constexpr size_t V_SB = V_KK;
constexpr size_t V_GS = V_V + (size_t)T * 2048 * 2;
constexpr size_t V_OINTRA = V_GS + (size_t)T * 2048 * 2;
constexpr size_t V_QHAT = V_OINTRA + (size_t)T * 2048 * 4;
constexpr size_t V_ST = V_QHAT + (size_t)T * 2048 * 2;
constexpr size_t V_DEC = V_ST + (size_t)128 * 16 * 128 * 128 * 4;
constexpr size_t V_HGO = V_DEC + (size_t)128 * 16 * 128 * 4;
constexpr size_t U_END1 = V_HGO + (size_t)T * 2048 * 2;
constexpr size_t WS_END = (U_END0 > U_END1 ? U_END0 : U_END1);

struct Params {
    const float* in[33];
    float* out;
    uchar* ws;
    int ph_lo, ph_hi;
};
enum { I_X = 0, I_C, I_RELB, I_ADAW, I_ADAB, I_NMG, I_NFG, I_EWIN, I_EWOUT, I_PE, I_CW1, I_CB1, I_CW2, I_CB2, I_CONVW, I_CONVB, I_LWA, I_LBA, I_LWI, I_LBI,
       I_LAMBDA, I_OWIN, I_OWOUT, I_LBL, I_HNG, I_MWGRP, I_MBGRP, I_MWEXP, I_MBEXP, I_MWG, I_MWU, I_MWD, I_FG };

__device__ __forceinline__ int tid_opaque() { int t = threadIdx.x; asm volatile("" : "+v"(t)); return t; }
typedef __bf16 bf16x2_t __attribute__((ext_vector_type(2)));
typedef float f32x2_t __attribute__((ext_vector_type(2)));
__device__ __forceinline__ unsigned cvt_pk_bf16(float lo, float hi) { const f32x2_t f = {lo, hi}; const bf16x2_t b = __builtin_convertvector(f, bf16x2_t); return __builtin_bit_cast(unsigned, b); }
__device__ __forceinline__ float bf_lo(unsigned u) { return __uint_as_float(u << 16); }
__device__ __forceinline__ float bf_hi(unsigned u) { return __uint_as_float(u & 0xffff0000u); }
__device__ __forceinline__ float bf2f(bf16_t b) { return __uint_as_float(((unsigned)b) << 16); }
__device__ __forceinline__ bf16_t f2bf(float f) { return (bf16_t)(cvt_pk_bf16(f, 0.f) & 0xffffu); }
__device__ __forceinline__ float sigmoidf_(float x) { return __builtin_amdgcn_rcpf(1.0f + __expf(-x)); }
__device__ __forceinline__ float siluf_(float x) { return x * __builtin_amdgcn_rcpf(1.0f + __expf(-x)); }
__device__ __forceinline__ float geluf_(float x) { const float u = 0.7978845608028654f * (x + 0.044715f * x * x * x); const float t = 1.0f - 2.0f * __builtin_amdgcn_rcpf(__expf(2.0f * u) + 1.0f); return 0.5f * x * (1.0f + t); }
__device__ __forceinline__ float wave_sum(float v) {
#pragma unroll
    for (int o = 32; o > 0; o >>= 1) v += __shfl_xor(v, o);
    return v;
}
__device__ __forceinline__ float wave_max(float v) {
#pragma unroll
    for (int o = 32; o > 0; o >>= 1) v = fmaxf(v, __shfl_xor(v, o));
    return v;
}
__device__ __forceinline__ unsigned pack_i8x4(float a, float b, float c, float d) {
    const int ia = (int)rintf(a), ib = (int)rintf(b), ic = (int)rintf(c), id = (int)rintf(d);
    return (unsigned)(ia & 255) | ((unsigned)(ib & 255) << 8) | ((unsigned)(ic & 255) << 16) | ((unsigned)id << 24);
}
__device__ __forceinline__ int t5_bucket(int n) {
    if (n < 16) return n;
    int b = 16;
    b += (n >= 19) + (n >= 21) + (n >= 24) + (n >= 27) + (n >= 31) + (n >= 35) + (n >= 40) + (n >= 46) + (n >= 52) + (n >= 59) + (n >= 67) + (n >= 77) + (n >= 87) + (n >= 99) + (n >= 113);
    return b;
}
#define XB_TMO      128
#define XB_XCNT(j)  (256  + 64 * (j))
#define XB_XSUB(j)  (1280 + 64 * (j))
#define XB_XGEN(j)  (2304 + 64 * (j))
#define XB_TOP      3328
#define XB_TOPGEN   3392
#define XCD_BAR_WORDS 3456
#define XB_SPIN_CAP (1u << 18)
#define LAS __attribute__((address_space(3)))

__device__ __forceinline__ unsigned xb_ld(unsigned* p)              { return __hip_atomic_load(p, __ATOMIC_RELAXED, __HIP_MEMORY_SCOPE_AGENT); }
__device__ __forceinline__ unsigned xb_add(unsigned* p, unsigned v) { return __hip_atomic_fetch_add(p, v, __ATOMIC_RELAXED, __HIP_MEMORY_SCOPE_AGENT); }
__device__ __forceinline__ unsigned xb_xcc_id() { return (unsigned)__builtin_amdgcn_s_getreg((3 << 11) | 20) & 0xFu; }
#define XB_SPIN(cond, bar) do { unsigned _sp = 0; while (cond) { __builtin_amdgcn_s_sleep(1); \
    if ((++_sp & 255u) == 0u) { if (xb_ld(&(bar)[XB_TMO])) break; if (_sp > XB_SPIN_CAP) { atomicAdd(&(bar)[XB_TMO], 1u); break; } } } } while (0)

struct XcdBarrier {
    unsigned* bar; unsigned x;
    volatile LAS unsigned* st;
};

__device__ __forceinline__ XcdBarrier xcd_barrier_post(unsigned* bar, volatile LAS unsigned* st) {
    XcdBarrier b; b.bar = bar; b.x = xb_xcc_id(); b.st = st;
    if (threadIdx.x == 0) (void)xb_add(&bar[XB_XCNT(b.x)], 1u);
    return b;
}
__device__ __forceinline__ void xcd_barrier_complete(unsigned* bar, unsigned x, unsigned& nloc, unsigned& nx) {
    const unsigned G = gridDim.x * gridDim.y * gridDim.z;
    unsigned sum, cnt, mine, sp = 0u;
    for (;;) {
        sum = 0u; cnt = 0u; mine = 0u;
#pragma unroll
        for (unsigned j = 0; j < 16; ++j) { const unsigned c = xb_ld(&bar[XB_XCNT(j)]); sum += c; cnt += (c > 0u) ? 1u : 0u; mine = (j == x) ? c : mine; }
        if (sum == G) break;
        __builtin_amdgcn_s_sleep(1);
        if ((++sp & 255u) == 0u) { if (xb_ld(&bar[XB_TMO])) break; if (sp > XB_SPIN_CAP) { atomicAdd(&bar[XB_TMO], 1u); break; } }
    }
    nloc = mine > 0u ? mine : 1u; nx = cnt > 0u ? cnt : 1u;
}

__device__ __forceinline__ void xcd_barrier(const XcdBarrier& b) {
    asm volatile("s_waitcnt vmcnt(0)" ::: "memory");
    __syncthreads();
    if (threadIdx.x == 0) {
        unsigned* bar = b.bar;
        __builtin_amdgcn_s_waitcnt(0);
        unsigned nloc = b.st[0], nx = b.st[1];
        if (nloc == 0u) { xcd_barrier_complete(bar, b.x, nloc, nx); b.st[0] = nloc; b.st[1] = nx; }
        const unsigned old = xb_add(&bar[XB_XSUB(b.x)], 1u);
        const unsigned gen = old / nloc;
        if (old + 1u == (gen + 1u) * nloc) {
            __builtin_amdgcn_fence(__ATOMIC_RELEASE, "agent");
            asm volatile("s_waitcnt vmcnt(0)" ::: "memory");
            const unsigned og = xb_add(&bar[XB_TOP], 1u);
            const unsigned tg = og / nx;
            if (og + 1u == (tg + 1u) * nx) xb_add(&bar[XB_TOPGEN], 1u);
            else XB_SPIN(xb_ld(&bar[XB_TOPGEN]) == tg, bar);
            __builtin_amdgcn_fence(__ATOMIC_ACQUIRE, "agent");
            xb_add(&bar[XB_XGEN(b.x)], 1u);
            asm volatile("s_waitcnt vmcnt(0)" ::: "memory");
        } else {
            XB_SPIN(xb_ld(&bar[XB_XGEN(b.x)]) == gen, bar);
            __builtin_amdgcn_fence(__ATOMIC_ACQUIRE, "agent");
            asm volatile("s_waitcnt vmcnt(0)" ::: "memory");
        }
    }
    __syncthreads();
}
namespace pg8 {
#define PG8_LAS __attribute__((address_space(3)))
constexpr int BM = 256, BK = 64, HALF = 128, HTB = HALF * BK * 2  , STAGE_BYTES = 8 * HTB, NXCD = 8, WGM = 8;
__host__ __device__ __forceinline__ int lds_byte(int r, int c) { const int st = (r >> 4) * 2 + (c >> 5), rr = r & 15, cc = c & 31, ob = rr * 64 + cc * 2; return st * 1024 + (ob ^ (((ob >> 9) & 1) << 5)); }
__host__ __device__ __forceinline__ void stage_rc(int b, int& R, int& C) { const int st = b / 1024, sb = b % 1024, swz = sb ^ (((sb >> 9) & 1) << 5); R = (st >> 1) * 16 + swz / 64; C = (st & 1) * 32 + (swz % 64) / 2; }
__host__ __device__ __forceinline__ int perm32(int rho) { const int n = rho >> 4, i = rho & 15; return 8 * (i >> 2) + 4 * n + (i & 3); }
struct Unit { int pm, pn; const char* a; const char* b; int aux; };
__host__ __device__ __forceinline__ void static_tile(int L, int nM, int nN, int& pm, int& pn) {
    const int nwg = nM * nN; int wgid = L; { const int q = nwg / NXCD, r = nwg % NXCD, xcd = wgid % NXCD, off = wgid / NXCD; wgid = (xcd < r ? xcd * (q + 1) : r * (q + 1) + (xcd - r) * q) + off; }
    const int nig = WGM * nN, gid = wgid / nig, fm = gid * WGM, gsz = (nM - fm) < WGM ? (nM - fm) : WGM;
    pm = fm + ((wgid % nig) % gsz); pn = (wgid % nig) / gsz;
}

template <class Epi, class Sched, bool STAMP = false>
__device__ __forceinline__ void gemm_phase(PG8_LAS unsigned char* lds, const int Kdim, const Sched& S, const Epi& E, unsigned long long* stamps, const int Kloop = 0) {
    const int tid = tid_opaque(), wid = __builtin_amdgcn_readfirstlane(tid >> 6), lane = tid & 63, wr = wid >> 2, wc = wid & 3, fr = lane & 15, fq = lane >> 4;
    const int K = Kdim, nt = (Kloop ? Kloop : K) / BK;
    int ts_lo = 0, ts_hi = 0, nts = 0; const unsigned long long rt_entry = STAMP ? (unsigned long long)wall_clock64() : 0ull;
#define PG8_STAMP() do { if (STAMP && wid == 0 && nts < 64) { const unsigned long long _c = (unsigned long long)clock64(); \
        ts_lo = (lane == nts) ? (int)(unsigned)_c : ts_lo; ts_hi = (lane == nts) ? (int)(unsigned)(_c >> 32) : ts_hi; ++nts; } } while (0)
    PG8_STAMP();
    unsigned voffA[2], voffB[2];
#pragma unroll
    for (int i = 0; i < 2; ++i) { int R, C; stage_rc(tid * 16 + i * 8192, R, C); const int Rb = Epi::PERM ? ((R & ~31) + perm32(R & 31)) : R;
        voffA[i] = (unsigned)(R * K + C) * 2u; voffB[i] = (unsigned)(Rb * K + C) * 2u; }
    const size_t kstep = (size_t)(BK * 2);
    const size_t hstep = (size_t)HALF * K * 2;
        const unsigned ldsw = (unsigned)wid * 1024u;
    const int aoff = lds_byte(wr * 64 + fr, fq * 8), boff = lds_byte(wc * 32 + fr, fq * 8);
#define PG8_SA(b, h) (((b) * 2 + (h)) * HTB)
#define PG8_SB(b, h) ((4 + (b) * 2 + (h)) * HTB)
#define PG8_STAGE(bufoff, gbase, voff) do { _Pragma("unroll") for (int _i = 0; _i < 2; ++_i) \
        __builtin_amdgcn_global_load_lds((const unsigned*)((const char*)(gbase) + (voff)[_i]), (PG8_LAS unsigned*)(lds + (bufoff) + ldsw + _i * 8192), 16, 0, 0); } while (0)
#define PG8_LDA(dst, b, h) do { _Pragma("unroll") for (int m = 0; m < 4; ++m) _Pragma("unroll") for (int k = 0; k < 2; ++k) dst[m][k] = *(const PG8_LAS bf16x8*)(lds + PG8_SA(b, h) + aoff + m * 2048 + k * 1024); } while (0)
#define PG8_LDB(dst, b, h) do { _Pragma("unroll") for (int n = 0; n < 2; ++n) _Pragma("unroll") for (int k = 0; k < 2; ++k) dst[n][k] = *(const PG8_LAS bf16x8*)(lds + PG8_SB(b, h) + boff + n * 2048 + k * 1024); } while (0)
#define PG8_MMA(ai, bj, At, Bt) do { __builtin_amdgcn_s_setprio(1); _Pragma("unroll") for (int m = 0; m < 4; ++m) _Pragma("unroll") for (int n = 0; n < 2; ++n) _Pragma("unroll") for (int k = 0; k < 2; ++k) \
        { if constexpr (Epi::I8) acc[ai][bj][m][n] = __builtin_bit_cast(acc_t, __builtin_amdgcn_mfma_i32_16x16x64_i8(__builtin_bit_cast(i32x4, Bt[n][k]), __builtin_bit_cast(i32x4, At[m][k]), __builtin_bit_cast(i32x4, acc[ai][bj][m][n]), 0, 0, 0)); \
          else acc[ai][bj][m][n] = __builtin_bit_cast(acc_t, __builtin_amdgcn_mfma_f32_16x16x32_bf16(Bt[n][k], At[m][k], __builtin_bit_cast(f32x4, acc[ai][bj][m][n]), 0, 0, 0)); } __builtin_amdgcn_s_setprio(0); } while (0)
#define PG8_WAIT_V(n) asm volatile("s_waitcnt vmcnt(" #n ")" ::: "memory")
#define PG8_WAIT_L(n) asm volatile("s_waitcnt lgkmcnt(" #n ")" ::: "memory")
#define PG8_BAR __builtin_amdgcn_s_barrier()
#define PG8_SCHED __builtin_amdgcn_sched_barrier(0)
    Unit cur, nxt; int ui = 0;
    if (!S.next(0, cur)) return;
    typedef f32x4 acc_t;
    acc_t acc[2][2][4][2];
#pragma unroll
    for (int a = 0; a < 2; ++a)
#pragma unroll
        for (int b = 0; b < 2; ++b)
#pragma unroll
            for (int m = 0; m < 4; ++m)
#pragma unroll
                for (int n = 0; n < 2; ++n) acc[a][b][m][n] = (acc_t){0, 0, 0, 0};
    bf16x8 At[4][2], B0[2][2], B1[2][2];
    const char* cA = cur.a; const char* cB = cur.b;
    S.a_ready(cur);
    PG8_STAGE(PG8_SB(0, 0), cB, voffB); PG8_STAGE(PG8_SA(0, 0), cA, voffA); PG8_STAGE(PG8_SB(0, 1), cB + hstep, voffB); PG8_STAGE(PG8_SA(0, 1), cA + hstep, voffA);
    if (wr == 1) PG8_BAR;
    PG8_WAIT_V(4); PG8_BAR;
    PG8_STAGE(PG8_SB(1, 0), cB + kstep, voffB); PG8_STAGE(PG8_SA(1, 0), cA + kstep, voffA); PG8_STAGE(PG8_SB(1, 1), cB + hstep + kstep, voffB);
    PG8_WAIT_V(6); PG8_BAR;
    PG8_STAMP();
    for (;;) {
        const bool has_next = S.next(ui + 1, nxt);
        const char* nA = has_next ? nxt.a : cA; const char* nB = has_next ? nxt.b : cB;
        for (int t = 0; t < nt; t += 2) {
            const bool last = (t == nt - 2);
            const char* a1 = cA + (size_t)(t + 1) * kstep;
            const char* a2 = last ? nA : cA + (size_t)(t + 2) * kstep; const char* b2 = last ? nB : cB + (size_t)(t + 2) * kstep;
            const char* a3 = a2 + kstep; const char* b3 = b2 + kstep;
            if (last && has_next) S.a_ready(nxt);
            PG8_LDB(B0, 0, 0); PG8_SCHED; PG8_LDA(At, 0, 0); PG8_STAGE(PG8_SA(1, 1), a1 + hstep, voffA);
            PG8_WAIT_L(8); PG8_BAR; PG8_WAIT_L(0); PG8_MMA(0, 0, At, B0); PG8_BAR; PG8_SCHED;
            PG8_LDB(B1, 0, 1); PG8_STAGE(PG8_SB(0, 0), b2, voffB);
            PG8_BAR; PG8_WAIT_L(0); PG8_MMA(0, 1, At, B1); PG8_BAR;
            PG8_LDA(At, 0, 1); PG8_STAGE(PG8_SA(0, 0), a2, voffA);
            PG8_BAR; PG8_WAIT_L(0); PG8_MMA(1, 0, At, B0); PG8_BAR; PG8_SCHED;
            PG8_STAGE(PG8_SB(0, 1), b2 + hstep, voffB);
            PG8_WAIT_V(6); PG8_BAR; PG8_MMA(1, 1, At, B1); PG8_BAR;
            PG8_LDB(B0, 1, 0); PG8_SCHED; PG8_LDA(At, 1, 0); PG8_STAGE(PG8_SA(0, 1), a2 + hstep, voffA);
            PG8_WAIT_L(8); PG8_BAR; PG8_WAIT_L(0); PG8_MMA(0, 0, At, B0); PG8_BAR; PG8_SCHED;
            PG8_LDB(B1, 1, 1); PG8_STAGE(PG8_SB(1, 0), b3, voffB);
            PG8_BAR; PG8_WAIT_L(0); PG8_MMA(0, 1, At, B1); PG8_BAR;
            PG8_LDA(At, 1, 1); PG8_STAGE(PG8_SA(1, 0), a3, voffA);
            PG8_BAR; PG8_WAIT_L(0); PG8_MMA(1, 0, At, B0); PG8_BAR; PG8_SCHED;
            PG8_STAGE(PG8_SB(1, 1), b3 + hstep, voffB);
            PG8_WAIT_V(6); PG8_BAR; PG8_MMA(1, 1, At, B1); PG8_BAR;
        }
        PG8_STAMP();
        if constexpr (Epi::I8) {
            static_assert(!Epi::AFTER_DRAIN, "int8 units use the in-loop epilogue");
            const float* rs; const float* cs; E.scales(cur, rs, cs);
            const int lr0 = cur.pm * 256 + wr * 64 + fr, lc0 = cur.pn * 256 + wc * 32 + 4 * fq;
            f32x4 csv[2][2];
#pragma unroll
            for (int b = 0; b < 2; ++b)
#pragma unroll
                for (int n = 0; n < 2; ++n) csv[b][n] = *(const f32x4*)(cs + lc0 + b * 128 + n * 16);
#pragma unroll
            for (int a = 0; a < 2; ++a)
#pragma unroll
                for (int m = 0; m < 4; ++m) { const float r = rs[lr0 + a * 128 + m * 16];
#pragma unroll
                    for (int b = 0; b < 2; ++b)
#pragma unroll
                        for (int n = 0; n < 2; ++n) { const i32x4 v = __builtin_bit_cast(i32x4, acc[a][b][m][n]); const f32x4 c = csv[b][n] * r;
                            acc[a][b][m][n] = (f32x4){(float)v[0] * c[0], (float)v[1] * c[1], (float)v[2] * c[2], (float)v[3] * c[3]}; } }
            E(acc, cur, wr, wc, fr, fq); S.done(cur);
        } else if constexpr (!Epi::AFTER_DRAIN) { E(acc, cur, wr, wc, fr, fq); S.done(cur); }
        PG8_STAMP();
        if (!has_next) break;
#pragma unroll
        for (int a = 0; a < 2; ++a)
#pragma unroll
            for (int b = 0; b < 2; ++b)
#pragma unroll
                for (int m = 0; m < 4; ++m)
#pragma unroll
                    for (int n = 0; n < 2; ++n) acc[a][b][m][n] = (acc_t){0, 0, 0, 0};
        cur = nxt; cA = nA; cB = nB; ++ui;
    }
    PG8_WAIT_V(0);
    if (wr == 0) PG8_BAR;
    PG8_BAR;
    if constexpr (Epi::AFTER_DRAIN && !Epi::I8) { E.fused(acc, cur, wr, wc, fr, fq, lds, wid, lane); S.done(cur); }
    PG8_STAMP();
    if (STAMP && wid == 0) { stamps[lane] = lane < nts ? (((unsigned long long)(unsigned)ts_hi << 32) | (unsigned)ts_lo) : 0ull;
        if (lane == 62) stamps[62] = rt_entry; if (lane == 63) stamps[63] = (unsigned long long)wall_clock64(); }
#undef PG8_STAMP
#undef PG8_SA
#undef PG8_SB
#undef PG8_STAGE
#undef PG8_LDA
#undef PG8_LDB
#undef PG8_MMA
#undef PG8_WAIT_V
#undef PG8_WAIT_L
#undef PG8_BAR
#undef PG8_SCHED
}
}
struct ConvJob { const float* src; int ld, K, c0, nc, cb, rb; bf16_t* dst; int r0; };

__device__ __forceinline__ void conv_load(f32x4 (&v)[16], const ConvJob& j, int kt, int ct, int lane) {
    const int k0 = kt * 64, cbase = ct * 64;
    const int ncv = (j.nc - cbase) < 64 ? (j.nc - cbase) : 64;
    const float* s = j.src + (size_t)k0 * j.ld + j.c0 + cbase;
#pragma unroll
    for (int i = 0; i < 16; ++i) {
        const int id = lane + 64 * i, row = id >> 4, c4 = (id & 15) * 4;
        v[i] = (c4 < ncv) ? *(const f32x4*)(s + (size_t)row * j.ld + c4) : (f32x4){0.f, 0.f, 0.f, 0.f};
    }
}
__device__ __forceinline__ void conv_store(const f32x4 (&v)[16], const ConvJob& j, int kt, int ct, LAS float* tl, int lane) {
    const int k0 = kt * 64, cbase = ct * 64;
    const int ncv = (j.nc - cbase) < 64 ? (j.nc - cbase) : 64;
#pragma unroll
    for (int i = 0; i < 16; ++i) {
        const int id = lane + 64 * i, row = id >> 4, c4 = (id & 15) * 4;
        tl[row * 65 + c4 + 0] = v[i][0]; tl[row * 65 + c4 + 1] = v[i][1]; tl[row * 65 + c4 + 2] = v[i][2]; tl[row * 65 + c4 + 3] = v[i][3];
    }
#pragma unroll
    for (int i = 0; i < 8; ++i) {
        const int id = lane + 64 * i, cc = id >> 3, kc = id & 7;
        if (cc < ncv) {
            const int c = cbase + cc, drow = j.r0 + (c / j.cb) * j.rb + (c % j.cb);
            float f[8];
#pragma unroll
            for (int q = 0; q < 8; ++q) f[q] = tl[(8 * kc + q) * 65 + cc];
            u32x4 o; o[0] = cvt_pk_bf16(f[0], f[1]); o[1] = cvt_pk_bf16(f[2], f[3]); o[2] = cvt_pk_bf16(f[4], f[5]); o[3] = cvt_pk_bf16(f[6], f[7]);
            *(u32x4*)(j.dst + (size_t)drow * j.K + k0 + 8 * kc) = o;
        }
    }
}
__device__ __forceinline__ bool conv_locate(int t, const Params& p, ConvJob& j, int& kt, int& ct);

__device__ __forceinline__ bool small_job(int idx, const Params& p, ConvJob& o) {
    uchar* ws = p.ws;
    o.rb = 0; o.r0 = 0;
    if (idx < 10) {
        o.src = p.in[I_EWIN]; o.ld = EVEN_COLS; o.K = 2048; o.nc = 256;
        switch (idx) {
            case 0: o.c0 = 0; o.nc = 1024; o.r0 = 0; break;
            case 1: o.c0 = 1024; o.r0 = 1024; break;
            case 2: o.c0 = 1280; o.r0 = 1280; break;
            case 3: o.c0 = 1536; o.r0 = 1536; break;
            case 4: o.c0 = 2048; o.r0 = 1792; break;
            case 5: o.c0 = 2584; o.nc = 1024; o.r0 = 2048; break;
            case 6: o.c0 = 3608; o.nc = 1024; o.r0 = 3072; break;
            case 7: o.c0 = 2560; o.nc = 24; o.r0 = 4096; break;
            case 8: o.c0 = 1792; o.r0 = 0; break;
            default: o.c0 = 2304; o.r0 = 256; break;
        }
        o.cb = o.nc;
        o.dst = (bf16_t*)(ws + (idx < 8 ? WS_WIN0T : WS_WV0T));
        return true;
    }
    o.c0 = 0;
    if (idx == 10) { o.src = p.in[I_EWOUT]; o.ld = 2048; o.K = 2048; o.nc = 2048; o.cb = 2048; o.dst = (bf16_t*)(ws + WS_WOUT0T); return true; }
    if (idx < 13) { const int k = idx - 11; o.src = p.in[I_CW1] + (size_t)k * 4096 * 128; o.ld = 128; o.K = 4096; o.nc = 128; o.cb = 128; o.dst = (bf16_t*)(ws + WS_WC1T) + (size_t)k * 128 * 4096; return true; }
    if (idx < 15) { const int k = idx - 13; o.src = p.in[I_CW2] + (size_t)k * 128 * 128; o.ld = 128; o.K = 128; o.nc = 128; o.cb = 128; o.dst = (bf16_t*)(ws + WS_WC2T) + (size_t)k * 128 * 128; return true; }
    if (idx < 23) { const int k = idx - 15; o.src = p.in[I_LWA] + (size_t)k * 128 * 128; o.ld = 128; o.K = 128; o.nc = 128; o.cb = 128; o.dst = (bf16_t*)(ws + WS_WAT) + (size_t)k * 128 * 128; return true; }
    if (idx < 31) { const int k = idx - 23; o.src = p.in[I_LWI] + (size_t)k * 128 * 128; o.ld = 128; o.K = 128; o.nc = 128; o.cb = 128; o.dst = (bf16_t*)(ws + WS_WIT) + (size_t)k * 128 * 128; return true; }
    if (idx == 31) { o.src = p.in[I_OWIN]; o.ld = 8192; o.K = 2048; o.nc = 8192; o.cb = 8192; o.dst = (bf16_t*)(ws + WS_WIN1T); return true; }
    if (idx == 32) { o.src = p.in[I_OWOUT]; o.ld = 2048; o.K = 2048; o.nc = 2048; o.cb = 2048; o.dst = (bf16_t*)(ws + WS_WOUT1T); return true; }
    if (idx < 35) { const int l = idx - 33; o.src = p.in[I_MWGRP] + (size_t)l * 2048 * 8; o.ld = 8; o.K = 2048; o.nc = 8; o.cb = 8; o.dst = (bf16_t*)(ws + WS_ROUTET) + (size_t)l * 256 * 2048; return true; }
    if (idx < 37) { const int l = idx - 35; o.src = p.in[I_MWEXP] + (size_t)l * 2048 * 64; o.ld = 64; o.K = 2048; o.nc = 64; o.cb = 64; o.r0 = 8; o.dst = (bf16_t*)(ws + WS_ROUTET) + (size_t)l * 256 * 2048; return true; }
    return false;
}
constexpr int N_SMALL_JOBS = 37;
__device__ __forceinline__ bool conv_locate(int t, const Params& p, ConvJob& j, int& kt, int& ct) {
    for (int jx = 10; jx < N_SMALL_JOBS; ++jx) {
        if (jx == 31) continue;
        small_job(jx, p, j);
        const int tk = j.K >> 6, tc = (j.nc + 63) >> 6, nt = tk * tc;
        if (t < nt) { kt = t % tk; ct = t / tk; return true; }
        t -= nt;
    }
    return false;
}

constexpr int N_CONV8_UNITS = 73 + 128;
__device__ __forceinline__ void conv8_locate(int u, const Params& p, ConvJob& j, int& ct, uchar*& dst8, float*& scl) {
    uchar* ws = p.ws;
    if (u >= 73) { small_job(31, p, j); ct = u - 73; dst8 = ws + WS_WIN1T; scl = (float*)(ws + WS_SC_W1); return; }
    int idx = 0;
    for (; idx < 10; ++idx) { small_job(idx, p, j); const int tc = (j.nc + 63) >> 6; if (u < tc) break; u -= tc; }
    ct = u; dst8 = ws + (idx < 8 ? WS_WIN0T : WS_WV0T); scl = (float*)(ws + (idx < 8 ? WS_SC_W0 : WS_SC_WV));
}
__device__ __forceinline__ void conv8_load(f32x4 (&v)[16], const ConvJob& j, int kt, int ct, int lane) {
    const float* s = j.src + (size_t)(kt * 64 + (lane >> 4)) * j.ld + j.c0 + ct * 64 + (lane & 15) * 4;
#pragma unroll
    for (int i = 0; i < 16; ++i) v[i] = *(const f32x4*)(s + (size_t)(4 * i) * j.ld);
}
__device__ __forceinline__ void conv8_max(f32x4& mx, const f32x4 (&v)[16]) {
#pragma unroll
    for (int i = 0; i < 16; ++i)
#pragma unroll
        for (int q = 0; q < 4; ++q) mx[q] = fmaxf(mx[q], fabsf(v[i][q]));
}
__device__ __forceinline__ void conv8_store(const f32x4 (&v)[16], const ConvJob& j, int kt, int cbase, int ncv, uchar* dst8, LAS float* tl, const LAS float* qinv, int lane) {
#pragma unroll
    for (int i = 0; i < 16; ++i) {
        const int id = lane + 64 * i, row = id >> 4, c4 = (id & 15) * 4;
        tl[row * 65 + c4 + 0] = v[i][0]; tl[row * 65 + c4 + 1] = v[i][1]; tl[row * 65 + c4 + 2] = v[i][2]; tl[row * 65 + c4 + 3] = v[i][3];
    }
#pragma unroll
    for (int i = 0; i < 4; ++i) {
        const int id = lane + 64 * i, cc = id >> 2, kc = id & 3;
        if (cc < ncv) {
            const int c = cbase + cc, drow = j.r0 + (c / j.cb) * j.rb + (c % j.cb);
            const float qi = qinv[cc];
            u32x4 o;
#pragma unroll
            for (int q = 0; q < 4; ++q) o[q] = pack_i8x4(tl[(16 * kc + 4 * q + 0) * 65 + cc] * qi, tl[(16 * kc + 4 * q + 1) * 65 + cc] * qi, tl[(16 * kc + 4 * q + 2) * 65 + cc] * qi, tl[(16 * kc + 4 * q + 3) * 65 + cc] * qi);
            *(u32x4*)(dst8 + (size_t)drow * 2048 + kt * 64 + 16 * kc) = o;
        }
    }
}
__device__ __forceinline__ void conv8_unit(const Params& p, LAS uchar* lds, int u, int tid) {
    const int lane = tid & 63, wave = tid >> 6;
    ConvJob j; int ct; uchar* dst8; float* scl;
    conv8_locate(u, p, j, ct, dst8, scl);
    LAS float* tl = (LAS float*)(lds + wave * 16640); LAS float* red = (LAS float*)(lds + 8 * 16640);
    const int cbase = ct * 64, ncv = (j.nc - cbase) < 64 ? (j.nc - cbase) : 64, kt0 = wave * 4;
    f32x4 va[16], vb[16];
    f32x4 mx = {0.f, 0.f, 0.f, 0.f};
    conv8_load(va, j, kt0, ct, lane);
#pragma unroll 1
    for (int tt = 0; tt < 4; tt += 2) {
        conv8_load(vb, j, kt0 + tt + 1, ct, lane);
        conv8_max(mx, va);
        conv8_load(va, j, kt0 + ((tt + 2) & 3), ct, lane);
        conv8_max(mx, vb);
    }
#pragma unroll
    for (int q = 0; q < 4; ++q) { mx[q] = fmaxf(mx[q], __shfl_xor(mx[q], 16)); mx[q] = fmaxf(mx[q], __shfl_xor(mx[q], 32)); }
    if (lane < 16) { red[wave * 64 + lane * 4 + 0] = mx[0]; red[wave * 64 + lane * 4 + 1] = mx[1]; red[wave * 64 + lane * 4 + 2] = mx[2]; red[wave * 64 + lane * 4 + 3] = mx[3]; }
    __syncthreads();
    float m = 0.f;
#pragma unroll
    for (int w = 0; w < 8; ++w) m = fmaxf(m, red[w * 64 + lane]);
    __syncthreads();
    if (wave == 0) { red[lane] = m > 0.f ? 127.0f / m : 0.f; if (lane < ncv) { const int c = cbase + lane; scl[j.r0 + (c / j.cb) * j.rb + (c % j.cb)] = m * (1.0f / 127.0f); } }
    __syncthreads();
#pragma unroll 1
    for (int tt = 0; tt < 4; tt += 2) {
        conv8_load(vb, j, kt0 + tt + 1, ct, lane);
        conv8_store(va, j, kt0 + tt, cbase, ncv, dst8, tl, red, lane);
        if (tt == 0) conv8_load(va, j, kt0 + 2, ct, lane);
        conv8_store(vb, j, kt0 + tt + 1, cbase, ncv, dst8, tl, red, lane);
    }
    __syncthreads();
}

__device__ __forceinline__ void phase_prologue(const Params& p, LAS uchar* lds) {
    const int tid = tid_opaque(), lane = tid & 63, wave = tid >> 6;
    const int gw = blockIdx.x * NWAVES + wave, nw = gridDim.x * NWAVES;
    uchar* ws = p.ws;
    {
        LAS float* cact = (LAS float*)lds; LAS float* red = (LAS float*)(lds + 8192);
        for (int i = tid; i < D; i += NTHREADS) cact[i] = siluf_(p.in[I_C][i]);
        __syncthreads();
        float* mod = (float*)(ws + WS_MOD);
        const int col = lane & 31, kh = lane >> 5;
        for (int u = blockIdx.x; u < 768; u += gridDim.x) {
            const int l = u / 384, c0 = (u % 384) * 32;
            const float* w = p.in[I_ADAW] + (size_t)l * 2048 * 12288 + c0 + col + (size_t)(wave * 256 + kh) * 12288;
            float acc = 0.f;
#pragma unroll 32
            for (int kk = 0; kk < 128; ++kk) acc += cact[wave * 256 + 2 * kk + kh] * w[(size_t)kk * 2 * 12288];
            acc += __shfl_xor(acc, 32);
            if (kh == 0) red[wave * 32 + col] = acc;
            __syncthreads();
            if (tid < 32) { float s = p.in[I_ADAB][l * 12288 + c0 + tid];
#pragma unroll
                for (int q = 0; q < 8; ++q) s += red[q * 32 + tid];
                mod[l * 12288 + c0 + tid] = s; }
            __syncthreads();
        }
    }
    {
        LAS float* red = (LAS float*)(lds + 8192);
        for (int u = blockIdx.x; u < 64; u += gridDim.x) {
            const int kind = u >> 5, half = (u >> 4) & 1, ks = u & 15, col = half * 64 + lane;
            const float* pe = p.in[I_PE] + (size_t)kind * 4096 + ks * 256 + wave * 32;
            const float* w = p.in[I_CW1] + ((size_t)kind * 4096 + ks * 256 + wave * 32) * 128 + col;
            float acc = 0.f;
#pragma unroll
            for (int k = 0; k < 32; ++k) acc += pe[k] * w[(size_t)k * 128];
            red[wave * 64 + lane] = acc;
            __syncthreads();
            if (wave == 0) { float s_ = 0.f;
#pragma unroll
                for (int q = 0; q < 8; ++q) s_ += red[q * 64 + lane];
                ((float*)(ws + WS_PEBP))[(ks * 2 + kind) * 128 + col] = s_; }
            __syncthreads();
        }
    }
    __syncthreads();
    for (int u = blockIdx.x; u < N_CONV8_UNITS; u += gridDim.x) conv8_unit(p, lds, u, tid_opaque());
    {
        const int tid = tid_opaque(), lane = tid & 63, wave = tid >> 6, nw = gridDim.x * NWAVES;
        LAS float* tl = (LAS float*)(lds + wave * 16640);
        f32x4 va[16], vb[16];
        ConvJob ja, jb; int kta = 0, cta = 0, ktb = 0, ctb = 0;
        const int G_ = gridDim.x, nfree = G_ > N_CONV8_UNITS ? G_ - N_CONV8_UNITS : 0;
        const int vblk = nfree ? ((int)blockIdx.x >= N_CONV8_UNITS ? (int)blockIdx.x - N_CONV8_UNITS : (int)blockIdx.x + nfree) : (int)blockIdx.x;
        int t = vblk * NWAVES + wave;
        bool ha = conv_locate(t, p, ja, kta, cta);
        if (ha) conv_load(va, ja, kta, cta, lane);
        while (ha) {
            const bool hb = conv_locate(t + nw, p, jb, ktb, ctb);
            if (hb) conv_load(vb, jb, ktb, ctb, lane);
            conv_store(va, ja, kta, cta, tl, lane);
            if (!hb) break;
            t += 2 * nw;
            ha = conv_locate(t, p, ja, kta, cta);
            if (ha) conv_load(va, ja, kta, cta, lane);
            conv_store(vb, jb, ktb, ctb, tl, lane);
        }
    }
    __syncthreads();
}

template <bool COMBINE, bool FINAL, bool Q8 = false, bool XBF = false>
__device__ __forceinline__ void phase_norm(const void* xin_, const float* gain, const float* sh, const float* sc, bf16_t* out_bf, float* out_f32,
                                           const bf16_t* yb, const int* tokrow, const float* tokw, const float* g2, bf16_t* xout, uchar* out8 = nullptr, float* rowscale = nullptr) {
    const float* xin = (const float*)xin_; const bf16_t* xinb = (const bf16_t*)xin_;
    const int tid = tid_opaque(), lane = tid & 63, wave = tid >> 6;
    for (int r = blockIdx.x * NWAVES + wave; r < T; r += gridDim.x * NWAVES) {
        f32x4 v[8];
#pragma unroll
        for (int i = 0; i < 8; ++i) {
            if constexpr (XBF) { const u32x2 w = *(const u32x2*)(xinb + (size_t)r * D + (i * 64 + lane) * 4); v[i] = (f32x4){bf_lo(w[0]), bf_hi(w[0]), bf_lo(w[1]), bf_hi(w[1])}; }
            else v[i] = *(const f32x4*)(xin + (size_t)r * D + (i * 64 + lane) * 4);
        }
        if (COMBINE) {
            const int r0 = tokrow[2 * r], r1 = tokrow[2 * r + 1]; const float w0 = tokw[2 * r], w1 = tokw[2 * r + 1];
#pragma unroll
            for (int i = 0; i < 8; ++i) {
                const int c = (i * 64 + lane) * 4;
                const u32x2 a = *(const u32x2*)(yb + (size_t)r0 * D + c), b = *(const u32x2*)(yb + (size_t)r1 * D + c);
                const f32x4 g = *(const f32x4*)(g2 + c);
                v[i][0] += g[0] * (w0 * bf_lo(a[0]) + w1 * bf_lo(b[0])); v[i][1] += g[1] * (w0 * bf_hi(a[0]) + w1 * bf_hi(b[0]));
                v[i][2] += g[2] * (w0 * bf_lo(a[1]) + w1 * bf_lo(b[1])); v[i][3] += g[3] * (w0 * bf_hi(a[1]) + w1 * bf_hi(b[1]));
                if (xout) { u32x2 w; w[0] = cvt_pk_bf16(v[i][0], v[i][1]); w[1] = cvt_pk_bf16(v[i][2], v[i][3]); *(u32x2*)(xout + (size_t)r * D + c) = w; }
            }
        }
        float ss = 0.f;
#pragma unroll
        for (int i = 0; i < 8; ++i) ss += v[i][0] * v[i][0] + v[i][1] * v[i][1] + v[i][2] * v[i][2] + v[i][3] * v[i][3];
        ss = wave_sum(ss);
        const float inv = rsqrtf(ss * (1.0f / D) + 1e-6f);
        if constexpr (Q8) {
            float mx = 0.f;
#pragma unroll
            for (int i = 0; i < 8; ++i) {
                const int c = (i * 64 + lane) * 4;
                const f32x4 g = *(const f32x4*)(gain + c), s1 = *(const f32x4*)(sc + c), s0 = *(const f32x4*)(sh + c);
#pragma unroll
                for (int q = 0; q < 4; ++q) { v[i][q] = v[i][q] * inv * g[q] * (1.0f + s1[q]) + s0[q]; mx = fmaxf(mx, fabsf(v[i][q])); }
            }
            mx = wave_max(mx);
            const float qs = mx > 0.f ? 127.0f / mx : 0.f;
            if (lane == 0) rowscale[r] = mx * (1.0f / 127.0f);
#pragma unroll
            for (int i = 0; i < 8; ++i) *(unsigned*)(out8 + (size_t)r * D + (i * 64 + lane) * 4) = pack_i8x4(v[i][0] * qs, v[i][1] * qs, v[i][2] * qs, v[i][3] * qs);
            continue;
        }
#pragma unroll
        for (int i = 0; i < 8; ++i) {
            const int c = (i * 64 + lane) * 4;
            const f32x4 g = *(const f32x4*)(gain + c);
            f32x4 y; y[0] = v[i][0] * inv * g[0]; y[1] = v[i][1] * inv * g[1]; y[2] = v[i][2] * inv * g[2]; y[3] = v[i][3] * inv * g[3];
            if (FINAL) { *(f32x4*)(out_f32 + (size_t)r * D + c) = y; }
            else {
                const f32x4 s1 = *(const f32x4*)(sc + c), s0 = *(const f32x4*)(sh + c);
                u32x2 o; o[0] = cvt_pk_bf16(y[0] * (1.0f + s1[0]) + s0[0], y[1] * (1.0f + s1[1]) + s0[1]); o[1] = cvt_pk_bf16(y[2] * (1.0f + s1[2]) + s0[2], y[3] * (1.0f + s1[3]) + s0[3]);
                *(u32x2*)(out_bf + (size_t)r * D + c) = o;
            }
        }
    }
}
struct SchedNoHooks {
    __device__ __forceinline__ void a_ready(const pg8::Unit&) const {}
    __device__ __forceinline__ void done(const pg8::Unit&) const {}
};
struct SchedDense2 : SchedNoHooks {
    const char* A1; const char* B1; const char* A2; const char* B2; int nM1, nN1, nM2, nN2, G, c; size_t tstep; int aux1 = 0, aux2 = 1; bool mix32 = false;
    __device__ __forceinline__ bool next(int i, pg8::Unit& u) const {
        int L = i * G + c; const int n1 = nM1 * nN1, n2 = nM2 * nN2;
        if (L >= n1 + n2) return false;
        if (L < n1) { pg8::static_tile(L, nM1, nN1, u.pm, u.pn); if (mix32) u.pn = ((u.pn >> 2) & 3) * 8 + (u.pn & 3) + 4 * (u.pn >> 4); u.a = A1 + (size_t)u.pm * tstep; u.b = B1 + (size_t)u.pn * tstep; u.aux = aux1; }
        else { L -= n1; pg8::static_tile(L, nM2, nN2, u.pm, u.pn); u.a = A2 + (size_t)u.pm * tstep; u.b = B2 + (size_t)u.pn * tstep; u.aux = aux2; }
        return true;
    }
};
struct SchedSplitK : SchedNoHooks {
    const char* A; const char* B; int G, c; size_t tstep;
    __device__ __forceinline__ bool next(int i, pg8::Unit& u) const {
        const int L = i * G + c;
        if (L >= 256) return false;
        u.pm = L >> 3; u.pn = 0; u.aux = L & 7; u.a = A + (size_t)u.pm * tstep + (size_t)u.aux * 512; u.b = B + (size_t)u.aux * 512;
        return true;
    }
};
struct SchedMoe : SchedNoHooks {
    const char* A; const char* B; const LAS int* tile_e; int ntiles, npn, G, c; size_t tstep, estride;
    __device__ __forceinline__ bool next(int i, pg8::Unit& u) const {
        const int L = i * G + c;
        if (L >= ntiles * npn) return false;
        const int tile = L / npn, pn = L - tile * npn, e = __builtin_amdgcn_readfirstlane(tile_e[tile]);
        u.pm = tile; u.pn = pn; u.aux = e; u.a = A + (size_t)tile * tstep; u.b = B + (size_t)e * estride + (size_t)pn * tstep;
        return true;
    }
};

#define EPI_LOOP_ROWS _Pragma("unroll") for (int ai = 0; ai < 2; ++ai) _Pragma("unroll") for (int m = 0; m < 4; ++m)
#define EPI_LOOP_COLS _Pragma("unroll") for (int bj = 0; bj < 2; ++bj) _Pragma("unroll") for (int n = 0; n < 2; ++n)

struct EpiWin0 {
    static constexpr bool PERM = false, AFTER_DRAIN = false, I8 = true;
    bf16_t* q; bf16_t* kb; bf16_t* vt; bf16_t* y; float* xbr; float* gate; const float* sc_tok; const float* sc_w; const float* sc_wv;
    __device__ __forceinline__ void scales(const pg8::Unit& u, const float*& rs, const float*& cs) const {
        if (u.aux == 1) { rs = sc_wv; cs = sc_tok; } else { rs = sc_tok; cs = u.aux == 2 ? sc_w + 4096 : sc_w; } }
    __device__ __forceinline__ void operator()(const f32x4 (&acc)[2][2][4][2], const pg8::Unit& u, int wr, int wc, int fr, int fq) const {
        const int row0 = u.pm * 256 + wr * 64 + fr, cl0 = wc * 32 + 4 * fq;
        if (u.aux == 1) {
            EPI_LOOP_ROWS { bf16_t* rowp = vt + (size_t)(row0 + ai * 128 + m * 16) * TV + u.pn * 256 + cl0;
                EPI_LOOP_COLS { const f32x4 v = acc[ai][bj][m][n]; u32x2 o; o[0] = cvt_pk_bf16(v[0], v[1]); o[1] = cvt_pk_bf16(v[2], v[3]); *(u32x2*)(rowp + bj * 128 + n * 16) = o; } }
            return;
        }
        const int pn = u.aux == 2 ? 16 : u.pn;
        if (pn < 4) {
            EPI_LOOP_ROWS { bf16_t* rowp = q + (size_t)(row0 + ai * 128 + m * 16) * 1024 + pn * 256 + cl0;
                EPI_LOOP_COLS { const f32x4 v = acc[ai][bj][m][n] * 0.08838834764831845f; u32x2 o; o[0] = cvt_pk_bf16(v[0], v[1]); o[1] = cvt_pk_bf16(v[2], v[3]); *(u32x2*)(rowp + bj * 128 + n * 16) = o; } }
        } else if (pn < 8) {
            EPI_LOOP_ROWS {
                EPI_LOOP_COLS { bf16_t* dst = kb + ((size_t)((pn - 4) * 2 + bj) * TP + (row0 + ai * 128 + m * 16)) * 128 + cl0 + n * 16;
                    const f32x4 v = acc[ai][bj][m][n]; u32x2 o; o[0] = cvt_pk_bf16(v[0], v[1]); o[1] = cvt_pk_bf16(v[2], v[3]); *(u32x2*)dst = o; } }
        } else if (pn < 12) {
            EPI_LOOP_ROWS { bf16_t* rowp = y + (size_t)(row0 + ai * 128 + m * 16) * 1024 + (pn - 8) * 256 + cl0;
                EPI_LOOP_COLS { const f32x4 v = acc[ai][bj][m][n]; u32x2 o; o[0] = cvt_pk_bf16(geluf_(v[0]), geluf_(v[1])); o[1] = cvt_pk_bf16(geluf_(v[2]), geluf_(v[3])); *(u32x2*)(rowp + bj * 128 + n * 16) = o; } }
        } else if (pn < 16) {
            EPI_LOOP_ROWS { float* rowp = xbr + (size_t)(row0 + ai * 128 + m * 16) * 1024 + (pn - 12) * 256 + cl0;
                EPI_LOOP_COLS *(f32x4*)(rowp + bj * 128 + n * 16) = acc[ai][bj][m][n]; }
        } else {
            EPI_LOOP_ROWS { float* rowp = gate + (size_t)(row0 + ai * 128 + m * 16) * 24;
#pragma unroll
                for (int n = 0; n < 2; ++n) { const int c = cl0 + n * 16; if (c < 24) { const f32x4 v = acc[ai][0][m][n]; f32x4 o; o[0] = sigmoidf_(v[0]); o[1] = sigmoidf_(v[1]); o[2] = sigmoidf_(v[2]); o[3] = sigmoidf_(v[3]); *(f32x4*)(rowp + c) = o; } } }
        }
    }
};
template <bool XBF> struct EpiResid {
    static constexpr bool PERM = false, AFTER_DRAIN = false, I8 = false;
    const void* xin; const float* g; bf16_t* xout;
    __device__ __forceinline__ void operator()(const f32x4 (&acc)[2][2][4][2], const pg8::Unit& u, int wr, int wc, int fr, int fq) const {
        const int row0 = u.pm * 256 + wr * 64 + fr, col0 = u.pn * 256 + wc * 32 + 4 * fq;
        f32x4 gv[2][2];
        EPI_LOOP_COLS gv[bj][n] = *(const f32x4*)(g + col0 + bj * 128 + n * 16);
        EPI_LOOP_ROWS { const size_t ro = (size_t)(row0 + ai * 128 + m * 16) * D + col0;
            EPI_LOOP_COLS { f32x4 xi;
                if constexpr (XBF) { const u32x2 w = *(const u32x2*)((const bf16_t*)xin + ro + bj * 128 + n * 16); xi = (f32x4){bf_lo(w[0]), bf_hi(w[0]), bf_lo(w[1]), bf_hi(w[1])}; }
                else xi = *(const f32x4*)((const float*)xin + ro + bj * 128 + n * 16);
                const f32x4 y = xi + gv[bj][n] * acc[ai][bj][m][n];
                u32x2 o; o[0] = cvt_pk_bf16(y[0], y[1]); o[1] = cvt_pk_bf16(y[2], y[3]); *(u32x2*)(xout + ro + bj * 128 + n * 16) = o; } }
    }
};
struct EpiLogit {
    static constexpr bool PERM = false, AFTER_DRAIN = false, I8 = false;
    float* logit;
    __device__ __forceinline__ void operator()(const f32x4 (&acc)[2][2][4][2], const pg8::Unit& u, int wr, int wc, int fr, int fq) const {
        const int row0 = u.pm * 256 + wr * 64 + fr, cl0 = wc * 32 + 4 * fq;
        EPI_LOOP_ROWS { float* rowp = logit + ((size_t)u.aux * T + (row0 + ai * 128 + m * 16)) * LOGIT_LD;
#pragma unroll
            for (int n = 0; n < 2; ++n) { const int c = cl0 + n * 16; if (c < 72) *(f32x4*)(rowp + c) = acc[ai][0][m][n]; } }
    }
};
struct EpiMoe1 {
    static constexpr bool PERM = false, AFTER_DRAIN = false, I8 = false;
    bf16_t* hid;
    __device__ __forceinline__ void operator()(const f32x4 (&acc)[2][2][4][2], const pg8::Unit& u, int wr, int wc, int fr, int fq) const {
        const int row0 = u.pm * 256 + wr * 64 + fr, col0 = u.pn * 128 + wc * 32 + 4 * fq;
        EPI_LOOP_ROWS { bf16_t* rowp = hid + (size_t)(row0 + ai * 128 + m * 16) * 512 + col0;
#pragma unroll
            for (int n = 0; n < 2; ++n) { const f32x4 a = acc[ai][0][m][n], b = acc[ai][1][m][n];
                u32x2 o; o[0] = cvt_pk_bf16(siluf_(a[0]) * b[0], siluf_(a[1]) * b[1]); o[1] = cvt_pk_bf16(siluf_(a[2]) * b[2], siluf_(a[3]) * b[3]); *(u32x2*)(rowp + n * 16) = o; } }
    }
};
struct EpiBf16Plain {
    static constexpr bool PERM = false, AFTER_DRAIN = false, I8 = false;
    bf16_t* out; int ld;
    __device__ __forceinline__ void operator()(const f32x4 (&acc)[2][2][4][2], const pg8::Unit& u, int wr, int wc, int fr, int fq) const {
        const int row0 = u.pm * 256 + wr * 64 + fr, col0 = u.pn * 256 + wc * 32 + 4 * fq;
        EPI_LOOP_ROWS { bf16_t* rowp = out + (size_t)(row0 + ai * 128 + m * 16) * ld + col0;
            EPI_LOOP_COLS { const f32x4 v = acc[ai][bj][m][n]; u32x2 o; o[0] = cvt_pk_bf16(v[0], v[1]); o[1] = cvt_pk_bf16(v[2], v[3]); *(u32x2*)(rowp + bj * 128 + n * 16) = o; } }
    }
};
struct EpiWin1 {
    static constexpr bool PERM = false, AFTER_DRAIN = false, I8 = true;
    uchar* ws; const float* lbl;
    __device__ __forceinline__ void scales(const pg8::Unit&, const float*& rs, const float*& cs) const { rs = (const float*)(ws + WS_SC_TOK); cs = (const float*)(ws + WS_SC_W1); }
    __device__ __forceinline__ void operator()(const f32x4 (&acc)[2][2][4][2], const pg8::Unit& u, int wr, int wc, int fr, int fq) const {
        const int row0 = u.pm * 256 + wr * 64 + fr, sec = u.pn >> 3, col0 = (u.pn & 7) * 256 + wc * 32 + 4 * fq;
        if (sec == 1) {
            float* logf = (float*)(ws + V_LOGF); bf16_t* kk = (bf16_t*)(ws + V_KK);
            EPI_LOOP_COLS { const int c = col0 + bj * 128 + n * 16; const f32x4 l0 = *(const f32x4*)(lbl + c), l1 = *(const f32x4*)(lbl + 2048 + c);
                f32x4 lb;
#pragma unroll
                for (int i = 0; i < 4; ++i) lb[i] = sigmoidf_(l1[i] - l0[i]);
                EPI_LOOP_ROWS { const size_t ro = (size_t)(row0 + ai * 128 + m * 16) * 2048 + c;
                    const f32x4 z = acc[ai][bj][m][n]; f32x4 lf; float kv[4];
#pragma unroll
                    for (int i = 0; i < 4; ++i) { const float l = lb[i], sg = sigmoidf_(z[i]); const float f = l + (1.0f - l) * sg; lf[i] = __logf(fmaxf(f, 1e-30f)); kv[i] = (1.0f - l) * (1.0f - sg); }
                    *(f32x4*)(logf + ro) = lf;
                    u32x2 o; o[0] = cvt_pk_bf16(kv[0], kv[1]); o[1] = cvt_pk_bf16(kv[2], kv[3]); *(u32x2*)(kk + ro) = o; } }
            return;
        }
        const size_t doff = sec == 0 ? V_QS : (sec == 2 ? V_V : V_GS);
        bf16_t* dst = (bf16_t*)(ws + doff);
        EPI_LOOP_ROWS { bf16_t* rowp = dst + (size_t)(row0 + ai * 128 + m * 16) * 2048 + col0;
            EPI_LOOP_COLS { f32x4 z = acc[ai][bj][m][n];
                if (sec != 2) { z[0] = siluf_(z[0]); z[1] = siluf_(z[1]); z[2] = siluf_(z[2]); z[3] = siluf_(z[3]); }
                u32x2 o; o[0] = cvt_pk_bf16(z[0], z[1]); o[1] = cvt_pk_bf16(z[2], z[3]); *(u32x2*)(rowp + bj * 128 + n * 16) = o; } }
    }
};
__device__ __forceinline__ void compress_unit(const Params& p, LAS uchar* lds, int u) {
    const int tid = tid_opaque(), lane = tid & 63, wave = tid >> 6, fr = lane & 15, fq = lane >> 4;
    const int kind = u >> 5, g = (u >> 4) & 1, mt = u & 15;
    uchar* ws = p.ws;
    const bf16_t* src = (const bf16_t*)(ws + U_KB) + (size_t)(kind * 2 + g) * TP * 128;
    const bf16_t* W1 = (const bf16_t*)(ws + WS_WC1T) + (size_t)kind * 128 * 4096;
    const bf16_t* W2 = (const bf16_t*)(ws + WS_WC2T) + (size_t)kind * 128 * 128;
    LAS float* slab = (LAS float*)lds;
    LAS bf16_t* hidl = (LAS bf16_t*)(lds + 131072);
    f32x4 acc[2][8];
#pragma unroll
    for (int m = 0; m < 2; ++m)
#pragma unroll
        for (int n = 0; n < 8; ++n) acc[m][n] = (f32x4){0.f, 0.f, 0.f, 0.f};
    const int kbeg = wave * 512;
    {
        const bf16_t* ap = src + (size_t)(mt * 32 + fr) * 2048 + kbeg + 8 * fq; const bf16_t* bp = W1 + (size_t)fr * 4096 + kbeg + 8 * fq;
        bf16x8 a0[2], b0[8], a1[2], b1[8];
#define CU_LOAD(A, B, KS) do { _Pragma("unroll") for (int m = 0; m < 2; ++m) A[m] = *(const bf16x8*)(ap + (size_t)(m * 16) * 2048 + (KS) * 32); \
        _Pragma("unroll") for (int n = 0; n < 8; ++n) B[n] = *(const bf16x8*)(bp + (size_t)(n * 16) * 4096 + (KS) * 32); } while (0)
#define CU_MMA(A, B) do { _Pragma("unroll") for (int m = 0; m < 2; ++m) _Pragma("unroll") for (int n = 0; n < 8; ++n) acc[m][n] = __builtin_amdgcn_mfma_f32_16x16x32_bf16(A[m], B[n], acc[m][n], 0, 0, 0); \
        __builtin_amdgcn_sched_barrier(0); } while (0)
        CU_LOAD(a0, b0, 0);
#pragma unroll
        for (int ks = 0; ks < 16; ks += 2) {
            CU_LOAD(a1, b1, ks + 1); CU_MMA(a0, b0);
            if (ks + 2 < 16) CU_LOAD(a0, b0, ks + 2);
            CU_MMA(a1, b1);
        }
#undef CU_LOAD
#undef CU_MMA
    }
#pragma unroll
    for (int m = 0; m < 2; ++m)
#pragma unroll
        for (int n = 0; n < 8; ++n)
#pragma unroll
            for (int j = 0; j < 4; ++j) slab[(wave * 32 + m * 16 + fq * 4 + j) * 128 + n * 16 + fr] = acc[m][n][j];
    __syncthreads();
    {
        const float* pebp = (const float*)(ws + WS_PEBP);
        for (int e = tid; e < 32 * 128; e += NTHREADS) {
            const int r = e >> 7, c = e & 127;
            float s = p.in[I_CB1][kind * 128 + c];
#pragma unroll
            for (int q = 0; q < 16; ++q) s += pebp[(q * 2 + kind) * 128 + c];
#pragma unroll
            for (int w = 0; w < 8; ++w) s += slab[(w * 32 + r) * 128 + c];
            hidl[r * 136 + c] = f2bf(geluf_(s));
        }
    }
    __syncthreads();
    {
        f32x4 o[2] = {(f32x4){0.f, 0.f, 0.f, 0.f}, (f32x4){0.f, 0.f, 0.f, 0.f}};
#pragma unroll
        for (int ks = 0; ks < 4; ++ks) {
            const bf16x8 b = *(const bf16x8*)(W2 + (size_t)(wave * 16 + fr) * 128 + ks * 32 + 8 * fq);
#pragma unroll
            for (int m = 0; m < 2; ++m) { const bf16x8 a = *(const LAS bf16x8*)(hidl + (m * 16 + fr) * 136 + ks * 32 + 8 * fq); o[m] = __builtin_amdgcn_mfma_f32_16x16x32_bf16(a, b, o[m], 0, 0, 0); }
        }
        const int col = wave * 16 + fr; const float b2 = p.in[I_CB2][kind * 128 + col];
#pragma unroll
        for (int m = 0; m < 2; ++m)
#pragma unroll
            for (int j = 0; j < 4; ++j) {
                const int n = mt * 32 + m * 16 + fq * 4 + j; const float v = (n < 511) ? o[m][j] + b2 : 0.f;
                if (kind == 0) ((bf16_t*)(ws + U_KCMP))[((size_t)g * 512 + n) * 128 + col] = f2bf(v);
                else ((bf16_t*)(ws + U_VCMPT))[((size_t)g * 128 + col) * 512 + n] = f2bf(v);
            }
    }
    __syncthreads();
}

__device__ __forceinline__ void lru_xload(float (&x)[19], const uchar* ws, int u, int tid) {
    const int cc = u >> 3, nb = u & 7, tb = cc * 64 + (tid >> 7) * 16 - 3;
    const float* xbr = (const float*)(ws + U_XBR) + nb * 128 + (tid & 127);
#pragma unroll
    for (int i = 0; i < 19; ++i) { const int t = tb + i; x[i] = t >= 0 ? xbr[(size_t)t * 1024] : 0.f; }
}
__device__ __forceinline__ void lru_local_unit(const Params& p, LAS uchar* lds, int u, int unext, float (&x)[19]) {
    const int tid = tid_opaque(), lane = tid & 63, wave = tid >> 6, fr = lane & 15, fq = lane >> 4;
    const int cc = u >> 3, nb = u & 7, t0 = cc * 64, ch0 = nb * 128;
    uchar* ws = p.ws;
    LAS float* xc = (LAS float*)lds;
    LAS bf16_t* xcb = (LAS bf16_t*)(lds + 32768);
    LAS float* la = (LAS float*)(lds + 50176);
    LAS float* bb = (LAS float*)(lds + 82944);
    LAS float* segh = (LAS float*)(lds + 115712);
    LAS float* segl = (LAS float*)(lds + 117760);
    {
        const int ch = tid & 127, sg = tid >> 7;
        const float w0 = p.in[I_CONVW][0 * 1024 + ch0 + ch], w1 = p.in[I_CONVW][1 * 1024 + ch0 + ch], w2 = p.in[I_CONVW][2 * 1024 + ch0 + ch], w3 = p.in[I_CONVW][3 * 1024 + ch0 + ch];
        const float cb = p.in[I_CONVB][ch0 + ch];
#pragma unroll
        for (int i = 0; i < 16; ++i) {
            const int r = sg * 16 + i;
            const float v = x[i] * w0 + x[i + 1] * w1 + x[i + 2] * w2 + x[i + 3] * w3 + cb;
            xc[r * 128 + ch] = v; xcb[r * 136 + ch] = f2bf(v);
        }
        if (unext >= 0) lru_xload(x, ws, unext, tid);
    }
    __syncthreads();
    {
        const bf16_t* WA = (const bf16_t*)(ws + WS_WAT) + (size_t)nb * 16384, * WI = (const bf16_t*)(ws + WS_WIT) + (size_t)nb * 16384;
        f32x4 ra[4], ia[4];
#pragma unroll
        for (int m = 0; m < 4; ++m) { ra[m] = (f32x4){0.f, 0.f, 0.f, 0.f}; ia[m] = (f32x4){0.f, 0.f, 0.f, 0.f}; }
#pragma unroll
        for (int ks = 0; ks < 4; ++ks) {
            const bf16x8 ba = *(const bf16x8*)(WA + (size_t)(wave * 16 + fr) * 128 + ks * 32 + 8 * fq), bi = *(const bf16x8*)(WI + (size_t)(wave * 16 + fr) * 128 + ks * 32 + 8 * fq);
#pragma unroll
            for (int m = 0; m < 4; ++m) { const bf16x8 a = *(const LAS bf16x8*)(xcb + (m * 16 + fr) * 136 + ks * 32 + 8 * fq);
                ra[m] = __builtin_amdgcn_mfma_f32_16x16x32_bf16(a, ba, ra[m], 0, 0, 0); ia[m] = __builtin_amdgcn_mfma_f32_16x16x32_bf16(a, bi, ia[m], 0, 0, 0); }
        }
        const int e = wave * 16 + fr;
        const float bav = p.in[I_LBA][ch0 + e], biv = p.in[I_LBI][ch0 + e];
        const float sp = log1pf(__expf(-p.in[I_LAMBDA][ch0 + e]));
#pragma unroll
        for (int m = 0; m < 4; ++m)
#pragma unroll
            for (int j = 0; j < 4; ++j) {
                const int r = m * 16 + fq * 4 + j;
                const float rg = sigmoidf_(ra[m][j] + bav), ig = sigmoidf_(ia[m][j] + biv);
                const float lg = -8.0f * rg * sp;
                la[r * 128 + e] = lg;
                bb[r * 128 + e] = __builtin_amdgcn_sqrtf(fmaxf(1.0f - __expf(2.0f * lg), 0.f)) * (ig * xc[r * 128 + e]);
            }
    }
    __syncthreads();
    {
        const int ch = tid & 127, sg = tid >> 7;
        float h = 0.f, cl = 0.f;
        for (int r = sg * 16; r < sg * 16 + 16; ++r) { const float lg = la[r * 128 + ch]; h = __expf(lg) * h + bb[r * 128 + ch]; cl += lg; bb[r * 128 + ch] = h; la[r * 128 + ch] = cl; }
        segh[sg * 128 + ch] = h; segl[sg * 128 + ch] = cl;
        __syncthreads();
        float carry = 0.f, lpre = 0.f;
        for (int s = 0; s < sg; ++s) { carry = segh[s * 128 + ch] + __expf(segl[s * 128 + ch]) * carry; lpre += segl[s * 128 + ch]; }
        float* hloc = (float*)(ws + U_HLOC); float* pc = (float*)(ws + U_PC);
        float hl = 0.f, pl = 0.f;
        for (int r = sg * 16; r < sg * 16 + 16; ++r) {
            const float pw = __expf(la[r * 128 + ch]);
            hl = bb[r * 128 + ch] + pw * carry; pl = pw * __expf(lpre);
            hloc[(size_t)(t0 + r) * 1024 + ch0 + ch] = hl; pc[(size_t)(t0 + r) * 1024 + ch0 + ch] = pl;
        }
        if (sg == 3) { ((float*)(ws + U_HEND))[cc * 1024 + ch0 + ch] = hl; ((float*)(ws + U_PEND))[cc * 1024 + ch0 + ch] = pl; }
    }
    __syncthreads();
}

__device__ __forceinline__ void lru_fix_unit(const Params& p, int u) {
    const int tid = tid_opaque(), cc = u >> 1, rh = (u & 1) * 32;
    uchar* ws = p.ws;
    const float* hend = (const float*)(ws + U_HEND); const float* pend = (const float*)(ws + U_PEND);
    const int ch = 2 * tid;
    float c0 = 0.f, c1 = 0.f;
    int c = 0;
    for (; c + 8 <= cc; c += 8) {
        float2 he[8], pe[8];
#pragma unroll
        for (int i = 0; i < 8; ++i) { he[i] = *(const float2*)(hend + (c + i) * 1024 + ch); pe[i] = *(const float2*)(pend + (c + i) * 1024 + ch); }
#pragma unroll
        for (int i = 0; i < 8; ++i) { c0 = he[i].x + pe[i].x * c0; c1 = he[i].y + pe[i].y * c1; }
    }
    for (; c < cc; ++c) {
        const float2 he = *(const float2*)(hend + c * 1024 + ch), pe = *(const float2*)(pend + c * 1024 + ch);
        c0 = he.x + pe.x * c0; c1 = he.y + pe.y * c1;
    }
    const float* hloc = (const float*)(ws + U_HLOC); const float* pc = (const float*)(ws + U_PC);
    const bf16_t* y = (const bf16_t*)(ws + U_Y); bf16_t* cat = (bf16_t*)(ws + U_CAT);
#pragma unroll 1
    for (int rb = 0; rb < 32; rb += 8) {
        float2 h[8], pw[8]; unsigned yy[8];
#pragma unroll
        for (int i = 0; i < 8; ++i) { const size_t t = (size_t)cc * 64 + rh + rb + i; h[i] = *(const float2*)(hloc + t * 1024 + ch); pw[i] = *(const float2*)(pc + t * 1024 + ch); yy[i] = *(const unsigned*)(y + t * 1024 + ch); }
#pragma unroll
        for (int i = 0; i < 8; ++i) { const size_t t = (size_t)cc * 64 + rh + rb + i;
            *(unsigned*)(cat + t * 2048 + 1024 + ch) = cvt_pk_bf16(bf_lo(yy[i]) * (h[i].x + pw[i].x * c0), bf_hi(yy[i]) * (h[i].y + pw[i].y * c1)); }
    }
}
constexpr int A_STG = 33792;
constexpr int A_VOFF = 16384;
constexpr int A_Q = 67584;
constexpr int A_IMP = 100352;
constexpr int A_SEL = 116864;
constexpr int A_UNI = 117376;
constexpr int A_LUT = 117392;
constexpr int A_ML = 119504;
constexpr int A_END = 121552;
constexpr int IMP_LD = 129;
#define F16ZERO (f32x16){0.f, 0.f, 0.f, 0.f, 0.f, 0.f, 0.f, 0.f, 0.f, 0.f, 0.f, 0.f, 0.f, 0.f, 0.f, 0.f}

struct AttnPre { u32x4 k0, k1, v0, v1; };
__device__ __forceinline__ void attn_issue(AttnPre& pre, const bf16_t* krow0, const bf16_t* v0, int ldv, int tid) {
    { const int row = tid >> 4, ch = tid & 15; pre.k0 = *(const u32x4*)(krow0 + (size_t)row * 128 + ch * 8); pre.k1 = *(const u32x4*)(krow0 + (size_t)(row + 32) * 128 + ch * 8); }
    { const int d = tid >> 3, ch = tid & 7; pre.v0 = *(const u32x4*)(v0 + (size_t)d * ldv + ch * 8); pre.v1 = *(const u32x4*)(v0 + (size_t)(d + 64) * ldv + ch * 8); }
}
__device__ __forceinline__ void attn_commit(const AttnPre& pre, LAS uchar* stg, int tid) {
    { const int row = tid >> 4, ch = tid & 15;
      *(LAS u32x4*)(stg + row * 256 + ((ch ^ (row & 15)) << 4)) = pre.k0; *(LAS u32x4*)(stg + (row + 32) * 256 + ((ch ^ (row & 15)) << 4)) = pre.k1; }
    { const int d = tid >> 3, ch = tid & 7;
      LAS u32x2* q0 = (LAS u32x2*)(stg + A_VOFF + d * 136 + ch * 16); q0[0] = (u32x2){pre.v0[0], pre.v0[1]}; q0[1] = (u32x2){pre.v0[2], pre.v0[3]};
      LAS u32x2* q1 = (LAS u32x2*)(stg + A_VOFF + (d + 64) * 136 + ch * 16); q1[0] = (u32x2){pre.v1[0], pre.v1[1]}; q1[1] = (u32x2){pre.v1[2], pre.v1[3]}; }
}
#define AT_LOAD(dst, ptr) asm volatile("global_load_dwordx4 %0, %1, off" : "=&v"(dst) : "v"(ptr) : "memory")
#define AT_WAIT(P, n) asm volatile("s_waitcnt vmcnt(" #n ")" : "+v"(P.k0), "+v"(P.k1), "+v"(P.v0), "+v"(P.v1) :: "memory")
__device__ __forceinline__ void at_issue(AttnPre& pre, const bf16_t* krow0, const bf16_t* v0, int ldv, int tid) {
    { const int row = tid >> 4, ch = tid & 15; const bf16_t* p0 = krow0 + (size_t)row * 128 + ch * 8; const bf16_t* p1 = krow0 + (size_t)(row + 32) * 128 + ch * 8; AT_LOAD(pre.k0, p0); AT_LOAD(pre.k1, p1); }
    { const int d = tid >> 3, ch = tid & 7; const bf16_t* p0 = v0 + (size_t)d * ldv + ch * 8; const bf16_t* p1 = v0 + (size_t)(d + 64) * ldv + ch * 8; AT_LOAD(pre.v0, p0); AT_LOAD(pre.v1, p1); }
}
struct AttnSeq { int mode, n, base, last; unsigned long long ua, ub; };
__device__ __forceinline__ int seq_next(AttnSeq& q) {
    if (q.mode == 0) { const int j = q.base < q.last ? q.base : q.last; ++q.base; return j; }
    if ((q.ua | q.ub) == 0ull) return q.last;
    int j; if (q.ua) { j = __builtin_ctzll(q.ua); q.ua &= q.ua - 1; } else { j = 64 + __builtin_ctzll(q.ub); q.ub &= q.ub - 1; }
    q.last = j; return j;
}
#define ATTN_PIPE(seq, kb, vb, ldv, COMPUTE) do { \
    const int n_ = (seq).n; int jq0_ = seq_next(seq), jq1_ = seq_next(seq), jq2_; \
    at_issue(P0, (kb) + (size_t)jq0_ * 8192, (vb) + jq0_ * 64, ldv, tid); \
    at_issue(P1, (kb) + (size_t)jq1_ * 8192, (vb) + jq1_ * 64, ldv, tid); \
    AT_WAIT(P0, 4); \
    attn_commit(P0, lds, tid); __syncthreads(); \
    for (int i_ = 0; i_ < n_; i_ += 2) { \
        jq2_ = seq_next(seq); at_issue(P0, (kb) + (size_t)jq2_ * 8192, (vb) + jq2_ * 64, ldv, tid); \
        COMPUTE(lds, jq0_); \
        AT_WAIT(P1, 4); \
        if (i_ + 1 < n_) attn_commit(P1, lds + A_STG, tid); \
        __syncthreads(); \
        jq0_ = jq1_; jq1_ = jq2_; \
        jq2_ = seq_next(seq); at_issue(P1, (kb) + (size_t)jq2_ * 8192, (vb) + jq2_ * 64, ldv, tid); \
        if (i_ + 1 < n_) { COMPUTE(lds + A_STG, jq0_); } \
        AT_WAIT(P0, 4); \
        if (i_ + 2 < n_) attn_commit(P0, lds, tid); \
        __syncthreads(); \
        jq0_ = jq1_; jq1_ = jq2_; \
    } \
    asm volatile("s_waitcnt vmcnt(0)" ::: "memory"); } while (0)

__device__ __forceinline__ f32x16 attn_qk(const LAS uchar* stg, const LAS uchar* qimg, int qrow, int kh, int r, int hh) {
    f32x16 s = F16ZERO;
    const int row = 32 * kh + r;
#pragma unroll
    for (int ks = 0; ks < 8; ++ks) {
        const bf16x8 qf = *(const LAS bf16x8*)(qimg + qrow * 256 + (((2 * ks + hh) ^ (qrow & 15)) << 4));
        const bf16x8 kf = *(const LAS bf16x8*)(stg + row * 256 + (((2 * ks + hh) ^ (row & 15)) << 4));
        s = __builtin_amdgcn_mfma_f32_32x32x16_bf16(kf, qf, s, 0, 0, 0);
    }
    return s;
}
__device__ __forceinline__ void attn_pv(const LAS uchar* stg, const f32x16& p, f32x16 (&o)[4], int kh, int r, int hh) {
    bf16x8 pb[2];
#pragma unroll
    for (int sx = 0; sx < 2; ++sx) {
        u32x4 w;
#pragma unroll
        for (int q = 0; q < 4; ++q) w[q] = cvt_pk_bf16(p[8 * sx + 2 * q], p[8 * sx + 2 * q + 1]);
        pb[sx] = __builtin_bit_cast(bf16x8, w);
    }
#pragma unroll
    for (int dt = 0; dt < 4; ++dt) {
        const LAS uchar* vrow = stg + A_VOFF + (32 * dt + r) * 136;
#pragma unroll
        for (int sx = 0; sx < 2; ++sx) {
            const int col = 32 * kh + 16 * sx + 4 * hh;
            const u32x2 lo = *(const LAS u32x2*)(vrow + col * 2), hi = *(const LAS u32x2*)(vrow + (col + 8) * 2);
            const u32x4 w = {lo[0], lo[1], hi[0], hi[1]};
            o[dt] = __builtin_amdgcn_mfma_f32_32x32x16_bf16(__builtin_bit_cast(bf16x8, w), pb[sx], o[dt], 0, 0, 0);
        }
    }
}
__device__ __forceinline__ void attn_online(f32x16& s, f32x16 (&o)[4], float& m, float& l, float bias = 0.f) {
    float mx = -INFINITY;
#pragma unroll
    for (int i = 0; i < 16; ++i) mx = fmaxf(mx, s[i]);
    mx += bias;
    mx = fmaxf(mx, __shfl_xor(mx, 32));
    const float mn = fmaxf(m, mx), mu = (mn == -INFINITY) ? 0.f : mn;
    const float alpha = __expf(m - mu);
    const float nmu2 = 1.4426950408889634f * (bias - mu);
    float sum = 0.f;
#pragma unroll
    for (int i = 0; i < 16; ++i) { const float e = __builtin_amdgcn_exp2f(__builtin_fmaf(s[i], 1.4426950408889634f, nmu2)); s[i] = e; sum += e; }
    l = l * alpha + sum; m = mn;
    if (__any(alpha != 1.0f)) {
#pragma unroll
        for (int dt = 0; dt < 4; ++dt) o[dt] *= alpha;
    }
}
__device__ __forceinline__ float attn_merge_scale(LAS float* ml, int kh, int hl, int r, int hh, float m, float l, float gate) {
    const float lt = l + __shfl_xor(l, 32);
    if (hh == 0) { ml[((kh * 4 + hl) * 32 + r) * 2] = m; ml[((kh * 4 + hl) * 32 + r) * 2 + 1] = lt; }
    __syncthreads();
    const float m2 = ml[(((kh ^ 1) * 4 + hl) * 32 + r) * 2], l2 = ml[(((kh ^ 1) * 4 + hl) * 32 + r) * 2 + 1];
    const float ms = fmaxf(m, m2), mu = (ms == -INFINITY) ? 0.f : ms;
    const float e1 = __expf(m - mu), e2 = __expf(m2 - mu), den = lt * e1 + l2 * e2;
    return den > 0.f ? gate * e1 / den : 0.f;
}
__device__ __forceinline__ void attn_merge_o(LAS uchar* lds, int kh, int hl, int lane, f32x16 (&o)[4], float f) {
    LAS f32x4* buf = (LAS f32x4*)lds + (size_t)hl * 1024;
    __syncthreads();
    if (kh == 1) {
#pragma unroll
        for (int dt = 0; dt < 4; ++dt)
#pragma unroll
            for (int c4 = 0; c4 < 4; ++c4) buf[(dt * 4 + c4) * 64 + lane] = (f32x4){o[dt][4 * c4] * f, o[dt][4 * c4 + 1] * f, o[dt][4 * c4 + 2] * f, o[dt][4 * c4 + 3] * f};
    }
    __syncthreads();
    if (kh == 0) {
#pragma unroll
        for (int dt = 0; dt < 4; ++dt)
#pragma unroll
            for (int c4 = 0; c4 < 4; ++c4) { const f32x4 v = buf[(dt * 4 + c4) * 64 + lane];
#pragma unroll
                for (int q = 0; q < 4; ++q) o[dt][4 * c4 + q] = o[dt][4 * c4 + q] * f + v[q]; }
    }
    __syncthreads();
}
__device__ __forceinline__ void attn_park(f32x4* park, const f32x16 (&o)[4], bool first) {
#pragma unroll
    for (int dt = 0; dt < 4; ++dt)
#pragma unroll
        for (int c4 = 0; c4 < 4; ++c4) {
            f32x4 v = {o[dt][4 * c4], o[dt][4 * c4 + 1], o[dt][4 * c4 + 2], o[dt][4 * c4 + 3]};
            if (!first) v += park[dt * 4 + c4];
            park[dt * 4 + c4] = v;
        }
}

__device__ __forceinline__ void attn_unit(const Params& p, LAS uchar* lds, int g, int c32) {
    const int tid = tid_opaque(), lane = tid & 63, wave = tid >> 6, r = lane & 31, hh = lane >> 5;
    const int hl = wave & 3, kh = wave >> 2, t0 = c32 * 32, t = t0 + r, head = g * 4 + hl, cur = c32 >> 1;
    uchar* ws = p.ws;
    LAS unsigned* imp = (LAS unsigned*)(lds + A_IMP); LAS unsigned* sel = (LAS unsigned*)(lds + A_SEL); LAS unsigned* uni = (LAS unsigned*)(lds + A_UNI);
    LAS float* lut = (LAS float*)(lds + A_LUT); LAS float* ml = (LAS float*)(lds + A_ML);
    const LAS uchar* qimg = lds + A_Q;
    for (int i = tid; i < 4 * 129; i += NTHREADS) { const int h = i / 129, rel = i % 129; lut[h * 132 + rel] = p.in[I_RELB][(rel >= 128 ? 31 : t5_bucket(rel)) * 8 + g * 4 + h]; }
    for (int i = tid; i < 32 * IMP_LD; i += NTHREADS) imp[i] = 0u;
    if (tid < 4) uni[tid] = 0u;
    {
        const bf16_t* qg = (const bf16_t*)(ws + U_Q);
#pragma unroll
        for (int rep = 0; rep < 4; ++rep) {
            const int id = tid + NTHREADS * rep, row = id >> 4, ch = id & 15;
            const u32x4 v = *(const u32x4*)(qg + (size_t)(t0 + (row & 31)) * 1024 + (g * 4 + (row >> 5)) * 128 + ch * 8);
            *(LAS u32x4*)(lds + A_Q + row * 256 + ((ch ^ (row & 15)) << 4)) = v;
        }
    }
    const int qrow = hl * 32 + r;
    const float* gp = (const float*)(ws + U_GATE) + (size_t)t * 24 + head * 3;
    const float g_cmp = gp[0], g_slc = gp[1], g_win = gp[2];
    const LAS float* mylut = lut + hl * 132;
    const float b31 = p.in[I_RELB][31 * 8 + head];
    f32x16 o[4];
#pragma unroll
    for (int dt = 0; dt < 4; ++dt) o[dt] = F16ZERO;
    f32x4* park = (f32x4*)(ws + WS_PARK) + ((size_t)blockIdx.x * 256 + (tid & 255)) * 16;
    AttnPre P0, P1;

    const bf16_t* kcmp = (const bf16_t*)(ws + U_KCMP) + (size_t)g * 512 * 128;
    const bf16_t* vcmpt = (const bf16_t*)(ws + U_VCMPT) + (size_t)g * 128 * 512;
    const int ntc = (2 * c32) / 64 + 1;
    float m = -INFINITY, l = 0.f;
#define CMP1_COMPUTE(stg, nt) do { \
        f32x16 s = attn_qk(stg, qimg, qrow, kh, r, hh); \
        float mx = -INFINITY, bc1 = 0.f; \
        if (t0 >= 1024 * (nt) + 1167) {            \
            _Pragma("unroll") for (int i = 0; i < 16; ++i) mx = fmaxf(mx, s[i]); \
            mx += b31; bc1 = b31; \
        } else { \
        _Pragma("unroll") for (int i = 0; i < 16; ++i) { \
            const int n = (nt) * 64 + 32 * kh + (i & 3) + 8 * (i >> 2) + 4 * hh, rel = t - (16 * n + 31); \
            const float bv = mylut[min(max(rel, 0), 128)]; const float v = rel >= 0 ? s[i] + bv : -INFINITY; \
            s[i] = v; mx = fmaxf(mx, v); } } \
        mx = fmaxf(mx, __shfl_xor(mx, 32)); \
        const float mn = fmaxf(m, mx), mu_ = (mn == -INFINITY) ? 0.f : mn; \
        float sum = 0.f; \
        const float nmu2_ = 1.4426950408889634f * (bc1 - mu_); \
        _Pragma("unroll") for (int i = 0; i < 16; ++i) sum += __builtin_amdgcn_exp2f(__builtin_fmaf(s[i], 1.4426950408889634f, nmu2_)); \
        l = l * __expf(m - mu_) + sum; m = mn; } while (0)
    { AttnSeq q; q.mode = 0; q.n = ntc; q.base = 0; q.last = ntc - 1; q.ua = 0; q.ub = 0; ATTN_PIPE(q, kcmp, vcmpt, 512, CMP1_COMPUTE); }
    {
        const float lt = l + __shfl_xor(l, 32);
        if (hh == 0) { ml[((kh * 4 + hl) * 32 + r) * 2] = m; ml[((kh * 4 + hl) * 32 + r) * 2 + 1] = lt; }
        __syncthreads();
        const float m2 = ml[(((kh ^ 1) * 4 + hl) * 32 + r) * 2], l2 = ml[(((kh ^ 1) * 4 + hl) * 32 + r) * 2 + 1];
        const float ms = fmaxf(m, m2), mu = (ms == -INFINITY) ? 0.f : ms;
        const float den = lt * __expf(m - mu) + l2 * __expf(m2 - mu);
        const float inv = den > 0.f ? 1.0f / den : 0.f;
#define CMP2_COMPUTE(stg, nt) do { \
            f32x16 s = attn_qk(stg, qimg, qrow, kh, r, hh); \
            if (t0 >= 1024 * (nt) + 1167) { \
                const float bm = b31 - mu; \
                const float bm2 = 1.4426950408889634f * bm; \
                _Pragma("unroll") for (int i = 0; i < 16; ++i) s[i] = __builtin_amdgcn_exp2f(__builtin_fmaf(s[i], 1.4426950408889634f, bm2)) * inv; \
            } else { \
            _Pragma("unroll") for (int i = 0; i < 16; ++i) { \
                const int n = (nt) * 64 + 32 * kh + (i & 3) + 8 * (i >> 2) + 4 * hh, rel = t - (16 * n + 31); \
                const float bv = mylut[min(max(rel, 0), 128)]; s[i] = rel >= 0 ? __expf(s[i] + bv - mu) * inv : 0.f; } } \
            _Pragma("unroll") for (int c4 = 0; c4 < 4; ++c4) { \
                const int j = (nt) * 16 + 8 * kh + 2 * c4 + hh; \
                const float s4 = s[4 * c4] + s[4 * c4 + 1] + s[4 * c4 + 2] + s[4 * c4 + 3]; \
                const unsigned q4 = (unsigned)(s4 * 67108864.f + 0.5f), q3 = (unsigned)(s[4 * c4 + 3] * 67108864.f + 0.5f); \
                (void)__hip_atomic_fetch_add(imp + r * IMP_LD + j, q4, __ATOMIC_RELAXED, __HIP_MEMORY_SCOPE_WORKGROUP); \
                (void)__hip_atomic_fetch_add(imp + r * IMP_LD + (j + 1 < 128 ? j + 1 : 128), q3, __ATOMIC_RELAXED, __HIP_MEMORY_SCOPE_WORKGROUP); } \
            _Pragma("unroll") for (int i = 0; i < 16; ++i) s[i] *= g_cmp; \
            attn_pv(stg, s, o, kh, r, hh); } while (0)
        { AttnSeq q; q.mode = 0; q.n = ntc; q.base = 0; q.last = ntc - 1; q.ua = 0; q.ub = 0; ATTN_PIPE(q, kcmp, vcmpt, 512, CMP2_COMPUTE); }
        attn_merge_o(lds, kh, hl, lane, o, 1.0f);
        if (kh == 0) attn_park(park, o, true);
    }
    {
        unsigned long long u0 = 0ull, u1 = 0ull;
        for (int tq = 0; tq < 4; ++tq) {
            const int tok = 4 * wave + tq;
            const LAS unsigned* row = imp + tok * IMP_LD;
            unsigned long long b0, b1;
            if (cur <= 15) { b0 = (2ull << cur) - 1ull; b1 = 0ull; }
            else {
                const int v0 = lane < cur ? (int)row[lane] : -1, v1 = (lane + 64 < cur) ? (int)row[lane + 64] : -1;
                int c0 = 0, c1 = 0;
                const int ja = cur < 64 ? cur : 64;
                for (int j = 0; j < ja; ++j) { const int vj = __builtin_amdgcn_readlane(v0, j); c0 += (vj > v0 || (vj == v0 && j < lane)) ? 1 : 0; c1 += (vj >= v1) ? 1 : 0; }
                for (int j = 64; j < cur; ++j) { const int vj = __builtin_amdgcn_readlane(v1, j - 64); c0 += (vj > v0) ? 1 : 0; c1 += (vj > v1 || (vj == v1 && j - 64 < lane)) ? 1 : 0; }
                b0 = __ballot(lane < cur && c0 < 15); b1 = __ballot(lane + 64 < cur && c1 < 15);
                if (cur < 64) b0 |= 1ull << cur; else b1 |= 1ull << (cur - 64);
            }
            if (lane == 0) { sel[tok * 4 + 0] = (unsigned)b0; sel[tok * 4 + 1] = (unsigned)(b0 >> 32); sel[tok * 4 + 2] = (unsigned)b1; sel[tok * 4 + 3] = (unsigned)(b1 >> 32); }
            u0 |= b0; u1 |= b1;
        }
        if (lane == 0) { (void)__hip_atomic_fetch_or(uni + 0, (unsigned)u0, __ATOMIC_RELAXED, __HIP_MEMORY_SCOPE_WORKGROUP); (void)__hip_atomic_fetch_or(uni + 1, (unsigned)(u0 >> 32), __ATOMIC_RELAXED, __HIP_MEMORY_SCOPE_WORKGROUP);
                         (void)__hip_atomic_fetch_or(uni + 2, (unsigned)u1, __ATOMIC_RELAXED, __HIP_MEMORY_SCOPE_WORKGROUP); (void)__hip_atomic_fetch_or(uni + 3, (unsigned)(u1 >> 32), __ATOMIC_RELAXED, __HIP_MEMORY_SCOPE_WORKGROUP); }
    }
    __syncthreads();
    {
        const unsigned sm0 = sel[r * 4 + 0], sm1 = sel[r * 4 + 1], sm2 = sel[r * 4 + 2], sm3 = sel[r * 4 + 3];
        const unsigned long long ua = ((unsigned long long)(unsigned)__builtin_amdgcn_readfirstlane((int)uni[1]) << 32) | (unsigned)__builtin_amdgcn_readfirstlane((int)uni[0]);
        const unsigned long long ub = ((unsigned long long)(unsigned)__builtin_amdgcn_readfirstlane((int)uni[3]) << 32) | (unsigned)__builtin_amdgcn_readfirstlane((int)uni[2]);
        const bf16_t* kslc = (const bf16_t*)(ws + U_KB) + (size_t)(2 * 2 + g) * TP * 128;
        const bf16_t* vslc = (const bf16_t*)(ws + U_VT) + (size_t)(0 * 2 + g) * 128 * TV;
#pragma unroll
        for (int dt = 0; dt < 4; ++dt) o[dt] = F16ZERO;
        m = -INFINITY; l = 0.f;
#define SLC_COMPUTE(stg, j) do { \
            f32x16 s = attn_qk(stg, qimg, qrow, kh, r, hh); \
            const unsigned mw = ((j) < 32) ? sm0 : ((j) < 64) ? sm1 : ((j) < 96) ? sm2 : sm3; \
            const bool mine = (mw >> ((j) & 31)) & 1u; \
            float bsel = 0.f; \
            if (cur - (j) >= 3) { \
                bsel = mine ? b31 : -INFINITY;                    \
            } else { \
                _Pragma("unroll") for (int i = 0; i < 16; ++i) { \
                    const int key = (j) * 64 + 32 * kh + (i & 3) + 8 * (i >> 2) + 4 * hh, rel = t - key; \
                    const float bv = mylut[min(max(rel, 0), 128)]; s[i] = (mine && rel >= 0) ? s[i] + bv : -INFINITY; } \
            } \
            attn_online(s, o, m, l, bsel); \
            attn_pv(stg, s, o, kh, r, hh); } while (0)
        { AttnSeq q; q.mode = 1; q.n = __builtin_popcountll(ua) + __builtin_popcountll(ub); q.base = 0; q.last = cur; q.ua = ua; q.ub = ub; ATTN_PIPE(q, kslc, vslc, TV, SLC_COMPUTE); }
        {
            const float f = attn_merge_scale(ml, kh, hl, r, hh, m, l, g_slc);
            attn_merge_o(lds, kh, hl, lane, o, f);
            if (kh == 0) attn_park(park, o, false);
        }
        const bf16_t* kwin = (const bf16_t*)(ws + U_KB) + (size_t)(3 * 2 + g) * TP * 128;
        const bf16_t* vwin = (const bf16_t*)(ws + U_VT) + (size_t)(1 * 2 + g) * 128 * TV;
#pragma unroll
        for (int dt = 0; dt < 4; ++dt) o[dt] = F16ZERO;
        m = -INFINITY; l = 0.f;
        const int j0 = cur >= 8 ? cur - 8 : 0;
#define WIN_COMPUTE(stg, jw) do { \
            f32x16 s = attn_qk(stg, qimg, qrow, kh, r, hh); \
            float bwin = 0.f; \
            if (cur - (jw) >= 3 && cur - (jw) <= 7) {    \
                bwin = b31; \
            } else if (cur - (jw) >= 3) {              \
                _Pragma("unroll") for (int i = 0; i < 16; ++i) { \
                    const int key = (jw) * 64 + 32 * kh + (i & 3) + 8 * (i >> 2) + 4 * hh; s[i] = (t - key < 512) ? s[i] + b31 : -INFINITY; } \
            } else { \
            _Pragma("unroll") for (int i = 0; i < 16; ++i) { \
                const int key = (jw) * 64 + 32 * kh + (i & 3) + 8 * (i >> 2) + 4 * hh, rel = t - key; \
                const float bv = mylut[min(max(rel, 0), 128)]; s[i] = (rel >= 0 && rel < 512) ? s[i] + bv : -INFINITY; } } \
            attn_online(s, o, m, l, bwin); \
            attn_pv(stg, s, o, kh, r, hh); } while (0)
        { AttnSeq q; q.mode = 0; q.n = cur - j0 + 1; q.base = j0; q.last = cur; q.ua = 0; q.ub = 0; ATTN_PIPE(q, kwin, vwin, TV, WIN_COMPUTE); }
        {
            const float f = attn_merge_scale(ml, kh, hl, r, hh, m, l, g_win);
            attn_merge_o(lds, kh, hl, lane, o, f);
        }
    }
    if (kh == 0) {
        bf16_t* op = (bf16_t*)(ws + U_CAT) + (size_t)t * 2048 + head * 128 + 4 * hh;
#pragma unroll
        for (int dt = 0; dt < 4; ++dt)
#pragma unroll
            for (int c4 = 0; c4 < 4; ++c4) {
                const f32x4 pv = park[dt * 4 + c4];
                u32x2 w; w[0] = cvt_pk_bf16(o[dt][4 * c4] + pv[0], o[dt][4 * c4 + 1] + pv[1]); w[1] = cvt_pk_bf16(o[dt][4 * c4 + 2] + pv[2], o[dt][4 * c4 + 3] + pv[3]);
                *(u32x2*)(op + 32 * dt + 8 * c4) = w;
            }
    }
    __syncthreads();
}
constexpr int H_BC = 0;
constexpr int H_QT = 32768;
constexpr int H_KT = 50176;
constexpr int H_VT = 93696;
constexpr int H_KH = 112128;
constexpr int H_ATT = 130560;
constexpr int H_SEG = 139776;
constexpr int H_END = 141824;
__device__ __forceinline__ int kt_row0(int i) { return i == 0 ? 0 : (i == 1 ? 16 : (i == 2 ? 48 : 96)); }

struct HlPre { float lf[16]; u32x4 q[2], k[2], v[2]; };
__device__ __forceinline__ void hl_load(HlPre& pre, const uchar* ws, int u, int tid) {
    const int h = u & 15, c = u >> 4, t0 = c * 64, col0 = h * 128;
    { const int d = tid & 127, sg = tid >> 7;
      const float* lf = (const float*)(ws + V_LOGF) + (size_t)(t0 + sg * 16) * 2048 + col0 + d;
#pragma unroll
      for (int r = 0; r < 16; ++r) pre.lf[r] = lf[(size_t)r * 2048]; }
#pragma unroll
    for (int rep = 0; rep < 2; ++rep) {
        const int id = tid + NTHREADS * rep, row = id >> 4, ch = id & 15;
        const size_t go = (size_t)(t0 + row) * 2048 + col0 + ch * 8;
        pre.q[rep] = *(const u32x4*)((const bf16_t*)(ws + V_QS) + go); pre.k[rep] = *(const u32x4*)((const bf16_t*)(ws + V_KK) + go); pre.v[rep] = *(const u32x4*)((const bf16_t*)(ws + V_V) + go);
    }
}
__device__ __forceinline__ void hgrn_local_unit(const Params& p, LAS uchar* lds, int u, int unext, HlPre& pre, int tid) {
    const int lane = tid & 63, wave = tid >> 6, fr = lane & 15, fq = lane >> 4;
    const int h = u & 15, c = u >> 4, t0 = c * 64, col0 = h * 128;
    uchar* ws = p.ws;
    LAS float* bc = (LAS float*)(lds + H_BC); LAS bf16_t* qt = (LAS bf16_t*)(lds + H_QT); LAS bf16_t* kt = (LAS bf16_t*)(lds + H_KT);
    LAS bf16_t* vt = (LAS bf16_t*)(lds + H_VT); LAS bf16_t* kh = (LAS bf16_t*)(lds + H_KH); LAS bf16_t* att = (LAS bf16_t*)(lds + H_ATT); LAS float* seg = (LAS float*)(lds + H_SEG);
    {
        const int d = tid & 127, sg = tid >> 7;
        float v[16];
#pragma unroll
        for (int r = 0; r < 16; ++r) v[r] = pre.lf[r];
        float a = 0.f;
#pragma unroll
        for (int r = 0; r < 16; ++r) { a += v[r]; v[r] = a; }
        seg[sg * 128 + d] = a;
        __syncthreads();
        float off = 0.f;
        for (int s = 0; s < sg; ++s) off += seg[s * 128 + d];
#pragma unroll
        for (int r = 0; r < 16; ++r) bc[(sg * 16 + r) * 128 + d] = v[r] + off;
        for (int i = tid; i < 64 * 72 / 2; i += NTHREADS) ((LAS unsigned*)att)[i] = 0u;
    }
    __syncthreads();
    {
#pragma unroll
        for (int rep = 0; rep < 2; ++rep) {
            const int id = tid + NTHREADS * rep, row = id >> 4, ch = id & 15, d0 = ch * 8, si = row >> 4;
            const size_t go = (size_t)(t0 + row) * 2048 + col0 + d0;
            const u32x4 qv = pre.q[rep], kv = pre.k[rep], vv = pre.v[rep];
            float qf[8], kf[8], bcv[8], bref[8], bl[8];
#pragma unroll
            for (int q = 0; q < 4; ++q) { qf[2 * q] = bf_lo(qv[q]); qf[2 * q + 1] = bf_hi(qv[q]); kf[2 * q] = bf_lo(kv[q]); kf[2 * q + 1] = bf_hi(kv[q]); }
            {
                const LAS f32x4* pc = (const LAS f32x4*)(bc + row * 128 + d0); const LAS f32x4* pr = (const LAS f32x4*)(bc + (si > 0 ? 16 * si - 1 : 0) * 128 + d0);
                const LAS f32x4* pl = (const LAS f32x4*)(bc + 63 * 128 + d0);
                const f32x4 c0 = pc[0], c1 = pc[1], r0 = pr[0], r1 = pr[1], l0 = pl[0], l1 = pl[1];
#pragma unroll
                for (int q = 0; q < 4; ++q) { bcv[q] = c0[q]; bcv[q + 4] = c1[q]; bref[q] = si > 0 ? r0[q] : 0.f; bref[q + 4] = si > 0 ? r1[q] : 0.f; bl[q] = l0[q]; bl[q + 4] = l1[q]; }
            }
            u32x4 w;
#pragma unroll
            for (int q = 0; q < 4; ++q) w[q] = cvt_pk_bf16(qf[2 * q] * __expf(bcv[2 * q] - bref[2 * q]), qf[2 * q + 1] * __expf(bcv[2 * q + 1] - bref[2 * q + 1]));
            *(LAS u32x4*)(qt + row * 136 + d0) = w;
#pragma unroll
            for (int q = 0; q < 4; ++q) w[q] = cvt_pk_bf16(qf[2 * q] * __expf(bcv[2 * q]), qf[2 * q + 1] * __expf(bcv[2 * q + 1]));
            *(u32x4*)((bf16_t*)(ws + V_QHAT) + go) = w;
#pragma unroll
            for (int i = 0; i < 4; ++i) {
                if (i >= si) {
                    float br[8];
#pragma unroll
                    for (int q = 0; q < 8; ++q) br[q] = i > 0 ? bc[(16 * i - 1) * 128 + d0 + q] : 0.f;
#pragma unroll
                    for (int q = 0; q < 4; ++q) w[q] = cvt_pk_bf16(kf[2 * q] * __expf(fminf(br[2 * q] - bcv[2 * q], 80.f)), kf[2 * q + 1] * __expf(fminf(br[2 * q + 1] - bcv[2 * q + 1], 80.f)));
                    *(LAS u32x4*)(kt + (kt_row0(i) + row) * 136 + d0) = w;
                }
            }
#pragma unroll
            for (int q = 0; q < 8; ++q) {
                kh[(d0 + q) * 72 + (row ^ ((ch & 7) << 3))] = f2bf(kf[q] * __expf(bl[q] - bcv[q]));
                vt[(d0 + q) * 72 + (row ^ ((ch & 7) << 3))] = (bf16_t)((q & 1) ? (vv[q >> 1] >> 16) : (vv[q >> 1] & 0xffffu));
            }
        }
        if (tid < 128) ((float*)(ws + V_DEC))[((size_t)c * 16 + h) * 128 + tid] = __expf(bc[63 * 128 + tid]);
    }
    if (unext < 2048) hl_load(pre, ws, unext, tid);
    __syncthreads();
    {
        for (int tix = wave; tix < 10; tix += 8) {
            int i = 0, j = tix;
            if (tix >= 6) { i = 3; j = tix - 6; } else if (tix >= 3) { i = 2; j = tix - 3; } else if (tix >= 1) { i = 1; j = tix - 1; }
            f32x4 a = {0.f, 0.f, 0.f, 0.f};
#pragma unroll
            for (int ks = 0; ks < 4; ++ks) {
                const bf16x8 af = *(const LAS bf16x8*)(qt + (16 * i + fr) * 136 + ks * 32 + 8 * fq);
                const bf16x8 bf = *(const LAS bf16x8*)(kt + (kt_row0(i) + 16 * j + fr) * 136 + ks * 32 + 8 * fq);
                a = __builtin_amdgcn_mfma_f32_16x16x32_bf16(af, bf, a, 0, 0, 0);
            }
#pragma unroll
            for (int q = 0; q < 4; ++q) {
                const int tq = fq * 4 + q;
                const float v = (j < i || fr <= tq) ? a[q] : 0.f;
                att[(16 * i + tq) * 72 + 16 * j + fr] = f2bf(v);
            }
        }
    }
    __syncthreads();
    {
        f32x4 oi[4];
#pragma unroll
        for (int m = 0; m < 4; ++m) oi[m] = (f32x4){0.f, 0.f, 0.f, 0.f};
#pragma unroll
        for (int ks = 0; ks < 2; ++ks) {
            const bf16x8 bv = *(const LAS bf16x8*)(vt + (wave * 16 + fr) * 72 + (((ks * 4 + fq) ^ (((wave * 16 + fr) >> 3) & 7)) << 3));
#pragma unroll
            for (int m = 0; m < 4; ++m) { const bf16x8 af = *(const LAS bf16x8*)(att + (m * 16 + fr) * 72 + ks * 32 + 8 * fq); oi[m] = __builtin_amdgcn_mfma_f32_16x16x32_bf16(bv, af, oi[m], 0, 0, 0); }
        }
        bf16_t* oint = (bf16_t*)(ws + V_OINTRA);
#pragma unroll
        for (int m = 0; m < 4; ++m) { u32x2 w; w[0] = cvt_pk_bf16(oi[m][0], oi[m][1]); w[1] = cvt_pk_bf16(oi[m][2], oi[m][3]);
            *(u32x2*)(oint + (size_t)(t0 + m * 16 + fr) * 2048 + col0 + wave * 16 + fq * 4) = w; }
        f32x4 kvv[8];
#pragma unroll
        for (int n = 0; n < 8; ++n) kvv[n] = (f32x4){0.f, 0.f, 0.f, 0.f};
#pragma unroll
        for (int ks = 0; ks < 2; ++ks) {
            const bf16x8 af = *(const LAS bf16x8*)(vt + (wave * 16 + fr) * 72 + (((ks * 4 + fq) ^ (((wave * 16 + fr) >> 3) & 7)) << 3));
#pragma unroll
            for (int n = 0; n < 8; ++n) { const int dr = (fr >> 2) * 32 + n * 4 + (fr & 3); const bf16x8 bf = *(const LAS bf16x8*)(kh + dr * 72 + (((ks * 4 + fq) ^ ((dr >> 3) & 7)) << 3)); kvv[n] = __builtin_amdgcn_mfma_f32_16x16x32_bf16(bf, af, kvv[n], 0, 0, 0); }
        }
        bf16_t* st = (bf16_t*)(ws + V_ST) + ((size_t)c * 16 + h) * 16384 + (wave * 16 + fr) * 128 + fq * 32;
#pragma unroll
        for (int g = 0; g < 4; ++g) { u32x4 w; w[0] = cvt_pk_bf16(kvv[2 * g][0], kvv[2 * g][1]); w[1] = cvt_pk_bf16(kvv[2 * g][2], kvv[2 * g][3]);
            w[2] = cvt_pk_bf16(kvv[2 * g + 1][0], kvv[2 * g + 1][1]); w[3] = cvt_pk_bf16(kvv[2 * g + 1][2], kvv[2 * g + 1][3]); *(u32x4*)(st + g * 8) = w; }
    }
    __syncthreads();
}

__device__ __forceinline__ void hgrn_local_phase(const Params& p, LAS uchar* lds) {
    const int tid = tid_opaque();
    HlPre pre;
    int u = blockIdx.x;
    if (u < 2048) hl_load(pre, p.ws, u, tid);
    for (; u < 2048; u += gridDim.x) hgrn_local_unit(p, lds, u, u + (int)gridDim.x, pre, tid);
}

__device__ __forceinline__ void hgrn_scan(const Params& p) {
    uchar* ws = p.ws;
    const int gt = blockIdx.x * NTHREADS + tid_opaque(), nthr = gridDim.x * NTHREADS;
    for (int idx = gt; idx < 16 * 128 * 64; idx += nthr) {
        const int h = idx >> 13, e = (idx >> 6) & 127, d = (idx & 63) * 2;
        const bf16_t* st = (const bf16_t*)(ws + V_ST) + (size_t)h * 16384 + e * 128 + d;
        unsigned* sb = (unsigned*)((bf16_t*)(ws + V_SB) + (size_t)h * 16384 + e * 128 + d);
        const float* dec = (const float*)(ws + V_DEC) + h * 128 + d;
        float s0 = 0.f, s1 = 0.f;
#pragma unroll 32
        for (int c = 0; c < 128; ++c) {
            const unsigned kv = *(const unsigned*)(st + (size_t)c * 16 * 16384); const float2 dc = *(const float2*)(dec + (size_t)c * 16 * 128);
            sb[(size_t)c * 16 * 8192] = cvt_pk_bf16(s0, s1);
            s0 = dc.x * s0 + bf_lo(kv); s1 = dc.y * s1 + bf_hi(kv);
        }
    }
}

struct HoStage { bf16x8 af[2]; bf16x8 bf[8]; };
__device__ __forceinline__ void hgrn_out_phase(const Params& p) {
    const int tid = tid_opaque(), lane = tid & 63, wave = tid >> 6, fr = lane & 15, fq = lane >> 4;
    uchar* ws = p.ws;
    const bf16_t* qh = (const bf16_t*)(ws + V_QHAT);
    const bf16_t* oint = (const bf16_t*)(ws + V_OINTRA);
    const bf16_t* gs = (const bf16_t*)(ws + V_GS); bf16_t* out = (bf16_t*)(ws + V_HGO);
    const int erow = (fr >> 2) * 32 + (fr & 3);
    for (int u = blockIdx.x * NWAVES + wave; u < 2048; u += gridDim.x * NWAVES) {
        const int h = u & 15, c = u >> 4, t0 = c * 64, col0 = h * 128;
        const bf16_t* sb = (const bf16_t*)(ws + V_SB) + ((size_t)c * 16 + h) * 16384;
#define HO_LOAD(S, MH, KS) do { _Pragma("unroll") for (int m = 0; m < 2; ++m) S.af[m] = *(const bf16x8*)(qh + (size_t)(t0 + ((MH) * 2 + m) * 16 + fr) * 2048 + col0 + (KS) * 32 + 8 * fq); \
            _Pragma("unroll") for (int n = 0; n < 8; ++n) S.bf[n] = *(const bf16x8*)(sb + (erow + 4 * n) * 128 + (KS) * 32 + 8 * fq); } while (0)
#define HO_MMA(S) do { _Pragma("unroll") for (int n = 0; n < 8; ++n) _Pragma("unroll") for (int m = 0; m < 2; ++m) o[m][n] = __builtin_amdgcn_mfma_f32_16x16x32_bf16(S.bf[n], S.af[m], o[m][n], 0, 0, 0); } while (0)
        HoStage s0, s1;
        HO_LOAD(s0, 0, 0);
#pragma unroll
        for (int mh = 0; mh < 2; ++mh) {
            f32x4 o[2][8];
#pragma unroll
            for (int m = 0; m < 2; ++m)
#pragma unroll
                for (int n = 0; n < 8; ++n) o[m][n] = (f32x4){0.f, 0.f, 0.f, 0.f};
            HO_LOAD(s1, mh, 1); HO_MMA(s0); __builtin_amdgcn_sched_barrier(0);
            HO_LOAD(s0, mh, 2); HO_MMA(s1); __builtin_amdgcn_sched_barrier(0);
            HO_LOAD(s1, mh, 3); HO_MMA(s0); __builtin_amdgcn_sched_barrier(0);
            u32x4 oi[4], gv[4];
            const size_t rb0 = (size_t)(t0 + (mh * 2) * 16 + fr) * 2048 + col0 + fq * 32;
#pragma unroll
            for (int g = 0; g < 4; ++g) { oi[g] = *(const u32x4*)(oint + rb0 + g * 8); gv[g] = *(const u32x4*)(gs + rb0 + g * 8); }
            if (mh == 0) HO_LOAD(s0, 1, 0);
            HO_MMA(s1); __builtin_amdgcn_sched_barrier(0);
            f32x4 ng[8];
#pragma unroll
            for (int n = 0; n < 8; ++n) ng[n] = *(const f32x4*)(p.in[I_HNG] + col0 + fq * 32 + n * 4);
#pragma unroll
            for (int m = 0; m < 2; ++m) {
                const size_t rb = (size_t)(t0 + (mh * 2 + m) * 16 + fr) * 2048 + col0 + fq * 32;
                if (m == 1) {
#pragma unroll
                    for (int g = 0; g < 4; ++g) { oi[g] = *(const u32x4*)(oint + rb + g * 8); gv[g] = *(const u32x4*)(gs + rb + g * 8); }
                }
                float ss = 0.f;
#pragma unroll
                for (int n = 0; n < 8; ++n) { const unsigned w0 = oi[n >> 1][(n & 1) * 2], w1 = oi[n >> 1][(n & 1) * 2 + 1];
                    f32x4 v = o[m][n]; v[0] += bf_lo(w0); v[1] += bf_hi(w0); v[2] += bf_lo(w1); v[3] += bf_hi(w1);
                    o[m][n] = v; ss += v[0] * v[0] + v[1] * v[1] + v[2] * v[2] + v[3] * v[3]; }
                ss += __shfl_xor(ss, 16); ss += __shfl_xor(ss, 32);
                const float inv = rsqrtf(ss * (1.0f / 128.0f) + 1e-6f);
#pragma unroll
                for (int g = 0; g < 4; ++g) { u32x4 w;
#pragma unroll
                    for (int hf = 0; hf < 2; ++hf) { const int n = 2 * g + hf; const unsigned g0 = gv[g][hf * 2], g1 = gv[g][hf * 2 + 1]; const f32x4 v = o[m][n] * inv * ng[n];
                        w[hf * 2] = cvt_pk_bf16(v[0] * bf_lo(g0), v[1] * bf_hi(g0)); w[hf * 2 + 1] = cvt_pk_bf16(v[2] * bf_lo(g1), v[3] * bf_hi(g1)); }
                    *(u32x4*)(out + rb + g * 8) = w; }
            }
        }
#undef HO_LOAD
#undef HO_MMA
    }
}
__device__ __forceinline__ void moe_route(const Params& p, int layer) {
    uchar* ws = p.ws;
    const float* logit = (const float*)(ws + WS_LOGIT);
    const float* bg = p.in[I_MBGRP] + layer * 8; const float* be = p.in[I_MBEXP] + layer * 64;
    unsigned* cnt = (unsigned*)(ws + WS_CTL + CTL_CNT_OFF) + layer * 64;
    int* toke = (int*)(ws + WS_TOKE); int* tokpos = (int*)(ws + WS_TOKPOS); float* tokw = (float*)(ws + WS_TOKW); int* etok = (int*)(ws + WS_ETOK);
    for (int t = blockIdx.x * NTHREADS + tid_opaque(); t < T; t += gridDim.x * NTHREADS) {
        const float* lr = logit + (size_t)t * LOGIT_LD;
        float gl[8]; float gm = -INFINITY; int grp = 0;
#pragma unroll
        for (int i = 0; i < 8; ++i) { float a = bg[i];
#pragma unroll
            for (int ks = 0; ks < 8; ++ks) a += lr[(size_t)ks * T * LOGIT_LD + i];
            gl[i] = a; if (a > gm) { gm = a; grp = i; } }
        float den = 0.f;
#pragma unroll
        for (int i = 0; i < 8; ++i) den += __expf(gl[i] - gm);
        const float pg = 1.0f / den;
        float v0 = -INFINITY, v1 = -INFINITY; int i0 = 0, i1 = 0;
#pragma unroll
        for (int i = 0; i < 8; ++i) {
            float v = be[grp * 8 + i];
#pragma unroll
            for (int ks = 0; ks < 8; ++ks) v += lr[(size_t)ks * T * LOGIT_LD + 8 + grp * 8 + i];
            if (v > v0) { v1 = v0; i1 = i0; v0 = v; i0 = i; } else if (v > v1) { v1 = v; i1 = i; }
        }
        const float e0 = 1.0f / (1.0f + __expf(v1 - v0));
        const int ea = grp * 8 + i0, eb = grp * 8 + i1;
        const int pa = (int)atomicAdd(cnt + ea, 1u), pb = (int)atomicAdd(cnt + eb, 1u);
        toke[2 * t] = ea; toke[2 * t + 1] = eb; tokpos[2 * t] = pa; tokpos[2 * t + 1] = pb; tokw[2 * t] = pg * e0; tokw[2 * t + 1] = pg * (1.0f - e0);
        etok[(size_t)ea * T + pa] = t; etok[(size_t)eb * T + pb] = t;
    }
}
constexpr int NR_PITCH = 4112;
__device__ __forceinline__ void moe_norm_route(const Params& p, LAS uchar* lds, int layer) {
    uchar* ws = p.ws;
    const int tid = tid_opaque(), lane = tid & 63, wave = tid >> 6, fr = lane & 15, fq = lane >> 4;
    const float* mod = (const float*)(ws + WS_MOD) + layer * 12288;
    const float* gain = p.in[I_NFG] + layer * 2048; const float* sh = mod + 3 * 2048; const float* sc = mod + 4 * 2048;
    const bf16_t* xa = (const bf16_t*)(ws + WS_XA); bf16_t* hf = (bf16_t*)(ws + WS_HMIX);
    const bf16_t* RT = (const bf16_t*)(ws + WS_ROUTET) + (size_t)layer * 256 * 2048;
    const float* bg = p.in[I_MBGRP] + layer * 8; const float* be = p.in[I_MBEXP] + layer * 64;
    unsigned* cnt = (unsigned*)(ws + WS_CTL + CTL_CNT_OFF) + layer * 64;
    int* toke = (int*)(ws + WS_TOKE); int* tokpos = (int*)(ws + WS_TOKPOS); float* tokw = (float*)(ws + WS_TOKW); int* etok = (int*)(ws + WS_ETOK);
    LAS float* rb = (LAS float*)(lds + 32 * NR_PITCH);
    if (tid < 8) rb[tid] = bg[tid]; else if (tid < 72) rb[tid] = be[tid - 8];
    LAS float* red = (LAS float*)lds;
    for (int rg = blockIdx.x; rg < T / 32; rg += gridDim.x) {
        const int row0 = rg * 32;
        for (int k = 0; k < 4; ++k) {
            const int rl = wave * 4 + k, r = row0 + rl;
            f32x4 v[8];
#pragma unroll
            for (int i = 0; i < 8; ++i) { const u32x2 w = *(const u32x2*)(xa + (size_t)r * D + (i * 64 + lane) * 4); v[i] = (f32x4){bf_lo(w[0]), bf_hi(w[0]), bf_lo(w[1]), bf_hi(w[1])}; }
            float ss = 0.f;
#pragma unroll
            for (int i = 0; i < 8; ++i) ss += v[i][0] * v[i][0] + v[i][1] * v[i][1] + v[i][2] * v[i][2] + v[i][3] * v[i][3];
            ss = wave_sum(ss);
            const float inv = rsqrtf(ss * (1.0f / D) + 1e-6f);
#pragma unroll
            for (int i = 0; i < 8; ++i) {
                const int c = (i * 64 + lane) * 4;
                const f32x4 g = *(const f32x4*)(gain + c), s1 = *(const f32x4*)(sc + c), s0 = *(const f32x4*)(sh + c);
                f32x4 y; y[0] = v[i][0] * inv * g[0]; y[1] = v[i][1] * inv * g[1]; y[2] = v[i][2] * inv * g[2]; y[3] = v[i][3] * inv * g[3];
                u32x2 o; o[0] = cvt_pk_bf16(y[0] * (1.0f + s1[0]) + s0[0], y[1] * (1.0f + s1[1]) + s0[1]); o[1] = cvt_pk_bf16(y[2] * (1.0f + s1[2]) + s0[2], y[3] * (1.0f + s1[3]) + s0[3]);
                *(u32x2*)(hf + (size_t)r * D + c) = o;
                *(LAS u32x2*)(lds + rl * NR_PITCH + c * 2) = o;
            }
        }
        __syncthreads();
        f32x4 acc[2][5];
#pragma unroll
        for (int m = 0; m < 2; ++m)
#pragma unroll
            for (int n = 0; n < 5; ++n) acc[m][n] = (f32x4){0.f, 0.f, 0.f, 0.f};
#pragma unroll
        for (int ks = 0; ks < 8; ks += 2) {
            bf16x8 b[2][5];
#pragma unroll
            for (int kk = 0; kk < 2; ++kk)
#pragma unroll
                for (int n = 0; n < 5; ++n) b[kk][n] = *(const bf16x8*)(RT + (size_t)(n * 16 + fr) * 2048 + wave * 256 + (ks + kk) * 32 + 8 * fq);
#pragma unroll
            for (int kk = 0; kk < 2; ++kk)
#pragma unroll
                for (int m = 0; m < 2; ++m) {
                    const bf16x8 a = *(const LAS bf16x8*)(lds + (m * 16 + fr) * NR_PITCH + (wave * 256 + (ks + kk) * 32 + 8 * fq) * 2);
#pragma unroll
                    for (int n = 0; n < 5; ++n) acc[m][n] = __builtin_amdgcn_mfma_f32_16x16x32_bf16(a, b[kk][n], acc[m][n], 0, 0, 0);
                }
        }
        __syncthreads();
#pragma unroll
        for (int m = 0; m < 2; ++m)
#pragma unroll
            for (int n = 0; n < 5; ++n)
#pragma unroll
                for (int q = 0; q < 4; ++q) red[(wave * 32 + m * 16 + fq * 4 + q) * 81 + n * 16 + fr] = acc[m][n][q];
        __syncthreads();
        if (tid < 32) {
            const int t = row0 + tid;
            float gl[8]; float gm = -INFINITY; int grp = 0;
#pragma unroll
            for (int i = 0; i < 8; ++i) { float a = rb[i];
#pragma unroll
                for (int ks = 0; ks < 8; ++ks) a += red[(ks * 32 + tid) * 81 + i];
                gl[i] = a; if (a > gm) { gm = a; grp = i; } }
            float den = 0.f;
#pragma unroll
            for (int i = 0; i < 8; ++i) den += __expf(gl[i] - gm);
            const float pg = 1.0f / den;
            float v0 = -INFINITY, v1 = -INFINITY; int i0 = 0, i1 = 0;
#pragma unroll
            for (int i = 0; i < 8; ++i) {
                float v = rb[8 + grp * 8 + i];
#pragma unroll
                for (int ks = 0; ks < 8; ++ks) v += red[(ks * 32 + tid) * 81 + 8 + grp * 8 + i];
                if (v > v0) { v1 = v0; i1 = i0; v0 = v; i0 = i; } else if (v > v1) { v1 = v; i1 = i; }
            }
            const float e0 = 1.0f / (1.0f + __expf(v1 - v0));
            const int ea = grp * 8 + i0, eb = grp * 8 + i1;
            const int pa = (int)atomicAdd(cnt + ea, 1u), pb = (int)atomicAdd(cnt + eb, 1u);
            toke[2 * t] = ea; toke[2 * t + 1] = eb; tokpos[2 * t] = pa; tokpos[2 * t + 1] = pb; tokw[2 * t] = pg * e0; tokw[2 * t + 1] = pg * (1.0f - e0);
            etok[(size_t)ea * T + pa] = t; etok[(size_t)eb * T + pb] = t;
        }
        __syncthreads();
    }
}
__device__ __forceinline__ int moe_tiles(const Params& p, int layer, LAS int* tab  , bool publish) {
    uchar* ws = p.ws;
    const unsigned* cnt = (const unsigned*)(ws + WS_CTL + CTL_CNT_OFF) + layer * 64;
    const int tid = tid_opaque();
    if (tid < 64) {
        const int cn = (int)cnt[tid], n = (cn + 255) >> 8;
        tab[256 + tid] = cn;
        int incl = n;
#pragma unroll
        for (int o = 1; o < 64; o <<= 1) { const int t_ = __shfl_up(incl, o); if (tid >= o) incl += t_; }
        const int first = incl - n;
        tab[128 + tid] = first;
        for (int q = 0; q < n; ++q) tab[first + q] = tid;
        if (tid == 63) tab[192] = incl;
    }
    __syncthreads();
    const int nt = tab[192];
    if (publish && blockIdx.x == 0) { int* g = (int*)(ws + WS_TILEE); for (int i = tid; i < nt; i += NTHREADS) g[i] = tab[i]; if (tid == 0) g[128] = nt; }
    return nt;
}
__device__ __forceinline__ void moe_gather(const Params& p, LAS uchar* lds, int layer) {
    uchar* ws = p.ws;
    LAS int* tab = (LAS int*)lds;
    moe_tiles(p, layer, tab, true);
    const int tid = tid_opaque(), lane = tid & 63, wave = tid >> 6;
    const int* toke = (const int*)(ws + WS_TOKE); const int* tokpos = (const int*)(ws + WS_TOKPOS); int* tokrow = (int*)(ws + WS_TOKROW);
    const bf16_t* h = (const bf16_t*)(ws + WS_HMIX); bf16_t* xg = (bf16_t*)(ws + WS_XG);
    const int stride = gridDim.x * NWAVES;
    for (int a = blockIdx.x * NWAVES + wave; a < 2 * T; a += 4 * stride) {
        int rows[4]; u32x4 v[4][4];
#pragma unroll
        for (int k = 0; k < 4; ++k) { const int ak = a + k * stride; rows[k] = ak < 2 * T ? tab[128 + toke[ak]] * 256 + tokpos[ak] : -1; }
#pragma unroll
        for (int k = 0; k < 4; ++k) { const int ak = a + k * stride; if (rows[k] >= 0) { const u32x4* src = (const u32x4*)(h + (size_t)(ak >> 1) * D);
#pragma unroll
            for (int i = 0; i < 4; ++i) v[k][i] = src[i * 64 + lane]; } }
#pragma unroll
        for (int k = 0; k < 4; ++k) { const int ak = a + k * stride; if (rows[k] >= 0) { if (lane == 0) tokrow[ak] = rows[k]; u32x4* dst = (u32x4*)(xg + (size_t)rows[k] * D);
#pragma unroll
            for (int i = 0; i < 4; ++i) dst[i * 64 + lane] = v[k][i]; } }
    }
    __syncthreads();
}
constexpr int MG_BOFF = 65536;
struct MgRegs { u32x4 a[8]; f32x4 b[8]; };
struct MgSrc { const bf16_t* A; int lda; const float* W0; const float* W1; int ldw, qs; int skip = 0; int valid = 256; unsigned aoff[4]; };

__device__ __forceinline__ void mg_issue(MgRegs& R, const MgSrc& s, int kt, int tid) {
#pragma unroll
    for (int i = 0; i < 8; ++i) { const int id = tid + NTHREADS * i, row = id >> 4, ch = id & 15; R.a[i] = *(const u32x4*)(s.A + (size_t)row * s.lda + kt * 128 + ch * 8); }
    const int kq = tid >> 5, nq = tid & 31, q = nq >> 3;
    const float* w = ((q & 1) ? s.W1 : s.W0) + s.qs * (q >> 1) + 4 * (nq & 7) + (size_t)(kt * 128 + 8 * kq) * s.ldw;
#pragma unroll
    for (int i = 0; i < 8; ++i) R.b[i] = *(const f32x4*)(w + (size_t)i * s.ldw);
}
__device__ __forceinline__ void mg_commit(const MgRegs& R, LAS uchar* stg, int tid) {
#pragma unroll
    for (int i = 0; i < 8; ++i) { const int id = tid + NTHREADS * i, row = id >> 4, ch = id & 15; *(LAS u32x4*)(stg + row * 256 + ((ch ^ (row & 15)) << 4)) = R.a[i]; }
    const int kq = tid >> 5, nq = tid & 31;
#pragma unroll
    for (int j = 0; j < 4; ++j) {
        const int n = 4 * nq + j;
        u32x4 v; v[0] = cvt_pk_bf16(R.b[0][j], R.b[1][j]); v[1] = cvt_pk_bf16(R.b[2][j], R.b[3][j]); v[2] = cvt_pk_bf16(R.b[4][j], R.b[5][j]); v[3] = cvt_pk_bf16(R.b[6][j], R.b[7][j]);
        *(LAS u32x4*)(stg + MG_BOFF + n * 256 + ((kq ^ (n & 15)) << 4)) = v;
    }
}
__device__ __forceinline__ void mg_compute(const LAS uchar* stg, f32x4 (&acc)[4][4], int wr, int wc, int fr, int fq) {
#pragma unroll
    for (int kk = 0; kk < 4; ++kk) {
        bf16x8 af[4], bfr[4];
#pragma unroll
        for (int m = 0; m < 4; ++m) { const int row = wr * 64 + m * 16 + fr; af[m] = *(const LAS bf16x8*)(stg + row * 256 + (((kk * 4 + fq) ^ (row & 15)) << 4)); }
#pragma unroll
        for (int n = 0; n < 4; ++n) { const int row = wc * 64 + n * 16 + fr; bfr[n] = *(const LAS bf16x8*)(stg + MG_BOFF + row * 256 + (((kk * 4 + fq) ^ (row & 15)) << 4)); }
#pragma unroll
        for (int m = 0; m < 4; ++m)
#pragma unroll
            for (int n = 0; n < 4; ++n) acc[m][n] = __builtin_amdgcn_mfma_f32_16x16x32_bf16(bfr[n], af[m], acc[m][n], 0, 0, 0);
    }
}
__device__ __forceinline__ void mg_tile(LAS uchar* lds, const MgSrc& s, int K, f32x4 (&acc)[4][4], int tid) {
    const int lane = tid & 63, wid = tid >> 6, wr = wid >> 1, wc = wid & 1, fr = lane & 15, fq = lane >> 4;
    const int nk = K / 128;
#pragma unroll
    for (int m = 0; m < 4; ++m)
#pragma unroll
        for (int n = 0; n < 4; ++n) acc[m][n] = (f32x4){0.f, 0.f, 0.f, 0.f};
    MgRegs R;
    mg_issue(R, s, 0, tid);
    for (int kt = 0; kt < nk; ++kt) {
        mg_commit(R, lds, tid);
        __syncthreads();
        if (kt + 1 < nk) mg_issue(R, s, kt + 1, tid);
        mg_compute(lds, acc, wr, wc, fr, fq);
        __syncthreads();
    }
}

constexpr int M64_STAGE = 49152;
constexpr int M64_BOFF = 32768;
struct M64Regs { u32x4 a[4]; f32x4 b[4]; };

__device__ __forceinline__ void m64_issue(M64Regs& R, const MgSrc& s, int kt, int tid) {
    if (!(s.skip & 1)) {
#pragma unroll
        for (int i = 0; i < 4; ++i) { const int id = tid + NTHREADS * i, row = id >> 3, ch = id & 7; R.a[i] = *(const u32x4*)(s.A + (size_t)row * s.lda + kt * 64 + ch * 8); }
    } else {
#pragma unroll
        for (int i = 0; i < 4; ++i) R.a[i] = (u32x4){0x3f803f80u, 0x3f803f80u, 0x3f803f80u, 0x3f803f80u};
    }
    const int kq = tid >> 5, nq = tid & 31, q = nq >> 3;
    const float* w = ((q & 1) ? s.W1 : s.W0) + s.qs * (q >> 1) + 4 * (nq & 7) + (size_t)(kt * 64 + 4 * kq) * s.ldw;
    if (!(s.skip & 2)) {
#pragma unroll
        for (int i = 0; i < 4; ++i) R.b[i] = *(const f32x4*)(w + (size_t)i * s.ldw);
    } else {
#pragma unroll
        for (int i = 0; i < 4; ++i) R.b[i] = (f32x4){1.f, 1.f, 1.f, 1.f};
    }
}
__device__ __forceinline__ void m64_commit(const M64Regs& R, LAS uchar* stg, int tid) {
#pragma unroll
    for (int i = 0; i < 4; ++i) { const int id = tid + NTHREADS * i, row = id >> 3, ch = id & 7; *(LAS u32x4*)(stg + row * 128 + ((ch ^ ((row >> 1) & 7)) << 4)) = R.a[i]; }
    const int kq = tid >> 5, nq = tid & 31;
#pragma unroll
    for (int j = 0; j < 4; ++j) {
        const int n = 4 * nq + j;
        u32x2 v; v[0] = cvt_pk_bf16(R.b[0][j], R.b[1][j]); v[1] = cvt_pk_bf16(R.b[2][j], R.b[3][j]);
        *(LAS u32x2*)(stg + M64_BOFF + n * 128 + (((kq >> 1) ^ (((n >> 1) ^ (n >> 4)) & 7)) << 4) + (kq & 1) * 8) = v;
    }
}
__device__ __forceinline__ void m64_compute(const LAS uchar* stg, f32x4 (&acc)[4][4], int wr, int wc, int fr, int fq) {
    bf16x8 af[2][4], bfr[2][4];
#pragma unroll
    for (int kk = 0; kk < 2; ++kk)
#pragma unroll
        for (int n = 0; n < 4; ++n) { const int row = wc * 64 + n * 16 + fr; bfr[kk][n] = *(const LAS bf16x8*)(stg + M64_BOFF + row * 128 + (((kk * 4 + fq) ^ (((row >> 1) ^ (row >> 4)) & 7)) << 4)); }
#pragma unroll
    for (int kk = 0; kk < 2; ++kk)
#pragma unroll
        for (int m = 0; m < 4; ++m) { const int row = wr * 64 + m * 16 + fr; af[kk][m] = *(const LAS bf16x8*)(stg + row * 128 + (((kk * 4 + fq) ^ ((row >> 1) & 7)) << 4)); }
#pragma unroll
    for (int kk = 0; kk < 2; ++kk)
#pragma unroll
        for (int m = 0; m < 4; ++m)
#pragma unroll
            for (int n = 0; n < 4; ++n) acc[m][n] = __builtin_amdgcn_mfma_f32_16x16x32_bf16(bfr[kk][n], af[kk][m], acc[m][n], 0, 0, 0);
}
__device__ __forceinline__ void m64_tile(LAS uchar* lds, const MgSrc& s, int K, f32x4 (&acc)[4][4], int tid) {
    const int lane = tid & 63, wid = tid >> 6, wr = wid >> 1, wc = wid & 1, fr = lane & 15, fq = lane >> 4;
    const int nk = K / 64;
#pragma unroll
    for (int m = 0; m < 4; ++m)
#pragma unroll
        for (int n = 0; n < 4; ++n) acc[m][n] = (f32x4){0.f, 0.f, 0.f, 0.f};
    M64Regs R0, R1;
    m64_issue(R0, s, 0, tid); m64_issue(R1, s, 1, tid);
    m64_commit(R0, lds, tid);
    __syncthreads();
    for (int kt = 0; kt < nk; kt += 2) {
        if (kt + 2 < nk) m64_issue(R0, s, kt + 2, tid);
        m64_compute(lds, acc, wr, wc, fr, fq);
        m64_commit(R1, lds + M64_STAGE, tid);
        __syncthreads();
        if (kt + 3 < nk) m64_issue(R1, s, kt + 3, tid);
        m64_compute(lds + M64_STAGE, acc, wr, wc, fr, fq);
        if (kt + 2 < nk) m64_commit(R0, lds, tid);
        __syncthreads();
    }
}


struct MaRegs { u32x4 a[4]; u32x4 b[4]; };
#define MA_LOAD(dst, ptr) asm volatile("global_load_dwordx4 %0, %1, off" : "=&v"(dst) : "v"(ptr) : "memory")
#define MA_LOAD_NT(dst, ptr) asm volatile("global_load_dwordx4 %0, %1, off nt" : "=&v"(dst) : "v"(ptr) : "memory")
#define MA_WAIT(R, n) asm volatile("s_waitcnt vmcnt(" #n ")" : "+v"(R.a[0]), "+v"(R.a[1]), "+v"(R.a[2]), "+v"(R.a[3]), "+v"(R.b[0]), "+v"(R.b[1]), "+v"(R.b[2]), "+v"(R.b[3]) :: "memory")
__device__ __forceinline__ void ma_issue(MaRegs& R, const MgSrc& s, int kt, int tid) {
#pragma unroll
    for (int i = 0; i < 4; ++i) { const int ch = tid & 7; const bf16_t* ptr = (const bf16_t*)((const char*)s.A + s.aoff[i]) + kt * 64 + ch * 8; MA_LOAD(R.a[i], ptr); }
    const int kq = tid >> 5, nq = tid & 31, q = nq >> 3;
    const float* w = ((q & 1) ? s.W1 : s.W0) + s.qs * (q >> 1) + 4 * (nq & 7) + (size_t)(kt * 64 + 4 * kq) * s.ldw;
#pragma unroll
    for (int i = 0; i < 4; ++i) { const float* ptr = w + (size_t)i * s.ldw; MA_LOAD(R.b[i], ptr); }
}
__device__ __forceinline__ void ma_commit(const MaRegs& R, LAS uchar* stg, int tid) {
#pragma unroll
    for (int i = 0; i < 4; ++i) { const int id = tid + NTHREADS * i, row = id >> 3, ch = id & 7; *(LAS u32x4*)(stg + row * 128 + ((ch ^ ((row >> 1) & 7)) << 4)) = R.a[i]; }
    const int kq = tid >> 5, nq = tid & 31;
#pragma unroll
    for (int j = 0; j < 4; ++j) {
        const int n = 4 * nq + j;
        u32x2 v; v[0] = cvt_pk_bf16(__uint_as_float(R.b[0][j]), __uint_as_float(R.b[1][j])); v[1] = cvt_pk_bf16(__uint_as_float(R.b[2][j]), __uint_as_float(R.b[3][j]));
        *(LAS u32x2*)(stg + M64_BOFF + n * 128 + (((kq >> 1) ^ (((n >> 1) ^ (n >> 4)) & 7)) << 4) + (kq & 1) * 8) = v;
    }
}
template <int NK>
__device__ __forceinline__ void ma_tile(LAS uchar* lds, const MgSrc& s, f32x4 (&acc)[4][4], int tid) {
    const int lane = tid & 63, wid = tid >> 6, wr = wid >> 1, wc = wid & 1, fr = lane & 15, fq = lane >> 4;
#pragma unroll
    for (int m = 0; m < 4; ++m)
#pragma unroll
        for (int n = 0; n < 4; ++n) acc[m][n] = (f32x4){0.f, 0.f, 0.f, 0.f};
    MaRegs R0, R1;
    ma_issue(R0, s, 0, tid); ma_issue(R1, s, 1, tid);
    MA_WAIT(R0, 8);
    ma_commit(R0, lds, tid);
    __syncthreads();
#pragma unroll 1
    for (int kt = 0; kt < NK - 2; kt += 2) {
        ma_issue(R0, s, kt + 2, tid);
        m64_compute(lds, acc, wr, wc, fr, fq);
        MA_WAIT(R1, 8);
        ma_commit(R1, lds + M64_STAGE, tid);
        __syncthreads();
        ma_issue(R1, s, kt + 3, tid);
        m64_compute(lds + M64_STAGE, acc, wr, wc, fr, fq);
        MA_WAIT(R0, 8);
        ma_commit(R0, lds, tid);
        __syncthreads();
    }
    {
        m64_compute(lds, acc, wr, wc, fr, fq);
        MA_WAIT(R1, 0);
        ma_commit(R1, lds + M64_STAGE, tid);
        __syncthreads();
        m64_compute(lds + M64_STAGE, acc, wr, wc, fr, fq);
        __syncthreads();
    }
    return;
#pragma unroll
    for (int kt = 0; kt < 0; kt += 2) {
        if (kt + 2 < NK) ma_issue(R0, s, kt + 2, tid);
        m64_compute(lds, acc, wr, wc, fr, fq);
        if (kt + 2 < NK) { MA_WAIT(R1, 8); } else { MA_WAIT(R1, 0); }
        ma_commit(R1, lds + M64_STAGE, tid);
        __syncthreads();
        if (kt + 3 < NK) ma_issue(R1, s, kt + 3, tid);
        m64_compute(lds + M64_STAGE, acc, wr, wc, fr, fq);
        if (kt + 2 < NK) {
            if (kt + 3 < NK) { MA_WAIT(R0, 8); } else { MA_WAIT(R0, 0); }
            ma_commit(R0, lds, tid);
        }
        __syncthreads();
    }
}

#ifndef MG2_WS
#define MG2_WS 1
#endif
#ifndef MG1_BK
#define MG1_BK 1
#endif
#ifndef MG2_BK
#define MG2_BK 64
#endif
__device__ __forceinline__ void moe_gemm1(const Params& p, LAS uchar* lds, int layer) {
    uchar* ws = p.ws;
    LAS int* tab = (LAS int*)(lds + 131072);
    const int nt = moe_tiles(p, layer, tab, false);
    const int tid = tid_opaque(), lane = tid & 63, wid = tid >> 6, wr = wid >> 1, wc = wid & 1, fr = lane & 15, fq = lane >> 4;
    bf16_t* hid = (bf16_t*)(ws + WS_HID);
    {
        const int* toke = (const int*)(ws + WS_TOKE); const int* tokpos = (const int*)(ws + WS_TOKPOS); int* tokrow = (int*)(ws + WS_TOKROW);
        for (int a = blockIdx.x * NTHREADS + tid; a < 2 * T; a += gridDim.x * NTHREADS) tokrow[a] = tab[128 + toke[a]] * 256 + tokpos[a];
    }
    const bool xg = (gridDim.x & 63) == 0; const int bx = blockIdx.x, sl = bx >> 3, tpr = gridDim.x >> 3;
    for (int L = xg ? ((bx & 7) * (tpr >> 3) + (sl >> 3)) * 8 + (sl & 7) : bx; L < nt * 8; L += xg ? tpr * 8 : gridDim.x) {
        const int tile = L >> 3, nu = L & 7, e = __builtin_amdgcn_readfirstlane(tab[tile]);
        MgSrc s; s.A = (const bf16_t*)(ws + WS_HMIX); s.lda = 2048; s.ldw = 512; s.qs = 32;
        { const int jt = tile - __builtin_amdgcn_readfirstlane(tab[128 + e]), left = __builtin_amdgcn_readfirstlane(tab[256 + e]) - jt * 256; s.valid = left < 256 ? left : 256;
          const int* et = (const int*)(ws + WS_ETOK) + (size_t)e * T + jt * 256;
#pragma unroll
          for (int i = 0; i < 4; ++i) { const int row = (tid >> 3) + 64 * i; s.aoff[i] = (unsigned)et[row < s.valid ? row : 0] * 4096u; } }
        s.W0 = p.in[I_MWG] + (size_t)(layer * 64 + e) * 2048 * 512 + nu * 64; s.W1 = p.in[I_MWU] + (size_t)(layer * 64 + e) * 2048 * 512 + nu * 64;
        f32x4 acc[4][4];
#if MG1_BK == 128
        mg_tile(lds, s, 2048, acc, tid);
#elif MG1_BK == 64
        m64_tile(lds, s, 2048, acc, tid);
#else
        ma_tile<32>(lds, s, acc, tid);
#endif
#pragma unroll
        for (int m = 0; m < 4; ++m) {
            bf16_t* rowp = hid + (size_t)(tile * 256 + wr * 64 + m * 16 + fr) * 512 + nu * 64 + wc * 32 + 4 * fq;
#pragma unroll
            for (int n = 0; n < 2; ++n) { const f32x4 a = acc[m][n], b = acc[m][n + 2];
                u32x2 o; o[0] = cvt_pk_bf16(siluf_(a[0]) * b[0], siluf_(a[1]) * b[1]); o[1] = cvt_pk_bf16(siluf_(a[2]) * b[2], siluf_(a[3]) * b[3]); *(u32x2*)(rowp + n * 16) = o; }
        }
    }
}
template <int VAR> __device__ __forceinline__ void moe_gemm2v(const Params& p, LAS uchar* lds, int layer, bf16_t* yb) {
    uchar* ws = p.ws;
    LAS int* tab = (LAS int*)(lds + 131072);
    const int nt = moe_tiles(p, layer, tab, false);
    const int tid = tid_opaque(), lane = tid & 63, wid = tid >> 6, wr = wid >> 1, wc = wid & 1, fr = lane & 15, fq = lane >> 4;
    const bool xg = (gridDim.x & 127) == 0; const int bx = blockIdx.x, sl = bx >> 3, tpr = gridDim.x >> 4;
    for (int L = xg ? ((bx & 7) * (tpr >> 3) + (sl >> 4)) * 16 + (sl & 15) : bx; L < nt * 16; L += xg ? tpr * 16 : gridDim.x) {
        const int tile = L >> 4, nu = L & 15, e = __builtin_amdgcn_readfirstlane(tab[tile]);
        MgSrc s; s.A = (const bf16_t*)(ws + WS_HID) + (size_t)tile * 256 * 512; s.lda = 512; s.ldw = 2048; s.qs = 64; s.skip = (VAR == 65) ? 1 : (VAR == 66) ? 2 : 0;
#pragma unroll
        for (int i = 0; i < 4; ++i) s.aoff[i] = (unsigned)((tid >> 3) + 64 * i) * 1024u;
        s.W0 = p.in[I_MWD] + (size_t)(layer * 64 + e) * 512 * 2048 + nu * 128; s.W1 = s.W0 + 32;
        f32x4 acc[4][4];
        if (VAR == 128) mg_tile(lds, s, 512, acc, tid); else if (VAR >= 64 && VAR <= 66) m64_tile(lds, s, 512, acc, tid); else ma_tile<8>(lds, s, acc, tid);
#pragma unroll
        for (int m = 0; m < 4; ++m) {
            bf16_t* rowp = yb + (size_t)(tile * 256 + wr * 64 + m * 16 + fr) * 2048 + nu * 128 + wc * 64 + 4 * fq;
#pragma unroll
            for (int n = 0; n < 4; ++n) { const f32x4 v = acc[m][n]; u32x2 o; o[0] = cvt_pk_bf16(v[0], v[1]); o[1] = cvt_pk_bf16(v[2], v[3]); *(u32x2*)(rowp + n * 16) = o; }
        }
    }
}

constexpr int WS2_PITCH = 1040;
constexpr int WS2_TAB = 139264;
template <int DBG> __device__ __forceinline__ void moe_gemm2_wsv(const Params& p, LAS uchar* lds, int layer, bf16_t* yb, const XcdBarrier& gbar, bool do_gbar) {
    uchar* ws = p.ws;
    LAS int* tab = (LAS int*)(lds + WS2_TAB);
    (void)moe_tiles(p, layer, tab, false);
    const int tid = tid_opaque(), lane = tid & 63, wave = tid >> 6, fr = lane & 15, fq = lane >> 4;
    const unsigned* cnt = (const unsigned*)(ws + WS_CTL + CTL_CNT_OFF) + layer * 64;
    const bf16_t* hid = (const bf16_t*)(ws + WS_HID);
    const int kq = tid >> 5, nq = tid & 31;
    LAS uchar* wbase = lds + nq * (4 * WS2_PITCH) + kq * 8;
    const LAS uchar* rbase = lds + fr * WS2_PITCH + fq * 16;
    bool synced = false;
    for (int L = blockIdx.x; L < 64 * 16; L += gridDim.x) {
        const int e = L >> 4, nu = L & 15;
        const int count = __builtin_amdgcn_readfirstlane(tab[256 + e]), r0 = __builtin_amdgcn_readfirstlane(tab[128 + e]) * 256;
        if (count == 0) continue;
        const float* W = p.in[I_MWD] + (size_t)(layer * 64 + e) * 512 * 2048 + nu * 128 + (size_t)(4 * kq) * 2048 + 4 * nq;
#pragma unroll 1
        for (int half = 0; half < 2; ++half) {
            f32x4 b[4][4];
#pragma unroll
            for (int t4 = 0; t4 < 4; ++t4)
#pragma unroll
                for (int i = 0; i < 4; ++i) b[t4][i] = (DBG == 1) ? (f32x4){1.f, 1.f, 1.f, 1.f} : *(const f32x4*)(W + (size_t)((half * 4 + t4) * 64 + i) * 2048);
#pragma unroll
            for (int t4 = 0; t4 < 4; ++t4)
#pragma unroll
                for (int j = 0; j < 4; ++j) {
                    u32x2 v; v[0] = cvt_pk_bf16(b[t4][0][j], b[t4][1][j]); v[1] = cvt_pk_bf16(b[t4][2][j], b[t4][3][j]);
                    *(LAS u32x2*)(wbase + j * WS2_PITCH + (half * 4 + t4) * 128) = v;
                }
        }
        __syncthreads();
        if (!synced) { if (do_gbar) xcd_barrier(gbar); synced = true; }
        const int mtiles = (DBG == 2) ? 0 : ((count + 15) >> 4);
        for (int mt = wave; mt < mtiles; mt += NWAVES) {
            const bf16_t* arow = hid + (size_t)(r0 + mt * 16 + fr) * 512 + 8 * fq;
            bf16x8 af[16];
#pragma unroll
            for (int ks = 0; ks < 16; ++ks) af[ks] = *(const bf16x8*)(arow + ks * 32);
            f32x4 acc[8];
#pragma unroll
            for (int n = 0; n < 8; ++n) acc[n] = (f32x4){0.f, 0.f, 0.f, 0.f};
#pragma unroll
            for (int ks = 0; ks < 16; ++ks) {
#pragma unroll
                for (int n = 0; n < 8; ++n) {
                    const bf16x8 bf = *(const LAS bf16x8*)(rbase + n * (16 * WS2_PITCH) + ks * 64);
                    acc[n] = __builtin_amdgcn_mfma_f32_16x16x32_bf16(bf, af[ks], acc[n], 0, 0, 0);
                }
                if (ks & 1) __builtin_amdgcn_sched_barrier(0);
            }
            bf16_t* orow = yb + (size_t)(r0 + mt * 16 + fr) * 2048 + nu * 128 + 4 * fq;
#pragma unroll
            for (int n = 0; n < 8; ++n) { u32x2 o; o[0] = cvt_pk_bf16(acc[n][0], acc[n][1]); o[1] = cvt_pk_bf16(acc[n][2], acc[n][3]); *(u32x2*)(orow + n * 16) = o; }
        }
        __syncthreads();
    }
    if (!synced && do_gbar) xcd_barrier(gbar);
}

struct Ws2Unit { int e, nu, count, r0; };
__device__ __forceinline__ bool ws2_find(int& L, int step, const unsigned* cnt, const LAS int* tab, Ws2Unit& u) {
    for (; L < 64 * 16; L += step) { const int e = L >> 4, c = __builtin_amdgcn_readfirstlane((int)cnt[e]); if (c > 0) { u.e = e; u.nu = L & 15; u.count = c; u.r0 = __builtin_amdgcn_readfirstlane(tab[128 + e]) * 256; return true; } }
    return false;
}
__device__ __forceinline__ void ws2_load_w(f32x4 (&b)[2][4], const float* W, int q) {
#pragma unroll
    for (int t2 = 0; t2 < 2; ++t2)
#pragma unroll
        for (int i = 0; i < 4; ++i) b[t2][i] = *(const f32x4*)(W + (size_t)((2 * q + t2) * 64 + i) * 2048);
}
__device__ __forceinline__ void ws2_load_a(bf16x8 (&a)[2][4], const bf16_t* hid, const Ws2Unit& u, int q, int wave, int fr, int fq) {
    const int mtiles = (u.count + 15) >> 4;
#pragma unroll
    for (int t = 0; t < 2; ++t) {
        const int mt = wave + 8 * t < mtiles ? wave + 8 * t : 0;
        const bf16_t* arow = hid + (size_t)(u.r0 + mt * 16 + fr) * 512 + q * 128 + 8 * fq;
#pragma unroll
        for (int kk = 0; kk < 4; ++kk) a[t][kk] = *(const bf16x8*)(arow + kk * 32);
    }
}
__device__ __forceinline__ void moe_gemm2_wsp(const Params& p, LAS uchar* lds, int layer) {
    uchar* ws = p.ws;
    LAS int* tab = (LAS int*)(lds + WS2_TAB);
    (void)moe_tiles(p, layer, tab, false);
    const int tid = tid_opaque(), lane = tid & 63, wave = tid >> 6, fr = lane & 15, fq = lane >> 4;
    const unsigned* cnt = (const unsigned*)(ws + WS_CTL + CTL_CNT_OFF) + layer * 64;
    const bf16_t* hid = (const bf16_t*)(ws + WS_HID); bf16_t* yb = (bf16_t*)(ws + WS_YB);
    const int kq = tid >> 5, nq = tid & 31, G = gridDim.x;
    LAS uchar* wbase = lds + nq * (4 * WS2_PITCH) + kq * 8;
    const LAS uchar* rbase = lds + fr * WS2_PITCH + fq * 16;
    const float* Wall = p.in[I_MWD] + (size_t)layer * 64 * 512 * 2048 + (size_t)(4 * kq) * 2048 + 4 * nq;
    int L = blockIdx.x; Ws2Unit U, Un;
    if (!ws2_find(L, G, cnt, tab, U)) return;
    f32x4 breg[2][4]; bf16x8 afn[2][4];
    ws2_load_w(breg, Wall + (size_t)U.e * 512 * 2048 + U.nu * 128, 0);
    ws2_load_a(afn, hid, U, 0, wave, fr, fq);
    for (;;) {
        int Ln = L + G; const bool has_next = ws2_find(Ln, G, cnt, tab, Un);
        const int mtiles = (U.count + 15) >> 4;
        const float* W = Wall + (size_t)U.e * 512 * 2048 + U.nu * 128;
        f32x4 acc[2][8];
#pragma unroll
        for (int t = 0; t < 2; ++t)
#pragma unroll
            for (int n = 0; n < 8; ++n) acc[t][n] = (f32x4){0.f, 0.f, 0.f, 0.f};
#pragma unroll 1
        for (int q = 0; q < 4; ++q) {
#pragma unroll
            for (int t2 = 0; t2 < 2; ++t2)
#pragma unroll
                for (int j = 0; j < 4; ++j) {
                    u32x2 v; v[0] = cvt_pk_bf16(breg[t2][0][j], breg[t2][1][j]); v[1] = cvt_pk_bf16(breg[t2][2][j], breg[t2][3][j]);
                    *(LAS u32x2*)(wbase + j * WS2_PITCH + (2 * q + t2) * 128) = v;
                }
            bf16x8 afc[2][4];
#pragma unroll
            for (int t = 0; t < 2; ++t)
#pragma unroll
                for (int kk = 0; kk < 4; ++kk) afc[t][kk] = afn[t][kk];
            __syncthreads();
            if (q < 3) { ws2_load_w(breg, W, q + 1); ws2_load_a(afn, hid, U, q + 1, wave, fr, fq); }
            else if (has_next) { ws2_load_w(breg, Wall + (size_t)Un.e * 512 * 2048 + Un.nu * 128, 0); ws2_load_a(afn, hid, Un, 0, wave, fr, fq); }
            const LAS uchar* rq = rbase + q * 256;
#pragma unroll
            for (int kk = 0; kk < 4; ++kk) {
#pragma unroll
                for (int n = 0; n < 8; ++n) {
                    const bf16x8 bf = *(const LAS bf16x8*)(rq + n * (16 * WS2_PITCH) + kk * 64);
                    acc[0][n] = __builtin_amdgcn_mfma_f32_16x16x32_bf16(bf, afc[0][kk], acc[0][n], 0, 0, 0);
                    acc[1][n] = __builtin_amdgcn_mfma_f32_16x16x32_bf16(bf, afc[1][kk], acc[1][n], 0, 0, 0);
                }
                if (kk & 1) __builtin_amdgcn_sched_barrier(0);
            }
        }
#pragma unroll
        for (int t = 0; t < 2; ++t) {
            const int mt = wave + 8 * t;
            if (mt < mtiles) {
                bf16_t* orow = yb + (size_t)(U.r0 + mt * 16 + fr) * 2048 + U.nu * 128 + 4 * fq;
#pragma unroll
                for (int n = 0; n < 8; ++n) { u32x2 o; o[0] = cvt_pk_bf16(acc[t][n][0], acc[t][n][1]); o[1] = cvt_pk_bf16(acc[t][n][2], acc[t][n][3]); *(u32x2*)(orow + n * 16) = o; }
            }
        }
        if (mtiles > 16) {
            for (int mt = wave + 16; mt < mtiles; mt += NWAVES) {
                const bf16_t* arow = hid + (size_t)(U.r0 + mt * 16 + fr) * 512 + 8 * fq;
                f32x4 ax[8];
#pragma unroll
                for (int n = 0; n < 8; ++n) ax[n] = (f32x4){0.f, 0.f, 0.f, 0.f};
#pragma unroll 1
                for (int ks = 0; ks < 16; ++ks) {
                    const bf16x8 af = *(const bf16x8*)(arow + ks * 32);
#pragma unroll
                    for (int n = 0; n < 8; ++n) { const bf16x8 bf = *(const LAS bf16x8*)(rbase + n * (16 * WS2_PITCH) + ks * 64); ax[n] = __builtin_amdgcn_mfma_f32_16x16x32_bf16(bf, af, ax[n], 0, 0, 0); }
                }
                bf16_t* orow = yb + (size_t)(U.r0 + mt * 16 + fr) * 2048 + U.nu * 128 + 4 * fq;
#pragma unroll
                for (int n = 0; n < 8; ++n) { u32x2 o; o[0] = cvt_pk_bf16(ax[n][0], ax[n][1]); o[1] = cvt_pk_bf16(ax[n][2], ax[n][3]); *(u32x2*)(orow + n * 16) = o; }
            }
            __syncthreads();
        }
        if (!has_next) break;
        U = Un; L = Ln;
    }
    __syncthreads();
}

__device__ __forceinline__ void moe_gemm2_wsq(const Params& p, LAS uchar* lds, int layer) {
    uchar* ws = p.ws;
    LAS int* tab = (LAS int*)(lds + WS2_TAB);
    (void)moe_tiles(p, layer, tab, false);
    const int tid = tid_opaque(), lane = tid & 63, wave = tid >> 6, fr = lane & 15, fq = lane >> 4;
    const unsigned* cnt = (const unsigned*)(ws + WS_CTL + CTL_CNT_OFF) + layer * 64;
    const bf16_t* hid = (const bf16_t*)(ws + WS_HID); bf16_t* yb = (bf16_t*)(ws + WS_YB);
    const int kq = tid >> 5, nq = tid & 31, G = gridDim.x;
    LAS uchar* wbase = lds + nq * (4 * WS2_PITCH) + kq * 8;
    const LAS uchar* rbase = lds + fr * WS2_PITCH + fq * 16;
    const float* Wm = p.in[I_MWD] + (size_t)layer * 64 * 512 * 2048 + (size_t)(4 * kq) * 2048 + 4 * nq;
    Ws2Unit U, Un; int L = blockIdx.x;
    if (!ws2_find(L, G, cnt, tab, U)) return;
#define WQ_LOAD(DST, UU, T0) do { const float* w_ = Wm + (size_t)(UU).e * 512 * 2048 + (UU).nu * 128; _Pragma("unroll") for (int t4 = 0; t4 < 4; ++t4) _Pragma("unroll") for (int i = 0; i < 4; ++i) \
        DST[t4][i] = *(const f32x4*)(w_ + (size_t)(((T0) + t4) * 64 + i) * 2048); } while (0)
#define WQ_STORE(SRC, T0) do { _Pragma("unroll") for (int t4 = 0; t4 < 4; ++t4) _Pragma("unroll") for (int j = 0; j < 4; ++j) { \
        u32x2 v; v[0] = cvt_pk_bf16(SRC[t4][0][j], SRC[t4][1][j]); v[1] = cvt_pk_bf16(SRC[t4][2][j], SRC[t4][3][j]); *(LAS u32x2*)(wbase + j * WS2_PITCH + ((T0) + t4) * 128) = v; } } while (0)
#define WQ_LOADA(AF, MT) do { const bf16_t* arow_ = hid + (size_t)(U.r0 + (MT) * 16 + fr) * 512 + 8 * fq; _Pragma("unroll") for (int ks = 0; ks < 16; ++ks) AF[ks] = *(const bf16x8*)(arow_ + ks * 32); } while (0)
#define WQ_TILE(AF, MT) do { f32x4 acc[8]; _Pragma("unroll") for (int n = 0; n < 8; ++n) acc[n] = (f32x4){0.f, 0.f, 0.f, 0.f}; \
        _Pragma("unroll") for (int ks = 0; ks < 16; ++ks) { _Pragma("unroll") for (int n = 0; n < 8; ++n) { \
            const bf16x8 bf = *(const LAS bf16x8*)(rbase + n * (16 * WS2_PITCH) + ks * 64); acc[n] = __builtin_amdgcn_mfma_f32_16x16x32_bf16(bf, AF[ks], acc[n], 0, 0, 0); } \
            if (ks & 1) __builtin_amdgcn_sched_barrier(0); } \
        bf16_t* orow = yb + (size_t)(U.r0 + (MT) * 16 + fr) * 2048 + U.nu * 128 + 4 * fq; \
        _Pragma("unroll") for (int n = 0; n < 8; ++n) { u32x2 o; o[0] = cvt_pk_bf16(acc[n][0], acc[n][1]); o[1] = cvt_pk_bf16(acc[n][2], acc[n][3]); *(u32x2*)(orow + n * 16) = o; } } while (0)
    f32x4 pf[4][4];
    WQ_LOAD(pf, U, 0);
    for (;;) {
        { f32x4 b2[4][4]; WQ_LOAD(b2, U, 4); WQ_STORE(pf, 0); WQ_STORE(b2, 4); }
        __syncthreads();
        int Ln = L + G; const bool has_next = ws2_find(Ln, G, cnt, tab, Un);
        const int mtiles = (U.count + 15) >> 4;
        int mt = wave;
        if (mt < mtiles) {
            bf16x8 af[16];
            WQ_LOADA(af, mt);
            if (has_next) WQ_LOAD(pf, Un, 0);
            WQ_TILE(af, mt);
            mt += NWAVES;
        } else if (has_next) WQ_LOAD(pf, Un, 0);
        for (; mt < mtiles; mt += NWAVES) { bf16x8 af[16]; WQ_LOADA(af, mt); WQ_TILE(af, mt); }
        __syncthreads();
        if (!has_next) break;
        U = Un; L = Ln;
    }
#undef WQ_LOAD
#undef WQ_STORE
#undef WQ_LOADA
#undef WQ_TILE
}

__device__ __forceinline__ void moe_gemm2(const Params& p, LAS uchar* lds, int layer, const XcdBarrier& gbar, bool do_gbar) {
#if defined(PROBE_G2SHADOW)
    moe_gemm2v<PROBE_G2SHADOW>(p, lds, layer, (bf16_t*)(p.ws + WS_XG));
    moe_gemm2v<64>(p, lds, layer, (bf16_t*)(p.ws + WS_YB));
#elif defined(MG2_WS) && MG2_WS

#if MG2_WS == 2
    if (do_gbar) xcd_barrier(gbar);
    moe_gemm2_wsp(p, lds, layer);
#elif MG2_WS == 3
    moe_gemm2_wsq(p, lds, layer);
#else
    moe_gemm2_wsv<0>(p, lds, layer, (bf16_t*)(p.ws + WS_YB), gbar, do_gbar);
#endif
#else
    moe_gemm2v<MG2_BK>(p, lds, layer, (bf16_t*)(p.ws + WS_YB));
#endif
}
constexpr int N_PHASES = 25;
#ifndef MK_N_LAUNCHES
#define MK_N_LAUNCHES 1
#endif
#ifndef EN_MIX0
#define EN_MIX0 1
#endif
#ifndef EN_MIX1
#define EN_MIX1 1
#endif
#ifndef EN_MOE
#define EN_MOE 1
#endif
constexpr int LDS_TAB = 131072;
constexpr int LDS_XB = LDS_BYTES - 16;
typedef const __attribute__((address_space(4))) Params* KParamsPtr;
__device__ __forceinline__ KParamsPtr kparams() { KParamsPtr kp = (KParamsPtr)__builtin_amdgcn_kernarg_segment_ptr(); asm volatile("" : "+s"(kp)); return kp; }
__device__ __forceinline__ void load_params(Params& p, KParamsPtr k) {
#pragma unroll
    for (int i = 0; i < 33; ++i) p.in[i] = (const float*)(const __attribute__((address_space(1))) float*)k->in[i];
    p.out = (float*)(__attribute__((address_space(1))) float*)k->out; p.ws = (uchar*)(__attribute__((address_space(1))) uchar*)k->ws; p.ph_lo = k->ph_lo; p.ph_hi = k->ph_hi;
}
#define PHASE_FN static __device__ __forceinline__ void
#define KPARAMS Params p; load_params(p, kparams()); uchar* ws = p.ws; (void)ws
constexpr size_t TS2048 = (size_t)256 * 2048 * 2, TS512 = (size_t)256 * 512 * 2, TS2048Q = (size_t)256 * 2048;

PHASE_FN ph_prologue(LAS uchar* lds) { KPARAMS; phase_prologue(p, lds); }
PHASE_FN ph_copy(int which) {
    KPARAMS; bf16_t* dst = (bf16_t*)(ws + (which == 2 ? WS_XB : WS_XA)); const size_t n = (size_t)T * D;
    for (size_t i = (size_t)blockIdx.x * NTHREADS + tid_opaque(); i < n; i += (size_t)gridDim.x * NTHREADS)
        dst[i] = which == 0 ? f2bf(p.in[I_X][i]) : ((const bf16_t*)(ws + (which == 1 ? WS_XB : WS_XA)))[i];
}
PHASE_FN ph_norm_plain(int which) {
    KPARAMS; float* mod = (float*)(ws + WS_MOD); bf16_t* hmix = (bf16_t*)(ws + WS_HMIX);
    if (which == 0) phase_norm<false, false, true>(p.in[I_X], p.in[I_NMG], mod, mod + 2048, nullptr, nullptr, nullptr, nullptr, nullptr, nullptr, nullptr, ws + WS_HMIX, (float*)(ws + WS_SC_TOK));
    else if (which == 3) phase_norm<false, false, true, true>((const void*)(ws + WS_XA), p.in[I_NMG] + 2048, mod + 12288, mod + 12288 + 2048, nullptr, nullptr, nullptr, nullptr, nullptr, nullptr, nullptr, ws + WS_HMIX, (float*)(ws + WS_SC_TOK));
    else { const int layer = which - 1; phase_norm<false, false, false, true>((const void*)(ws + WS_XA), p.in[I_NFG] + layer * 2048, mod + layer * 12288 + 3 * 2048, mod + layer * 12288 + 4 * 2048, hmix, nullptr, nullptr, nullptr, nullptr, nullptr, nullptr); }
}
PHASE_FN ph_norm_combine() {
    KPARAMS; float* mod = (float*)(ws + WS_MOD);
    phase_norm<true, false, true, true>((const void*)(ws + WS_XA), p.in[I_NMG] + 2048, mod + 12288, mod + 12288 + 2048, nullptr, nullptr, (const bf16_t*)(ws + WS_YB), (const int*)(ws + WS_TOKROW), (const float*)(ws + WS_TOKW), mod + 5 * 2048, (bf16_t*)(ws + WS_XB), ws + WS_HMIX, (float*)(ws + WS_SC_TOK));
}
PHASE_FN ph_final(int with_moe) {
    KPARAMS; float* mod = (float*)(ws + WS_MOD);
    if (with_moe) phase_norm<true, true, false, true>((const void*)(ws + WS_XA), p.in[I_FG], nullptr, nullptr, nullptr, p.out, (const bf16_t*)(ws + WS_YB), (const int*)(ws + WS_TOKROW), (const float*)(ws + WS_TOKW), mod + 12288 + 5 * 2048, nullptr);
    else phase_norm<false, true, false, true>((const void*)(ws + WS_XA), p.in[I_FG], nullptr, nullptr, nullptr, p.out, nullptr, nullptr, nullptr, nullptr, nullptr);
}
PHASE_FN ph_win0(LAS uchar* lds) {
    KPARAMS; const char* hmix = (const char*)(ws + WS_HMIX);
    SchedDense2 S; S.A1 = hmix; S.B1 = (const char*)(ws + WS_WIN0T); S.nM1 = 32; S.nN1 = 16; S.A2 = nullptr; S.B2 = nullptr; S.nM2 = 0; S.nN2 = 0; S.G = gridDim.x; S.c = blockIdx.x; S.tstep = TS2048Q;
    EpiWin0 E{(bf16_t*)(ws + U_Q), (bf16_t*)(ws + U_KB), (bf16_t*)(ws + U_VT), (bf16_t*)(ws + U_Y), (float*)(ws + U_XBR), (float*)(ws + U_GATE), (const float*)(ws + WS_SC_TOK), (const float*)(ws + WS_SC_W0), (const float*)(ws + WS_SC_WV)};
    pg8::gemm_phase<EpiWin0, SchedDense2>(lds, 1024, S, E, nullptr);
}
PHASE_FN ph_l0_local(LAS uchar* lds) {
    KPARAMS;
    {
        const char* hmix = (const char*)(ws + WS_HMIX);
        SchedDense2 S; S.A1 = hmix; S.B1 = (const char*)(ws + WS_WIN0T) + (size_t)16 * TS2048Q; S.nM1 = 32; S.nN1 = 1; S.aux1 = 2; S.A2 = (const char*)(ws + WS_WV0T); S.B2 = hmix; S.nM2 = 2; S.nN2 = 32; S.aux2 = 1;
        S.G = gridDim.x; S.c = blockIdx.x; S.tstep = TS2048Q;
        EpiWin0 E{(bf16_t*)(ws + U_Q), (bf16_t*)(ws + U_KB), (bf16_t*)(ws + U_VT), (bf16_t*)(ws + U_Y), (float*)(ws + U_XBR), (float*)(ws + U_GATE), (const float*)(ws + WS_SC_TOK), (const float*)(ws + WS_SC_W0), (const float*)(ws + WS_SC_WV)};
        pg8::gemm_phase<EpiWin0, SchedDense2>(lds, 1024, S, E, nullptr);
    }
    const int G = gridDim.x, vb = (int)blockIdx.x >= 96 ? (int)blockIdx.x - 96 : (int)blockIdx.x + (G - 96);
    for (int u = (G > 96 ? vb : (int)blockIdx.x); u < 64; u += G) compress_unit(p, lds, u);
    unsigned* qctr = (unsigned*)(ws + WS_CTL + CTL_LRUQ_OFF);
    LAS int* qs = (LAS int*)(lds + LDS_BYTES - 64);
    const int tid = tid_opaque();
    if (tid == 0) { qs[0] = (int)atomicAdd(qctr, 1u); qs[1] = (int)atomicAdd(qctr, 1u); }
    __syncthreads();
    int u = qs[0], unext = qs[1];
    float xpre[19];
    if (u < 1024) lru_xload(xpre, ws, u, tid);
    while (u < 1024) {
        int tk = 0;
        if (tid == 0) tk = (int)atomicAdd(qctr, 1u);
        lru_local_unit(p, lds, u, unext < 1024 ? unext : -1, xpre);
        if (tid == 0) qs[0] = tk;
        __syncthreads();
        u = unext; unext = qs[0];
        __syncthreads();
    }
}
PHASE_FN ph_attn(LAS uchar* lds) {
    KPARAMS; for (int u = blockIdx.x; u < 256; u += gridDim.x) { attn_unit(p, lds, u & 1, 255 - (u >> 1)); attn_unit(p, lds, u & 1, u >> 1); } }
PHASE_FN ph_lru_fix() { KPARAMS; for (int u = blockIdx.x; u < 256; u += gridDim.x) lru_fix_unit(p, u); }
PHASE_FN ph_wout(LAS uchar* lds, int layer) {
    KPARAMS; float* mod = (float*)(ws + WS_MOD) + layer * 12288;
    SchedDense2 S; S.A1 = (const char*)(ws + (layer ? V_HGO : U_CAT)); S.B1 = (const char*)(ws + (layer ? WS_WOUT1T : WS_WOUT0T)); S.nM1 = 32; S.nN1 = 8; S.A2 = nullptr; S.B2 = nullptr; S.nM2 = 0; S.nN2 = 0; S.G = gridDim.x; S.c = blockIdx.x; S.tstep = TS2048;
    if (layer) { EpiResid<true> E{(const void*)(ws + WS_XB), mod + 2 * 2048, (bf16_t*)(ws + WS_XA)}; pg8::gemm_phase<EpiResid<true>, SchedDense2>(lds, 2048, S, E, nullptr); }
    else { EpiResid<false> E{(const void*)p.in[I_X], mod + 2 * 2048, (bf16_t*)(ws + WS_XA)}; pg8::gemm_phase<EpiResid<false>, SchedDense2>(lds, 2048, S, E, nullptr); }
}
PHASE_FN ph_win1(LAS uchar* lds) {
    KPARAMS;
    SchedDense2 S; S.A1 = (const char*)(ws + WS_HMIX); S.B1 = (const char*)(ws + WS_WIN1T); S.nM1 = 32; S.nN1 = 32; S.A2 = nullptr; S.B2 = nullptr; S.nM2 = 0; S.nN2 = 0; S.G = gridDim.x; S.c = blockIdx.x; S.tstep = TS2048Q; S.mix32 = true;
    EpiWin1 E{ws, p.in[I_LBL]};
    pg8::gemm_phase<EpiWin1, SchedDense2>(lds, 1024, S, E, nullptr);
}
PHASE_FN ph_hgrn_local(LAS uchar* lds) { KPARAMS; hgrn_local_phase(p, lds); }
PHASE_FN ph_hgrn_scan() { KPARAMS; hgrn_scan(p); }
PHASE_FN ph_hgrn_out(LAS uchar* lds) { KPARAMS; (void)lds; hgrn_out_phase(p); }
PHASE_FN ph_logit(LAS uchar* lds, int layer) {
    KPARAMS;
    SchedSplitK S; S.A = (const char*)(ws + WS_HMIX); S.B = (const char*)(ws + WS_ROUTET) + (size_t)layer * 256 * 2048 * 2; S.G = gridDim.x; S.c = blockIdx.x; S.tstep = TS2048;
    EpiLogit E{(float*)(ws + WS_LOGIT)};
    pg8::gemm_phase<EpiLogit, SchedSplitK>(lds, 2048, S, E, nullptr, 256);
}
PHASE_FN ph_route(int layer) { KPARAMS; moe_route(p, layer); }
PHASE_FN ph_ffn_route(LAS uchar* lds, int layer) { KPARAMS; moe_norm_route(p, lds, layer); }
PHASE_FN ph_gather(LAS uchar* lds, int layer) { KPARAMS; moe_gather(p, lds + LDS_TAB, layer); }
PHASE_FN ph_moe1(LAS uchar* lds, int layer) { KPARAMS; moe_gemm1(p, lds, layer); }
PHASE_FN ph_moe2(LAS uchar* lds, int layer, const XcdBarrier& gbar, int k) { KPARAMS; moe_gemm2(p, lds, layer, gbar, p.ph_lo <= k - 1 && k < p.ph_hi); }

__global__ void __launch_bounds__(NTHREADS, 2) fwd_kernel(Params p) {
    extern __shared__ __attribute__((aligned(16))) uchar smem[];
    LAS uchar* lds = (LAS uchar*)smem;
    if (threadIdx.x == 0) *(LAS u32x4*)(lds + LDS_XB) = (u32x4){0u, 0u, 0u, 0u};
    __syncthreads();
    XcdBarrier bar; bar.bar = (unsigned*)(p.ws + WS_CTL); bar.x = 0; bar.st = (volatile LAS unsigned*)(lds + LDS_XB);
    const int lo = p.ph_lo, hi = p.ph_hi;
    if (hi - lo > 1) bar = xcd_barrier_post((unsigned*)(p.ws + WS_CTL), (volatile LAS unsigned*)(lds + LDS_XB));
#define PH(k) if (kparams()->ph_lo <= (k) && (k) < kparams()->ph_hi)
#define SEAM(k) do { KParamsPtr kq_ = kparams(); if (kq_->ph_lo <= (k) && (k) + 1 < kq_->ph_hi) xcd_barrier(bar); } while (0)
#ifdef PROBE_BAR
    for (int q = 0; q < 10; ++q) xcd_barrier(bar);
#endif
    PH(0) { ph_prologue(lds);
#ifdef PROBE_PRO2
        ph_prologue(lds);
#endif
    } SEAM(0);
    PH(1) { ph_norm_plain(0);
#ifdef PROBE_NORM
        ph_norm_plain(0);
#endif
    } SEAM(1);
#if EN_MIX0
    PH(2) { ph_win0(lds);
#ifdef PROBE_DENSE
        ph_win0(lds);
#endif
    } SEAM(2);
    PH(3) { ph_l0_local(lds);
#ifdef PROBE_L0LOC
        ph_l0_local(lds);
#endif
    } SEAM(3);
    PH(4) { ph_attn(lds);
#ifdef PROBE_ATTN2
        ph_attn(lds);
#endif
        ph_lru_fix();
#ifdef PROBE_L0LOC
        ph_lru_fix();
#endif
    } SEAM(4);
    PH(5) { ph_wout(lds, 0);
#ifdef PROBE_DENSE
        ph_wout(lds, 0);
#endif
    } SEAM(5);
#else
    SEAM(2); SEAM(3); SEAM(4); PH(5) ph_copy(0); SEAM(5);
#endif
#if EN_MOE
        PH(6) ph_ffn_route(lds, 0); SEAM(6);
        PH(6 + 4) { ph_moe1(lds, 0);
#ifdef PROBE_MOE1
            ph_moe1(lds, 0);
#endif
        }
        PH(6 + 5) { ph_moe2(lds, 0, bar, 6 + 5); } SEAM(6 + 5);
#else
        SEAM(6); SEAM(6 + 1); SEAM(6 + 2); SEAM(6 + 3); SEAM(6 + 4); SEAM(6 + 5);
#endif
#if EN_MOE
            PH(12) { ph_norm_combine();
#ifdef PROBE_NORM
                ph_norm_combine();
#endif
            } SEAM(12);
#else
            PH(12) { ph_copy(2); ph_norm_plain(3); } SEAM(12);
#endif
#if EN_MIX1
            PH(13) { ph_win1(lds);
#ifdef PROBE_DENSE
                ph_win1(lds);
#endif
            } SEAM(13);
            PH(14) {
#ifdef PROBE_HL
                for (int rep = 0; rep < kparams()->ph_hi - kparams()->ph_lo - 23; ++rep)
#endif
                ph_hgrn_local(lds);
            } SEAM(14);
            PH(15) { ph_hgrn_scan();
#ifdef PROBE_HS
                ph_hgrn_scan();
#endif
            } SEAM(15);
            PH(16) {
#ifdef PROBE_HO
                for (int rep = 0; rep < kparams()->ph_hi - kparams()->ph_lo - 23; ++rep)
#endif
                ph_hgrn_out(lds);
            } SEAM(16);
            PH(17) { ph_wout(lds, 1);
#ifdef PROBE_DENSE
                ph_wout(lds, 1);
#endif
            } SEAM(17);
#else
            SEAM(13); SEAM(14); SEAM(15); SEAM(16); PH(17) ph_copy(1); SEAM(17);
#endif
#if EN_MOE
        PH(18) ph_ffn_route(lds, 1); SEAM(18);
        PH(18 + 4) { ph_moe1(lds, 1);
#ifdef PROBE_MOE1
            ph_moe1(lds, 1);
#endif
        }
        PH(18 + 5) { ph_moe2(lds, 1, bar, 18 + 5); } SEAM(18 + 5);
#else
        SEAM(18); SEAM(18 + 1); SEAM(18 + 2); SEAM(18 + 3); SEAM(18 + 4); SEAM(18 + 5);
#endif
    PH(24) { ph_final(EN_MOE);
#ifdef PROBE_NORM
        ph_final(EN_MOE);
#endif
    }
}

extern "C" void kernel_launch(void* const* d_in, const int* in_sizes, int n_in, void* d_out, int out_size, void* d_ws, size_t ws_size, hipStream_t stream) {
    static int grid = 0;
    if (grid == 0) {
        if (n_in != 33 || out_size != T * D || ws_size < WS_END) { fprintf(stderr, "kernel_launch: unexpected problem (n_in %d, out %d, ws %zu < %zu)\n", n_in, out_size, ws_size, (size_t)WS_END); grid = -1; return; }
        int dev = 0, cus = 0, per_cu = 0;
        if (hipGetDevice(&dev) != hipSuccess || hipDeviceGetAttribute(&cus, hipDeviceAttributeMultiprocessorCount, dev) != hipSuccess) { grid = -1; return; }
        if (hipFuncSetAttribute((const void*)fwd_kernel, hipFuncAttributeMaxDynamicSharedMemorySize, LDS_BYTES) != hipSuccess) { fprintf(stderr, "kernel_launch: hipFuncSetAttribute failed\n"); grid = -1; return; }
        if (hipOccupancyMaxActiveBlocksPerMultiprocessor(&per_cu, (const void*)fwd_kernel, NTHREADS, LDS_BYTES) != hipSuccess || per_cu < 1) { fprintf(stderr, "kernel_launch: occupancy query says %d blocks per CU\n", per_cu); grid = -1; (void)hipGetLastError(); return; }
        grid = cus;
    }
    if (grid < 0) return;
    (void)hipMemsetAsync((char*)d_ws + WS_CTL, 0, CTL_BYTES, stream);
    Params p{};
    for (int i = 0; i < 33; ++i) p.in[i] = (const float*)d_in[i];
    p.out = (float*)d_out; p.ws = (uchar*)d_ws;
#if MK_N_LAUNCHES == 1
    p.ph_lo = 0; p.ph_hi = N_PHASES;
    hipLaunchKernelGGL(fwd_kernel, dim3(grid), dim3(NTHREADS), LDS_BYTES, stream, p);
#else
    for (int k = 0; k < N_PHASES; ++k) { p.ph_lo = k; p.ph_hi = k + 1; hipLaunchKernelGGL(fwd_kernel, dim3(grid), dim3(NTHREADS), LDS_BYTES, stream, p); }
#endif
}
```

```cpp
#include <hip/hip_runtime.h>
#include <cstdio>
#include <cstdint>

#define LAS __attribute__((address_space(3)))
typedef unsigned short bf16_t;
typedef short bf16x8 __attribute__((ext_vector_type(8)));
typedef float f32x4 __attribute__((ext_vector_type(4)));
typedef float f32x16 __attribute__((ext_vector_type(16)));
typedef unsigned u32x4 __attribute__((ext_vector_type(4)));
typedef int i32x4 __attribute__((ext_vector_type(4)));
typedef unsigned u32x2 __attribute__((ext_vector_type(2)));
typedef unsigned char uchar;

constexpr int T = 8192, D = 2048;
constexpr int NTHREADS = 512, NWAVES = 8;
constexpr int LDS_BYTES = 147456;
constexpr int EVEN_COLS = 4632;
constexpr int KPAD = 64;
constexpr int TP = T + KPAD;
constexpr int TV = T + 64;
constexpr int MOE_TILE = 256;
constexpr int MOE_ROWS = 32768;
constexpr int LOGIT_LD = 80;

constexpr size_t al256(size_t x) { return (x + 255) & ~(size_t)255; }
constexpr size_t WS_CTL = 0;
constexpr size_t CTL_BYTES = 16384;
constexpr size_t CTL_CNT_OFF = 13824;
constexpr size_t CTL_LRUQ_OFF = 14400;
constexpr size_t WS_MOD = WS_CTL + CTL_BYTES;
constexpr size_t WS_PEBP = WS_MOD + 2 * 12288 * 4;
constexpr size_t WS_WIN0T = WS_PEBP + 16 * 2 * 128 * 4;
constexpr size_t WS_WV0T = WS_WIN0T + (size_t)4352 * 2048 * 2;
constexpr size_t WS_WOUT0T = WS_WV0T + (size_t)512 * 2048 * 2;
constexpr size_t WS_WC1T = WS_WOUT0T + (size_t)2048 * 2048 * 2;
constexpr size_t WS_WC2T = WS_WC1T + (size_t)2 * 128 * 4096 * 2;
constexpr size_t WS_WAT = WS_WC2T + (size_t)2 * 128 * 128 * 2;
constexpr size_t WS_WIT = WS_WAT + (size_t)8 * 128 * 128 * 2;
constexpr size_t WS_WIN1T = WS_WIT + (size_t)8 * 128 * 128 * 2;
constexpr size_t WS_WOUT1T = WS_WIN1T + (size_t)8192 * 2048 * 2;
constexpr size_t WS_ROUTET = WS_WOUT1T + (size_t)2048 * 2048 * 2;
constexpr size_t WS_W1T = WS_ROUTET + (size_t)2 * 256 * 2048 * 2;
constexpr size_t WS_ETOK = WS_W1T + (size_t)1048576;
constexpr size_t WS_SC_TOK = WS_W1T, WS_SC_W0 = WS_SC_TOK + (size_t)T * 4, WS_SC_WV = WS_SC_W0 + 4352 * 4, WS_SC_W1 = WS_SC_WV + 512 * 4;
constexpr size_t WS_W2T = WS_W1T + (size_t)2 * 64 * 1024 * 2048 * 2;
constexpr size_t WS_HMIX = WS_W2T + (size_t)2 * 64 * 2048 * 512 * 2;
constexpr size_t WS_XA = WS_HMIX + (size_t)T * D * 2;
constexpr size_t WS_XB = WS_XA + (size_t)T * D * 4;
constexpr size_t WS_XG = WS_XB + (size_t)T * D * 4;
constexpr size_t WS_HID = WS_XG + (size_t)MOE_ROWS * 2048 * 2;
constexpr size_t WS_YB = WS_HID + (size_t)MOE_ROWS * 512 * 2;
constexpr size_t WS_LOGIT = WS_YB + (size_t)MOE_ROWS * 2048 * 2;
constexpr size_t WS_TOKE = WS_LOGIT + (size_t)8 * T * LOGIT_LD * 4;
constexpr size_t WS_TOKPOS = WS_TOKE + (size_t)T * 2 * 4;
constexpr size_t WS_TOKW = WS_TOKPOS + (size_t)T * 2 * 4;
constexpr size_t WS_TOKROW = WS_TOKW + (size_t)T * 2 * 4;
constexpr size_t WS_TILEE = WS_TOKROW + (size_t)T * 2 * 4;
constexpr size_t WS_PARK = WS_TILEE + 1024;
constexpr size_t WS_U = WS_PARK + (size_t)256 * 64 * 512 * 4;
constexpr size_t U_Q = WS_U;
constexpr size_t U_KB = U_Q + (size_t)T * 1024 * 2;
constexpr size_t U_VT = U_KB + (size_t)4 * 2 * TP * 128 * 2;
constexpr size_t U_Y = U_VT + (size_t)2 * 2 * 128 * TV * 2;
constexpr size_t U_XBR = U_Y + (size_t)T * 1024 * 2;
constexpr size_t U_GATE = U_XBR + (size_t)T * 1024 * 4;
constexpr size_t U_KCMP = U_GATE + (size_t)T * 24 * 4;
constexpr size_t U_VCMPT = U_KCMP + (size_t)2 * 512 * 128 * 2;
constexpr size_t U_HLOC = U_VCMPT + (size_t)2 * 128 * 512 * 2;
constexpr size_t U_PC = U_HLOC + (size_t)T * 1024 * 4;
constexpr size_t U_HEND = U_PC + (size_t)T * 1024 * 4;
constexpr size_t U_PEND = U_HEND + (size_t)128 * 1024 * 4;
constexpr size_t U_CAT = U_PEND + (size_t)128 * 1024 * 4;
constexpr size_t U_END0 = U_CAT + (size_t)T * 2048 * 2;
constexpr size_t V_QS = WS_U;
constexpr size_t V_LOGF = V_QS + (size_t)T * 2048 * 2;
constexpr size_t V_KK = V_LOGF + (size_t)T * 2048 * 4;
constexpr size_t V_V = V_KK + (size_t)T * 2048 * 2;
constexpr size_t V_SB = V_KK;
constexpr size_t V_GS = V_V + (size_t)T * 2048 * 2;
constexpr size_t V_OINTRA = V_GS + (size_t)T * 2048 * 2;
constexpr size_t V_QHAT = V_OINTRA + (size_t)T * 2048 * 4;
constexpr size_t V_ST = V_QHAT + (size_t)T * 2048 * 2;
constexpr size_t V_DEC = V_ST + (size_t)128 * 16 * 128 * 128 * 4;
constexpr size_t V_HGO = V_DEC + (size_t)128 * 16 * 128 * 4;
constexpr size_t U_END1 = V_HGO + (size_t)T * 2048 * 2;
constexpr size_t WS_END = (U_END0 > U_END1 ? U_END0 : U_END1);

struct Params {
    const float* in[33];
    float* out;
    uchar* ws;
    int ph_lo, ph_hi;
};
enum { I_X = 0, I_C, I_RELB, I_ADAW, I_ADAB, I_NMG, I_NFG, I_EWIN, I_EWOUT, I_PE, I_CW1, I_CB1, I_CW2, I_CB2, I_CONVW, I_CONVB, I_LWA, I_LBA, I_LWI, I_LBI,
       I_LAMBDA, I_OWIN, I_OWOUT, I_LBL, I_HNG, I_MWGRP, I_MBGRP, I_MWEXP, I_MBEXP, I_MWG, I_MWU, I_MWD, I_FG };

__device__ __forceinline__ int tid_opaque() { int t = threadIdx.x; asm volatile("" : "+v"(t)); return t; }
typedef __bf16 bf16x2_t __attribute__((ext_vector_type(2)));
typedef float f32x2_t __attribute__((ext_vector_type(2)));
__device__ __forceinline__ unsigned cvt_pk_bf16(float lo, float hi) { const f32x2_t f = {lo, hi}; const bf16x2_t b = __builtin_convertvector(f, bf16x2_t); return __builtin_bit_cast(unsigned, b); }
__device__ __forceinline__ float bf_lo(unsigned u) { return __uint_as_float(u << 16); }
__device__ __forceinline__ float bf_hi(unsigned u) { return __uint_as_float(u & 0xffff0000u); }
__device__ __forceinline__ float bf2f(bf16_t b) { return __uint_as_float(((unsigned)b) << 16); }
__device__ __forceinline__ bf16_t f2bf(float f) { return (bf16_t)(cvt_pk_bf16(f, 0.f) & 0xffffu); }
__device__ __forceinline__ float sigmoidf_(float x) { return __builtin_amdgcn_rcpf(1.0f + __expf(-x)); }
__device__ __forceinline__ float siluf_(float x) { return x * __builtin_amdgcn_rcpf(1.0f + __expf(-x)); }
__device__ __forceinline__ float geluf_(float x) { const float u = 0.7978845608028654f * (x + 0.044715f * x * x * x); const float t = 1.0f - 2.0f * __builtin_amdgcn_rcpf(__expf(2.0f * u) + 1.0f); return 0.5f * x * (1.0f + t); }
__device__ __forceinline__ float wave_sum(float v) {
#pragma unroll
    for (int o = 32; o > 0; o >>= 1) v += __shfl_xor(v, o);
    return v;
}
__device__ __forceinline__ float wave_max(float v) {
#pragma unroll
    for (int o = 32; o > 0; o >>= 1) v = fmaxf(v, __shfl_xor(v, o));
    return v;
}
__device__ __forceinline__ unsigned pack_i8x4(float a, float b, float c, float d) {
    const int ia = (int)rintf(a), ib = (int)rintf(b), ic = (int)rintf(c), id = (int)rintf(d);
    return (unsigned)(ia & 255) | ((unsigned)(ib & 255) << 8) | ((unsigned)(ic & 255) << 16) | ((unsigned)id << 24);
}
__device__ __forceinline__ int t5_bucket(int n) {
    if (n < 16) return n;
    int b = 16;
    b += (n >= 19) + (n >= 21) + (n >= 24) + (n >= 27) + (n >= 31) + (n >= 35) + (n >= 40) + (n >= 46) + (n >= 52) + (n >= 59) + (n >= 67) + (n >= 77) + (n >= 87) + (n >= 99) + (n >= 113);
    return b;
}
#define XB_TMO      128
#define XB_XCNT(j)  (256  + 64 * (j))
#define XB_XSUB(j)  (1280 + 64 * (j))
#define XB_XGEN(j)  (2304 + 64 * (j))
#define XB_TOP      3328
#define XB_TOPGEN   3392
#define XCD_BAR_WORDS 3456
#define XB_SPIN_CAP (1u << 18)
#define LAS __attribute__((address_space(3)))

__device__ __forceinline__ unsigned xb_ld(unsigned* p)              { return __hip_atomic_load(p, __ATOMIC_RELAXED, __HIP_MEMORY_SCOPE_AGENT); }
__device__ __forceinline__ unsigned xb_add(unsigned* p, unsigned v) { return __hip_atomic_fetch_add(p, v, __ATOMIC_RELAXED, __HIP_MEMORY_SCOPE_AGENT); }
__device__ __forceinline__ unsigned xb_xcc_id() { return (unsigned)__builtin_amdgcn_s_getreg((3 << 11) | 20) & 0xFu; }
#define XB_SPIN(cond, bar) do { unsigned _sp = 0; while (cond) { __builtin_amdgcn_s_sleep(1); \
    if ((++_sp & 255u) == 0u) { if (xb_ld(&(bar)[XB_TMO])) break; if (_sp > XB_SPIN_CAP) { atomicAdd(&(bar)[XB_TMO], 1u); break; } } } } while (0)

struct XcdBarrier {
    unsigned* bar; unsigned x;
    volatile LAS unsigned* st;
};

__device__ __forceinline__ XcdBarrier xcd_barrier_post(unsigned* bar, volatile LAS unsigned* st) {
    XcdBarrier b; b.bar = bar; b.x = xb_xcc_id(); b.st = st;
    if (threadIdx.x == 0) (void)xb_add(&bar[XB_XCNT(b.x)], 1u);
    return b;
}
__device__ __forceinline__ void xcd_barrier_complete(unsigned* bar, unsigned x, unsigned& nloc, unsigned& nx) {
    const unsigned G = gridDim.x * gridDim.y * gridDim.z;
    unsigned sum, cnt, mine, sp = 0u;
    for (;;) {
        sum = 0u; cnt = 0u; mine = 0u;
#pragma unroll
        for (unsigned j = 0; j < 16; ++j) { const unsigned c = xb_ld(&bar[XB_XCNT(j)]); sum += c; cnt += (c > 0u) ? 1u : 0u; mine = (j == x) ? c : mine; }
        if (sum == G) break;
        __builtin_amdgcn_s_sleep(1);
        if ((++sp & 255u) == 0u) { if (xb_ld(&bar[XB_TMO])) break; if (sp > XB_SPIN_CAP) { atomicAdd(&bar[XB_TMO], 1u); break; } }
    }
    nloc = mine > 0u ? mine : 1u; nx = cnt > 0u ? cnt : 1u;
}

__device__ __forceinline__ void xcd_barrier(const XcdBarrier& b) {
    asm volatile("s_waitcnt vmcnt(0)" ::: "memory");
    __syncthreads();
    if (threadIdx.x == 0) {
        unsigned* bar = b.bar;
        __builtin_amdgcn_s_waitcnt(0);
        unsigned nloc = b.st[0], nx = b.st[1];
        if (nloc == 0u) { xcd_barrier_complete(bar, b.x, nloc, nx); b.st[0] = nloc; b.st[1] = nx; }
        const unsigned old = xb_add(&bar[XB_XSUB(b.x)], 1u);
        const unsigned gen = old / nloc;
        if (old + 1u == (gen + 1u) * nloc) {
            __builtin_amdgcn_fence(__ATOMIC_RELEASE, "agent");
            asm volatile("s_waitcnt vmcnt(0)" ::: "memory");
            const unsigned og = xb_add(&bar[XB_TOP], 1u);
            const unsigned tg = og / nx;
            if (og + 1u == (tg + 1u) * nx) xb_add(&bar[XB_TOPGEN], 1u);
            else XB_SPIN(xb_ld(&bar[XB_TOPGEN]) == tg, bar);
            __builtin_amdgcn_fence(__ATOMIC_ACQUIRE, "agent");
            xb_add(&bar[XB_XGEN(b.x)], 1u);
            asm volatile("s_waitcnt vmcnt(0)" ::: "memory");
        } else {
            XB_SPIN(xb_ld(&bar[XB_XGEN(b.x)]) == gen, bar);
            __builtin_amdgcn_fence(__ATOMIC_ACQUIRE, "agent");
            asm volatile("s_waitcnt vmcnt(0)" ::: "memory");
        }
    }
    __syncthreads();
}
namespace pg8 {
#define PG8_LAS __attribute__((address_space(3)))
constexpr int BM = 256, BK = 64, HALF = 128, HTB = HALF * BK * 2  , STAGE_BYTES = 8 * HTB, NXCD = 8, WGM = 8;
__host__ __device__ __forceinline__ int lds_byte(int r, int c) { const int st = (r >> 4) * 2 + (c >> 5), rr = r & 15, cc = c & 31, ob = rr * 64 + cc * 2; return st * 1024 + (ob ^ (((ob >> 9) & 1) << 5)); }
__host__ __device__ __forceinline__ void stage_rc(int b, int& R, int& C) { const int st = b / 1024, sb = b % 1024, swz = sb ^ (((sb >> 9) & 1) << 5); R = (st >> 1) * 16 + swz / 64; C = (st & 1) * 32 + (swz % 64) / 2; }
__host__ __device__ __forceinline__ int perm32(int rho) { const int n = rho >> 4, i = rho & 15; return 8 * (i >> 2) + 4 * n + (i & 3); }
struct Unit { int pm, pn; const char* a; const char* b; int aux; };
__host__ __device__ __forceinline__ void static_tile(int L, int nM, int nN, int& pm, int& pn) {
    const int nwg = nM * nN; int wgid = L; { const int q = nwg / NXCD, r = nwg % NXCD, xcd = wgid % NXCD, off = wgid / NXCD; wgid = (xcd < r ? xcd * (q + 1) : r * (q + 1) + (xcd - r) * q) + off; }
    const int nig = WGM * nN, gid = wgid / nig, fm = gid * WGM, gsz = (nM - fm) < WGM ? (nM - fm) : WGM;
    pm = fm + ((wgid % nig) % gsz); pn = (wgid % nig) / gsz;
}

template <class Epi, class Sched, bool STAMP = false>
__device__ __forceinline__ void gemm_phase(PG8_LAS unsigned char* lds, const int Kdim, const Sched& S, const Epi& E, unsigned long long* stamps, const int Kloop = 0) {
    const int tid = tid_opaque(), wid = __builtin_amdgcn_readfirstlane(tid >> 6), lane = tid & 63, wr = wid >> 2, wc = wid & 3, fr = lane & 15, fq = lane >> 4;
    const int K = Kdim, nt = (Kloop ? Kloop : K) / BK;
    int ts_lo = 0, ts_hi = 0, nts = 0; const unsigned long long rt_entry = STAMP ? (unsigned long long)wall_clock64() : 0ull;
#define PG8_STAMP() do { if (STAMP && wid == 0 && nts < 64) { const unsigned long long _c = (unsigned long long)clock64(); \
        ts_lo = (lane == nts) ? (int)(unsigned)_c : ts_lo; ts_hi = (lane == nts) ? (int)(unsigned)(_c >> 32) : ts_hi; ++nts; } } while (0)
    PG8_STAMP();
    unsigned voffA[2], voffB[2];
#pragma unroll
    for (int i = 0; i < 2; ++i) { int R, C; stage_rc(tid * 16 + i * 8192, R, C); const int Rb = Epi::PERM ? ((R & ~31) + perm32(R & 31)) : R;
        voffA[i] = (unsigned)(R * K + C) * 2u; voffB[i] = (unsigned)(Rb * K + C) * 2u; }
    const size_t kstep = (size_t)(BK * 2);
    const size_t hstep = (size_t)HALF * K * 2;
        const unsigned ldsw = (unsigned)wid * 1024u;
    const int aoff = lds_byte(wr * 64 + fr, fq * 8), boff = lds_byte(wc * 32 + fr, fq * 8);
#define PG8_SA(b, h) (((b) * 2 + (h)) * HTB)
#define PG8_SB(b, h) ((4 + (b) * 2 + (h)) * HTB)
#define PG8_STAGE(bufoff, gbase, voff) do { _Pragma("unroll") for (int _i = 0; _i < 2; ++_i) \
        __builtin_amdgcn_global_load_lds((const unsigned*)((const char*)(gbase) + (voff)[_i]), (PG8_LAS unsigned*)(lds + (bufoff) + ldsw + _i * 8192), 16, 0, 0); } while (0)
#define PG8_LDA(dst, b, h) do { _Pragma("unroll") for (int m = 0; m < 4; ++m) _Pragma("unroll") for (int k = 0; k < 2; ++k) dst[m][k] = *(const PG8_LAS bf16x8*)(lds + PG8_SA(b, h) + aoff + m * 2048 + k * 1024); } while (0)
#define PG8_LDB(dst, b, h) do { _Pragma("unroll") for (int n = 0; n < 2; ++n) _Pragma("unroll") for (int k = 0; k < 2; ++k) dst[n][k] = *(const PG8_LAS bf16x8*)(lds + PG8_SB(b, h) + boff + n * 2048 + k * 1024); } while (0)
#define PG8_MMA(ai, bj, At, Bt) do { __builtin_amdgcn_s_setprio(1); _Pragma("unroll") for (int m = 0; m < 4; ++m) _Pragma("unroll") for (int n = 0; n < 2; ++n) _Pragma("unroll") for (int k = 0; k < 2; ++k) \
        { if constexpr (Epi::I8) acc[ai][bj][m][n] = __builtin_bit_cast(acc_t, __builtin_amdgcn_mfma_i32_16x16x64_i8(__builtin_bit_cast(i32x4, Bt[n][k]), __builtin_bit_cast(i32x4, At[m][k]), __builtin_bit_cast(i32x4, acc[ai][bj][m][n]), 0, 0, 0)); \
          else acc[ai][bj][m][n] = __builtin_bit_cast(acc_t, __builtin_amdgcn_mfma_f32_16x16x32_bf16(Bt[n][k], At[m][k], __builtin_bit_cast(f32x4, acc[ai][bj][m][n]), 0, 0, 0)); } __builtin_amdgcn_s_setprio(0); } while (0)
#define PG8_WAIT_V(n) asm volatile("s_waitcnt vmcnt(" #n ")" ::: "memory")
#define PG8_WAIT_L(n) asm volatile("s_waitcnt lgkmcnt(" #n ")" ::: "memory")
#define PG8_BAR __builtin_amdgcn_s_barrier()
#define PG8_SCHED __builtin_amdgcn_sched_barrier(0)
    Unit cur, nxt; int ui = 0;
    if (!S.next(0, cur)) return;
    typedef f32x4 acc_t;
    acc_t acc[2][2][4][2];
#pragma unroll
    for (int a = 0; a < 2; ++a)
#pragma unroll
        for (int b = 0; b < 2; ++b)
#pragma unroll
            for (int m = 0; m < 4; ++m)
#pragma unroll
                for (int n = 0; n < 2; ++n) acc[a][b][m][n] = (acc_t){0, 0, 0, 0};
    bf16x8 At[4][2], B0[2][2], B1[2][2];
    const char* cA = cur.a; const char* cB = cur.b;
    S.a_ready(cur);
    PG8_STAGE(PG8_SB(0, 0), cB, voffB); PG8_STAGE(PG8_SA(0, 0), cA, voffA); PG8_STAGE(PG8_SB(0, 1), cB + hstep, voffB); PG8_STAGE(PG8_SA(0, 1), cA + hstep, voffA);
    if (wr == 1) PG8_BAR;
    PG8_WAIT_V(4); PG8_BAR;
    PG8_STAGE(PG8_SB(1, 0), cB + kstep, voffB); PG8_STAGE(PG8_SA(1, 0), cA + kstep, voffA); PG8_STAGE(PG8_SB(1, 1), cB + hstep + kstep, voffB);
    PG8_WAIT_V(6); PG8_BAR;
    PG8_STAMP();
    for (;;) {
        const bool has_next = S.next(ui + 1, nxt);
        const char* nA = has_next ? nxt.a : cA; const char* nB = has_next ? nxt.b : cB;
        for (int t = 0; t < nt; t += 2) {
            const bool last = (t == nt - 2);
            const char* a1 = cA + (size_t)(t + 1) * kstep;
            const char* a2 = last ? nA : cA + (size_t)(t + 2) * kstep; const char* b2 = last ? nB : cB + (size_t)(t + 2) * kstep;
            const char* a3 = a2 + kstep; const char* b3 = b2 + kstep;
            if (last && has_next) S.a_ready(nxt);
            PG8_LDB(B0, 0, 0); PG8_SCHED; PG8_LDA(At, 0, 0); PG8_STAGE(PG8_SA(1, 1), a1 + hstep, voffA);
            PG8_WAIT_L(8); PG8_BAR; PG8_WAIT_L(0); PG8_MMA(0, 0, At, B0); PG8_BAR; PG8_SCHED;
            PG8_LDB(B1, 0, 1); PG8_STAGE(PG8_SB(0, 0), b2, voffB);
            PG8_BAR; PG8_WAIT_L(0); PG8_MMA(0, 1, At, B1); PG8_BAR;
            PG8_LDA(At, 0, 1); PG8_STAGE(PG8_SA(0, 0), a2, voffA);
            PG8_BAR; PG8_WAIT_L(0); PG8_MMA(1, 0, At, B0); PG8_BAR; PG8_SCHED;
            PG8_STAGE(PG8_SB(0, 1), b2 + hstep, voffB);
            PG8_WAIT_V(6); PG8_BAR; PG8_MMA(1, 1, At, B1); PG8_BAR;
            PG8_LDB(B0, 1, 0); PG8_SCHED; PG8_LDA(At, 1, 0); PG8_STAGE(PG8_SA(0, 1), a2 + hstep, voffA);
            PG8_WAIT_L(8); PG8_BAR; PG8_WAIT_L(0); PG8_MMA(0, 0, At, B0); PG8_BAR; PG8_SCHED;
            PG8_LDB(B1, 1, 1); PG8_STAGE(PG8_SB(1, 0), b3, voffB);
            PG8_BAR; PG8_WAIT_L(0); PG8_MMA(0, 1, At, B1); PG8_BAR;
            PG8_LDA(At, 1, 1); PG8_STAGE(PG8_SA(1, 0), a3, voffA);
            PG8_BAR; PG8_WAIT_L(0); PG8_MMA(1, 0, At, B0); PG8_BAR; PG8_SCHED;
            PG8_STAGE(PG8_SB(1, 1), b3 + hstep, voffB);
            PG8_WAIT_V(6); PG8_BAR; PG8_MMA(1, 1, At, B1); PG8_BAR;
        }
        PG8_STAMP();
        if constexpr (Epi::I8) {
            static_assert(!Epi::AFTER_DRAIN, "int8 units use the in-loop epilogue");
            const float* rs; const float* cs; E.scales(cur, rs, cs);
            const int lr0 = cur.pm * 256 + wr * 64 + fr, lc0 = cur.pn * 256 + wc * 32 + 4 * fq;
            f32x4 csv[2][2];
#pragma unroll
            for (int b = 0; b < 2; ++b)
#pragma unroll
                for (int n = 0; n < 2; ++n) csv[b][n] = *(const f32x4*)(cs + lc0 + b * 128 + n * 16);
#pragma unroll
            for (int a = 0; a < 2; ++a)
#pragma unroll
                for (int m = 0; m < 4; ++m) { const float r = rs[lr0 + a * 128 + m * 16];
#pragma unroll
                    for (int b = 0; b < 2; ++b)
#pragma unroll
                        for (int n = 0; n < 2; ++n) { const i32x4 v = __builtin_bit_cast(i32x4, acc[a][b][m][n]); const f32x4 c = csv[b][n] * r;
                            acc[a][b][m][n] = (f32x4){(float)v[0] * c[0], (float)v[1] * c[1], (float)v[2] * c[2], (float)v[3] * c[3]}; } }
            E(acc, cur, wr, wc, fr, fq); S.done(cur);
        } else if constexpr (!Epi::AFTER_DRAIN) { E(acc, cur, wr, wc, fr, fq); S.done(cur); }
        PG8_STAMP();
        if (!has_next) break;
#pragma unroll
        for (int a = 0; a < 2; ++a)
#pragma unroll
            for (int b = 0; b < 2; ++b)
#pragma unroll
                for (int m = 0; m < 4; ++m)
#pragma unroll
                    for (int n = 0; n < 2; ++n) acc[a][b][m][n] = (acc_t){0, 0, 0, 0};
        cur = nxt; cA = nA; cB = nB; ++ui;
    }
    PG8_WAIT_V(0);
    if (wr == 0) PG8_BAR;
    PG8_BAR;
    if constexpr (Epi::AFTER_DRAIN && !Epi::I8) { E.fused(acc, cur, wr, wc, fr, fq, lds, wid, lane); S.done(cur); }
    PG8_STAMP();
    if (STAMP && wid == 0) { stamps[lane] = lane < nts ? (((unsigned long long)(unsigned)ts_hi << 32) | (unsigned)ts_lo) : 0ull;
        if (lane == 62) stamps[62] = rt_entry; if (lane == 63) stamps[63] = (unsigned long long)wall_clock64(); }
#undef PG8_STAMP
#undef PG8_SA
#undef PG8_SB
#undef PG8_STAGE
#undef PG8_LDA
#undef PG8_LDB
#undef PG8_MMA
#undef PG8_WAIT_V
#undef PG8_WAIT_L
#undef PG8_BAR
#undef PG8_SCHED
}
}
struct ConvJob { const float* src; int ld, K, c0, nc, cb, rb; bf16_t* dst; int r0; };

__device__ __forceinline__ void conv_load(f32x4 (&v)[16], const ConvJob& j, int kt, int ct, int lane) {
    const int k0 = kt * 64, cbase = ct * 64;
    const int ncv = (j.nc - cbase) < 64 ? (j.nc - cbase) : 64;
    const float* s = j.src + (size_t)k0 * j.ld + j.c0 + cbase;
#pragma unroll
    for (int i = 0; i < 16; ++i) {
        const int id = lane + 64 * i, row = id >> 4, c4 = (id & 15) * 4;
        v[i] = (c4 < ncv) ? *(const f32x4*)(s + (size_t)row * j.ld + c4) : (f32x4){0.f, 0.f, 0.f, 0.f};
    }
}
__device__ __forceinline__ void conv_store(const f32x4 (&v)[16], const ConvJob& j, int kt, int ct, LAS float* tl, int lane) {
    const int k0 = kt * 64, cbase = ct * 64;
    const int ncv = (j.nc - cbase) < 64 ? (j.nc - cbase) : 64;
#pragma unroll
    for (int i = 0; i < 16; ++i) {
        const int id = lane + 64 * i, row = id >> 4, c4 = (id & 15) * 4;
        tl[row * 65 + c4 + 0] = v[i][0]; tl[row * 65 + c4 + 1] = v[i][1]; tl[row * 65 + c4 + 2] = v[i][2]; tl[row * 65 + c4 + 3] = v[i][3];
    }
#pragma unroll
    for (int i = 0; i < 8; ++i) {
        const int id = lane + 64 * i, cc = id >> 3, kc = id & 7;
        if (cc < ncv) {
            const int c = cbase + cc, drow = j.r0 + (c / j.cb) * j.rb + (c % j.cb);
            float f[8];
#pragma unroll
            for (int q = 0; q < 8; ++q) f[q] = tl[(8 * kc + q) * 65 + cc];
            u32x4 o; o[0] = cvt_pk_bf16(f[0], f[1]); o[1] = cvt_pk_bf16(f[2], f[3]); o[2] = cvt_pk_bf16(f[4], f[5]); o[3] = cvt_pk_bf16(f[6], f[7]);
            *(u32x4*)(j.dst + (size_t)drow * j.K + k0 + 8 * kc) = o;
        }
    }
}
__device__ __forceinline__ bool conv_locate(int t, const Params& p, ConvJob& j, int& kt, int& ct);

__device__ __forceinline__ bool small_job(int idx, const Params& p, ConvJob& o) {
    uchar* ws = p.ws;
    o.rb = 0; o.r0 = 0;
    if (idx < 10) {
        o.src = p.in[I_EWIN]; o.ld = EVEN_COLS; o.K = 2048; o.nc = 256;
        switch (idx) {
            case 0: o.c0 = 0; o.nc = 1024; o.r0 = 0; break;
            case 1: o.c0 = 1024; o.r0 = 1024; break;
            case 2: o.c0 = 1280; o.r0 = 1280; break;
            case 3: o.c0 = 1536; o.r0 = 1536; break;
            case 4: o.c0 = 2048; o.r0 = 1792; break;
            case 5: o.c0 = 2584; o.nc = 1024; o.r0 = 2048; break;
            case 6: o.c0 = 3608; o.nc = 1024; o.r0 = 3072; break;
            case 7: o.c0 = 2560; o.nc = 24; o.r0 = 4096; break;
            case 8: o.c0 = 1792; o.r0 = 0; break;
            default: o.c0 = 2304; o.r0 = 256; break;
        }
        o.cb = o.nc;
        o.dst = (bf16_t*)(ws + (idx < 8 ? WS_WIN0T : WS_WV0T));
        return true;
    }
    o.c0 = 0;
    if (idx == 10) { o.src = p.in[I_EWOUT]; o.ld = 2048; o.K = 2048; o.nc = 2048; o.cb = 2048; o.dst = (bf16_t*)(ws + WS_WOUT0T); return true; }
    if (idx < 13) { const int k = idx - 11; o.src = p.in[I_CW1] + (size_t)k * 4096 * 128; o.ld = 128; o.K = 4096; o.nc = 128; o.cb = 128; o.dst = (bf16_t*)(ws + WS_WC1T) + (size_t)k * 128 * 4096; return true; }
    if (idx < 15) { const int k = idx - 13; o.src = p.in[I_CW2] + (size_t)k * 128 * 128; o.ld = 128; o.K = 128; o.nc = 128; o.cb = 128; o.dst = (bf16_t*)(ws + WS_WC2T) + (size_t)k * 128 * 128; return true; }
    if (idx < 23) { const int k = idx - 15; o.src = p.in[I_LWA] + (size_t)k * 128 * 128; o.ld = 128; o.K = 128; o.nc = 128; o.cb = 128; o.dst = (bf16_t*)(ws + WS_WAT) + (size_t)k * 128 * 128; return true; }
    if (idx < 31) { const int k = idx - 23; o.src = p.in[I_LWI] + (size_t)k * 128 * 128; o.ld = 128; o.K = 128; o.nc = 128; o.cb = 128; o.dst = (bf16_t*)(ws + WS_WIT) + (size_t)k * 128 * 128; return true; }
    if (idx == 31) { o.src = p.in[I_OWIN]; o.ld = 8192; o.K = 2048; o.nc = 8192; o.cb = 8192; o.dst = (bf16_t*)(ws + WS_WIN1T); return true; }
    if (idx == 32) { o.src = p.in[I_OWOUT]; o.ld = 2048; o.K = 2048; o.nc = 2048; o.cb = 2048; o.dst = (bf16_t*)(ws + WS_WOUT1T); return true; }
    if (idx < 35) { const int l = idx - 33; o.src = p.in[I_MWGRP] + (size_t)l * 2048 * 8; o.ld = 8; o.K = 2048; o.nc = 8; o.cb = 8; o.dst = (bf16_t*)(ws + WS_ROUTET) + (size_t)l * 256 * 2048; return true; }
    if (idx < 37) { const int l = idx - 35; o.src = p.in[I_MWEXP] + (size_t)l * 2048 * 64; o.ld = 64; o.K = 2048; o.nc = 64; o.cb = 64; o.r0 = 8; o.dst = (bf16_t*)(ws + WS_ROUTET) + (size_t)l * 256 * 2048; return true; }
    return false;
}
constexpr int N_SMALL_JOBS = 37;
__device__ __forceinline__ bool conv_locate(int t, const Params& p, ConvJob& j, int& kt, int& ct) {
    for (int jx = 10; jx < N_SMALL_JOBS; ++jx) {
        if (jx == 31) continue;
        small_job(jx, p, j);
        const int tk = j.K >> 6, tc = (j.nc + 63) >> 6, nt = tk * tc;
        if (t < nt) { kt = t % tk; ct = t / tk; return true; }
        t -= nt;
    }
    return false;
}

constexpr int N_CONV8_UNITS = 73 + 128;
__device__ __forceinline__ void conv8_locate(int u, const Params& p, ConvJob& j, int& ct, uchar*& dst8, float*& scl) {
    uchar* ws = p.ws;
    if (u >= 73) { small_job(31, p, j); ct = u - 73; dst8 = ws + WS_WIN1T; scl = (float*)(ws + WS_SC_W1); return; }
    int idx = 0;
    for (; idx < 10; ++idx) { small_job(idx, p, j); const int tc = (j.nc + 63) >> 6; if (u < tc) break; u -= tc; }
    ct = u; dst8 = ws + (idx < 8 ? WS_WIN0T : WS_WV0T); scl = (float*)(ws + (idx < 8 ? WS_SC_W0 : WS_SC_WV));
}
__device__ __forceinline__ void conv8_load(f32x4 (&v)[16], const ConvJob& j, int kt, int ct, int lane) {
    const float* s = j.src + (size_t)(kt * 64 + (lane >> 4)) * j.ld + j.c0 + ct * 64 + (lane & 15) * 4;
#pragma unroll
    for (int i = 0; i < 16; ++i) v[i] = *(const f32x4*)(s + (size_t)(4 * i) * j.ld);
}
__device__ __forceinline__ void conv8_max(f32x4& mx, const f32x4 (&v)[16]) {
#pragma unroll
    for (int i = 0; i < 16; ++i)
#pragma unroll
        for (int q = 0; q < 4; ++q) mx[q] = fmaxf(mx[q], fabsf(v[i][q]));
}
__device__ __forceinline__ void conv8_store(const f32x4 (&v)[16], const ConvJob& j, int kt, int cbase, int ncv, uchar* dst8, LAS float* tl, const LAS float* qinv, int lane) {
#pragma unroll
    for (int i = 0; i < 16; ++i) {
        const int id = lane + 64 * i, row = id >> 4, c4 = (id & 15) * 4;
        tl[row * 65 + c4 + 0] = v[i][0]; tl[row * 65 + c4 + 1] = v[i][1]; tl[row * 65 + c4 + 2] = v[i][2]; tl[row * 65 + c4 + 3] = v[i][3];
    }
#pragma unroll
    for (int i = 0; i < 4; ++i) {
        const int id = lane + 64 * i, cc = id >> 2, kc = id & 3;
        if (cc < ncv) {
            const int c = cbase + cc, drow = j.r0 + (c / j.cb) * j.rb + (c % j.cb);
            const float qi = qinv[cc];
            u32x4 o;
#pragma unroll
            for (int q = 0; q < 4; ++q) o[q] = pack_i8x4(tl[(16 * kc + 4 * q + 0) * 65 + cc] * qi, tl[(16 * kc + 4 * q + 1) * 65 + cc] * qi, tl[(16 * kc + 4 * q + 2) * 65 + cc] * qi, tl[(16 * kc + 4 * q + 3) * 65 + cc] * qi);
            *(u32x4*)(dst8 + (size_t)drow * 2048 + kt * 64 + 16 * kc) = o;
        }
    }
}
__device__ __forceinline__ void conv8_unit(const Params& p, LAS uchar* lds, int u, int tid) {
    const int lane = tid & 63, wave = tid >> 6;
    ConvJob j; int ct; uchar* dst8; float* scl;
    conv8_locate(u, p, j, ct, dst8, scl);
    LAS float* tl = (LAS float*)(lds + wave * 16640); LAS float* red = (LAS float*)(lds + 8 * 16640);
    const int cbase = ct * 64, ncv = (j.nc - cbase) < 64 ? (j.nc - cbase) : 64, kt0 = wave * 4;
    f32x4 va[16], vb[16];
    f32x4 mx = {0.f, 0.f, 0.f, 0.f};
    conv8_load(va, j, kt0, ct, lane);
#pragma unroll 1
    for (int tt = 0; tt < 4; tt += 2) {
        conv8_load(vb, j, kt0 + tt + 1, ct, lane);
        conv8_max(mx, va);
        conv8_load(va, j, kt0 + ((tt + 2) & 3), ct, lane);
        conv8_max(mx, vb);
    }
#pragma unroll
    for (int q = 0; q < 4; ++q) { mx[q] = fmaxf(mx[q], __shfl_xor(mx[q], 16)); mx[q] = fmaxf(mx[q], __shfl_xor(mx[q], 32)); }
    if (lane < 16) { red[wave * 64 + lane * 4 + 0] = mx[0]; red[wave * 64 + lane * 4 + 1] = mx[1]; red[wave * 64 + lane * 4 + 2] = mx[2]; red[wave * 64 + lane * 4 + 3] = mx[3]; }
    __syncthreads();
    float m = 0.f;
#pragma unroll
    for (int w = 0; w < 8; ++w) m = fmaxf(m, red[w * 64 + lane]);
    __syncthreads();
    if (wave == 0) { red[lane] = m > 0.f ? 127.0f / m : 0.f; if (lane < ncv) { const int c = cbase + lane; scl[j.r0 + (c / j.cb) * j.rb + (c % j.cb)] = m * (1.0f / 127.0f); } }
    __syncthreads();
#pragma unroll 1
    for (int tt = 0; tt < 4; tt += 2) {
        conv8_load(vb, j, kt0 + tt + 1, ct, lane);
        conv8_store(va, j, kt0 + tt, cbase, ncv, dst8, tl, red, lane);
        if (tt == 0) conv8_load(va, j, kt0 + 2, ct, lane);
        conv8_store(vb, j, kt0 + tt + 1, cbase, ncv, dst8, tl, red, lane);
    }
    __syncthreads();
}

__device__ __forceinline__ void phase_prologue(const Params& p, LAS uchar* lds) {
    const int tid = tid_opaque(), lane = tid & 63, wave = tid >> 6;
    const int gw = blockIdx.x * NWAVES + wave, nw = gridDim.x * NWAVES;
    uchar* ws = p.ws;
    {
        LAS float* cact = (LAS float*)lds; LAS float* red = (LAS float*)(lds + 8192);
        for (int i = tid; i < D; i += NTHREADS) cact[i] = siluf_(p.in[I_C][i]);
        __syncthreads();
        float* mod = (float*)(ws + WS_MOD);
        const int col = lane & 31, kh = lane >> 5;
        for (int u = blockIdx.x; u < 768; u += gridDim.x) {
            const int l = u / 384, c0 = (u % 384) * 32;
            const float* w = p.in[I_ADAW] + (size_t)l * 2048 * 12288 + c0 + col + (size_t)(wave * 256 + kh) * 12288;
            float acc = 0.f;
#pragma unroll 32
            for (int kk = 0; kk < 128; ++kk) acc += cact[wave * 256 + 2 * kk + kh] * w[(size_t)kk * 2 * 12288];
            acc += __shfl_xor(acc, 32);
            if (kh == 0) red[wave * 32 + col] = acc;
            __syncthreads();
            if (tid < 32) { float s = p.in[I_ADAB][l * 12288 + c0 + tid];
#pragma unroll
                for (int q = 0; q < 8; ++q) s += red[q * 32 + tid];
                mod[l * 12288 + c0 + tid] = s; }
            __syncthreads();
        }
    }
    {
        LAS float* red = (LAS float*)(lds + 8192);
        for (int u = blockIdx.x; u < 64; u += gridDim.x) {
            const int kind = u >> 5, half = (u >> 4) & 1, ks = u & 15, col = half * 64 + lane;
            const float* pe = p.in[I_PE] + (size_t)kind * 4096 + ks * 256 + wave * 32;
            const float* w = p.in[I_CW1] + ((size_t)kind * 4096 + ks * 256 + wave * 32) * 128 + col;
            float acc = 0.f;
#pragma unroll
            for (int k = 0; k < 32; ++k) acc += pe[k] * w[(size_t)k * 128];
            red[wave * 64 + lane] = acc;
            __syncthreads();
            if (wave == 0) { float s_ = 0.f;
#pragma unroll
                for (int q = 0; q < 8; ++q) s_ += red[q * 64 + lane];
                ((float*)(ws + WS_PEBP))[(ks * 2 + kind) * 128 + col] = s_; }
            __syncthreads();
        }
    }
    __syncthreads();
    for (int u = blockIdx.x; u < N_CONV8_UNITS; u += gridDim.x) conv8_unit(p, lds, u, tid_opaque());
    {
        const int tid = tid_opaque(), lane = tid & 63, wave = tid >> 6, nw = gridDim.x * NWAVES;
        LAS float* tl = (LAS float*)(lds + wave * 16640);
        f32x4 va[16], vb[16];
        ConvJob ja, jb; int kta = 0, cta = 0, ktb = 0, ctb = 0;
        const int G_ = gridDim.x, nfree = G_ > N_CONV8_UNITS ? G_ - N_CONV8_UNITS : 0;
        const int vblk = nfree ? ((int)blockIdx.x >= N_CONV8_UNITS ? (int)blockIdx.x - N_CONV8_UNITS : (int)blockIdx.x + nfree) : (int)blockIdx.x;
        int t = vblk * NWAVES + wave;
        bool ha = conv_locate(t, p, ja, kta, cta);
        if (ha) conv_load(va, ja, kta, cta, lane);
        while (ha) {
            const bool hb = conv_locate(t + nw, p, jb, ktb, ctb);
            if (hb) conv_load(vb, jb, ktb, ctb, lane);
            conv_store(va, ja, kta, cta, tl, lane);
            if (!hb) break;
            t += 2 * nw;
            ha = conv_locate(t, p, ja, kta, cta);
            if (ha) conv_load(va, ja, kta, cta, lane);
            conv_store(vb, jb, ktb, ctb, tl, lane);
        }
    }
    __syncthreads();
}

template <bool COMBINE, bool FINAL, bool Q8 = false, bool XBF = false>
__device__ __forceinline__ void phase_norm(const void* xin_, const float* gain, const float* sh, const float* sc, bf16_t* out_bf, float* out_f32,
                                           const bf16_t* yb, const int* tokrow, const float* tokw, const float* g2, bf16_t* xout, uchar* out8 = nullptr, float* rowscale = nullptr) {
    const float* xin = (const float*)xin_; const bf16_t* xinb = (const bf16_t*)xin_;
    const int tid = tid_opaque(), lane = tid & 63, wave = tid >> 6;
    for (int r = blockIdx.x * NWAVES + wave; r < T; r += gridDim.x * NWAVES) {
        f32x4 v[8];
#pragma unroll
        for (int i = 0; i < 8; ++i) {
            if constexpr (XBF) { const u32x2 w = *(const u32x2*)(xinb + (size_t)r * D + (i * 64 + lane) * 4); v[i] = (f32x4){bf_lo(w[0]), bf_hi(w[0]), bf_lo(w[1]), bf_hi(w[1])}; }
            else v[i] = *(const f32x4*)(xin + (size_t)r * D + (i * 64 + lane) * 4);
        }
        if (COMBINE) {
            const int r0 = tokrow[2 * r], r1 = tokrow[2 * r + 1]; const float w0 = tokw[2 * r], w1 = tokw[2 * r + 1];
#pragma unroll
            for (int i = 0; i < 8; ++i) {
                const int c = (i * 64 + lane) * 4;
                const u32x2 a = *(const u32x2*)(yb + (size_t)r0 * D + c), b = *(const u32x2*)(yb + (size_t)r1 * D + c);
                const f32x4 g = *(const f32x4*)(g2 + c);
                v[i][0] += g[0] * (w0 * bf_lo(a[0]) + w1 * bf_lo(b[0])); v[i][1] += g[1] * (w0 * bf_hi(a[0]) + w1 * bf_hi(b[0]));
                v[i][2] += g[2] * (w0 * bf_lo(a[1]) + w1 * bf_lo(b[1])); v[i][3] += g[3] * (w0 * bf_hi(a[1]) + w1 * bf_hi(b[1]));
                if (xout) { u32x2 w; w[0] = cvt_pk_bf16(v[i][0], v[i][1]); w[1] = cvt_pk_bf16(v[i][2], v[i][3]); *(u32x2*)(xout + (size_t)r * D + c) = w; }
            }
        }
        float ss = 0.f;
#pragma unroll
        for (int i = 0; i < 8; ++i) ss += v[i][0] * v[i][0] + v[i][1] * v[i][1] + v[i][2] * v[i][2] + v[i][3] * v[i][3];
        ss = wave_sum(ss);
        const float inv = rsqrtf(ss * (1.0f / D) + 1e-6f);
        if constexpr (Q8) {
            float mx = 0.f;
#pragma unroll
            for (int i = 0; i < 8; ++i) {
                const int c = (i * 64 + lane) * 4;
                const f32x4 g = *(const f32x4*)(gain + c), s1 = *(const f32x4*)(sc + c), s0 = *(const f32x4*)(sh + c);
#pragma unroll
                for (int q = 0; q < 4; ++q) { v[i][q] = v[i][q] * inv * g[q] * (1.0f + s1[q]) + s0[q]; mx = fmaxf(mx, fabsf(v[i][q])); }
            }
            mx = wave_max(mx);
            const float qs = mx > 0.f ? 127.0f / mx : 0.f;
            if (lane == 0) rowscale[r] = mx * (1.0f / 127.0f);
#pragma unroll
            for (int i = 0; i < 8; ++i) *(unsigned*)(out8 + (size_t)r * D + (i * 64 + lane) * 4) = pack_i8x4(v[i][0] * qs, v[i][1] * qs, v[i][2] * qs, v[i][3] * qs);
            continue;
        }
#pragma unroll
        for (int i = 0; i < 8; ++i) {
            const int c = (i * 64 + lane) * 4;
            const f32x4 g = *(const f32x4*)(gain + c);
            f32x4 y; y[0] = v[i][0] * inv * g[0]; y[1] = v[i][1] * inv * g[1]; y[2] = v[i][2] * inv * g[2]; y[3] = v[i][3] * inv * g[3];
            if (FINAL) { *(f32x4*)(out_f32 + (size_t)r * D + c) = y; }
            else {
                const f32x4 s1 = *(const f32x4*)(sc + c), s0 = *(const f32x4*)(sh + c);
                u32x2 o; o[0] = cvt_pk_bf16(y[0] * (1.0f + s1[0]) + s0[0], y[1] * (1.0f + s1[1]) + s0[1]); o[1] = cvt_pk_bf16(y[2] * (1.0f + s1[2]) + s0[2], y[3] * (1.0f + s1[3]) + s0[3]);
                *(u32x2*)(out_bf + (size_t)r * D + c) = o;
            }
        }
    }
}
struct SchedNoHooks {
    __device__ __forceinline__ void a_ready(const pg8::Unit&) const {}
    __device__ __forceinline__ void done(const pg8::Unit&) const {}
};
struct SchedDense2 : SchedNoHooks {
    const char* A1; const char* B1; const char* A2; const char* B2; int nM1, nN1, nM2, nN2, G, c; size_t tstep; int aux1 = 0, aux2 = 1; bool mix32 = false;
    __device__ __forceinline__ bool next(int i, pg8::Unit& u) const {
        int L = i * G + c; const int n1 = nM1 * nN1, n2 = nM2 * nN2;
        if (L >= n1 + n2) return false;
        if (L < n1) { pg8::static_tile(L, nM1, nN1, u.pm, u.pn); if (mix32) u.pn = ((u.pn >> 2) & 3) * 8 + (u.pn & 3) + 4 * (u.pn >> 4); u.a = A1 + (size_t)u.pm * tstep; u.b = B1 + (size_t)u.pn * tstep; u.aux = aux1; }
        else { L -= n1; pg8::static_tile(L, nM2, nN2, u.pm, u.pn); u.a = A2 + (size_t)u.pm * tstep; u.b = B2 + (size_t)u.pn * tstep; u.aux = aux2; }
        return true;
    }
};
struct SchedSplitK : SchedNoHooks {
    const char* A; const char* B; int G, c; size_t tstep;
    __device__ __forceinline__ bool next(int i, pg8::Unit& u) const {
        const int L = i * G + c;
        if (L >= 256) return false;
        u.pm = L >> 3; u.pn = 0; u.aux = L & 7; u.a = A + (size_t)u.pm * tstep + (size_t)u.aux * 512; u.b = B + (size_t)u.aux * 512;
        return true;
    }
};
struct SchedMoe : SchedNoHooks {
    const char* A; const char* B; const LAS int* tile_e; int ntiles, npn, G, c; size_t tstep, estride;
    __device__ __forceinline__ bool next(int i, pg8::Unit& u) const {
        const int L = i * G + c;
        if (L >= ntiles * npn) return false;
        const int tile = L / npn, pn = L - tile * npn, e = __builtin_amdgcn_readfirstlane(tile_e[tile]);
        u.pm = tile; u.pn = pn; u.aux = e; u.a = A + (size_t)tile * tstep; u.b = B + (size_t)e * estride + (size_t)pn * tstep;
        return true;
    }
};

#define EPI_LOOP_ROWS _Pragma("unroll") for (int ai = 0; ai < 2; ++ai) _Pragma("unroll") for (int m = 0; m < 4; ++m)
#define EPI_LOOP_COLS _Pragma("unroll") for (int bj = 0; bj < 2; ++bj) _Pragma("unroll") for (int n = 0; n < 2; ++n)

struct EpiWin0 {
    static constexpr bool PERM = false, AFTER_DRAIN = false, I8 = true;
    bf16_t* q; bf16_t* kb; bf16_t* vt; bf16_t* y; float* xbr; float* gate; const float* sc_tok; const float* sc_w; const float* sc_wv;
    __device__ __forceinline__ void scales(const pg8::Unit& u, const float*& rs, const float*& cs) const {
        if (u.aux == 1) { rs = sc_wv; cs = sc_tok; } else { rs = sc_tok; cs = u.aux == 2 ? sc_w + 4096 : sc_w; } }
    __device__ __forceinline__ void operator()(const f32x4 (&acc)[2][2][4][2], const pg8::Unit& u, int wr, int wc, int fr, int fq) const {
        const int row0 = u.pm * 256 + wr * 64 + fr, cl0 = wc * 32 + 4 * fq;
        if (u.aux == 1) {
            EPI_LOOP_ROWS { bf16_t* rowp = vt + (size_t)(row0 + ai * 128 + m * 16) * TV + u.pn * 256 + cl0;
                EPI_LOOP_COLS { const f32x4 v = acc[ai][bj][m][n]; u32x2 o; o[0] = cvt_pk_bf16(v[0], v[1]); o[1] = cvt_pk_bf16(v[2], v[3]); *(u32x2*)(rowp + bj * 128 + n * 16) = o; } }
            return;
        }
        const int pn = u.aux == 2 ? 16 : u.pn;
        if (pn < 4) {
            EPI_LOOP_ROWS { bf16_t* rowp = q + (size_t)(row0 + ai * 128 + m * 16) * 1024 + pn * 256 + cl0;
                EPI_LOOP_COLS { const f32x4 v = acc[ai][bj][m][n] * 0.08838834764831845f; u32x2 o; o[0] = cvt_pk_bf16(v[0], v[1]); o[1] = cvt_pk_bf16(v[2], v[3]); *(u32x2*)(rowp + bj * 128 + n * 16) = o; } }
        } else if (pn < 8) {
            EPI_LOOP_ROWS {
                EPI_LOOP_COLS { bf16_t* dst = kb + ((size_t)((pn - 4) * 2 + bj) * TP + (row0 + ai * 128 + m * 16)) * 128 + cl0 + n * 16;
                    const f32x4 v = acc[ai][bj][m][n]; u32x2 o; o[0] = cvt_pk_bf16(v[0], v[1]); o[1] = cvt_pk_bf16(v[2], v[3]); *(u32x2*)dst = o; } }
        } else if (pn < 12) {
            EPI_LOOP_ROWS { bf16_t* rowp = y + (size_t)(row0 + ai * 128 + m * 16) * 1024 + (pn - 8) * 256 + cl0;
                EPI_LOOP_COLS { const f32x4 v = acc[ai][bj][m][n]; u32x2 o; o[0] = cvt_pk_bf16(geluf_(v[0]), geluf_(v[1])); o[1] = cvt_pk_bf16(geluf_(v[2]), geluf_(v[3])); *(u32x2*)(rowp + bj * 128 + n * 16) = o; } }
        } else if (pn < 16) {
            EPI_LOOP_ROWS { float* rowp = xbr + (size_t)(row0 + ai * 128 + m * 16) * 1024 + (pn - 12) * 256 + cl0;
                EPI_LOOP_COLS *(f32x4*)(rowp + bj * 128 + n * 16) = acc[ai][bj][m][n]; }
        } else {
            EPI_LOOP_ROWS { float* rowp = gate + (size_t)(row0 + ai * 128 + m * 16) * 24;
#pragma unroll
                for (int n = 0; n < 2; ++n) { const int c = cl0 + n * 16; if (c < 24) { const f32x4 v = acc[ai][0][m][n]; f32x4 o; o[0] = sigmoidf_(v[0]); o[1] = sigmoidf_(v[1]); o[2] = sigmoidf_(v[2]); o[3] = sigmoidf_(v[3]); *(f32x4*)(rowp + c) = o; } } }
        }
    }
};
template <bool XBF> struct EpiResid {
    static constexpr bool PERM = false, AFTER_DRAIN = false, I8 = false;
    const void* xin; const float* g; bf16_t* xout;
    __device__ __forceinline__ void operator()(const f32x4 (&acc)[2][2][4][2], const pg8::Unit& u, int wr, int wc, int fr, int fq) const {
        const int row0 = u.pm * 256 + wr * 64 + fr, col0 = u.pn * 256 + wc * 32 + 4 * fq;
        f32x4 gv[2][2];
        EPI_LOOP_COLS gv[bj][n] = *(const f32x4*)(g + col0 + bj * 128 + n * 16);
        EPI_LOOP_ROWS { const size_t ro = (size_t)(row0 + ai * 128 + m * 16) * D + col0;
            EPI_LOOP_COLS { f32x4 xi;
                if constexpr (XBF) { const u32x2 w = *(const u32x2*)((const bf16_t*)xin + ro + bj * 128 + n * 16); xi = (f32x4){bf_lo(w[0]), bf_hi(w[0]), bf_lo(w[1]), bf_hi(w[1])}; }
                else xi = *(const f32x4*)((const float*)xin + ro + bj * 128 + n * 16);
                const f32x4 y = xi + gv[bj][n] * acc[ai][bj][m][n];
                u32x2 o; o[0] = cvt_pk_bf16(y[0], y[1]); o[1] = cvt_pk_bf16(y[2], y[3]); *(u32x2*)(xout + ro + bj * 128 + n * 16) = o; } }
    }
};
struct EpiLogit {
    static constexpr bool PERM = false, AFTER_DRAIN = false, I8 = false;
    float* logit;
    __device__ __forceinline__ void operator()(const f32x4 (&acc)[2][2][4][2], const pg8::Unit& u, int wr, int wc, int fr, int fq) const {
        const int row0 = u.pm * 256 + wr * 64 + fr, cl0 = wc * 32 + 4 * fq;
        EPI_LOOP_ROWS { float* rowp = logit + ((size_t)u.aux * T + (row0 + ai * 128 + m * 16)) * LOGIT_LD;
#pragma unroll
            for (int n = 0; n < 2; ++n) { const int c = cl0 + n * 16; if (c < 72) *(f32x4*)(rowp + c) = acc[ai][0][m][n]; } }
    }
};
struct EpiMoe1 {
    static constexpr bool PERM = false, AFTER_DRAIN = false, I8 = false;
    bf16_t* hid;
    __device__ __forceinline__ void operator()(const f32x4 (&acc)[2][2][4][2], const pg8::Unit& u, int wr, int wc, int fr, int fq) const {
        const int row0 = u.pm * 256 + wr * 64 + fr, col0 = u.pn * 128 + wc * 32 + 4 * fq;
        EPI_LOOP_ROWS { bf16_t* rowp = hid + (size_t)(row0 + ai * 128 + m * 16) * 512 + col0;
#pragma unroll
            for (int n = 0; n < 2; ++n) { const f32x4 a = acc[ai][0][m][n], b = acc[ai][1][m][n];
                u32x2 o; o[0] = cvt_pk_bf16(siluf_(a[0]) * b[0], siluf_(a[1]) * b[1]); o[1] = cvt_pk_bf16(siluf_(a[2]) * b[2], siluf_(a[3]) * b[3]); *(u32x2*)(rowp + n * 16) = o; } }
    }
};
struct EpiBf16Plain {
    static constexpr bool PERM = false, AFTER_DRAIN = false, I8 = false;
    bf16_t* out; int ld;
    __device__ __forceinline__ void operator()(const f32x4 (&acc)[2][2][4][2], const pg8::Unit& u, int wr, int wc, int fr, int fq) const {
        const int row0 = u.pm * 256 + wr * 64 + fr, col0 = u.pn * 256 + wc * 32 + 4 * fq;
        EPI_LOOP_ROWS { bf16_t* rowp = out + (size_t)(row0 + ai * 128 + m * 16) * ld + col0;
            EPI_LOOP_COLS { const f32x4 v = acc[ai][bj][m][n]; u32x2 o; o[0] = cvt_pk_bf16(v[0], v[1]); o[1] = cvt_pk_bf16(v[2], v[3]); *(u32x2*)(rowp + bj * 128 + n * 16) = o; } }
    }
};
struct EpiWin1 {
    static constexpr bool PERM = false, AFTER_DRAIN = false, I8 = true;
    uchar* ws; const float* lbl;
    __device__ __forceinline__ void scales(const pg8::Unit&, const float*& rs, const float*& cs) const { rs = (const float*)(ws + WS_SC_TOK); cs = (const float*)(ws + WS_SC_W1); }
    __device__ __forceinline__ void operator()(const f32x4 (&acc)[2][2][4][2], const pg8::Unit& u, int wr, int wc, int fr, int fq) const {
        const int row0 = u.pm * 256 + wr * 64 + fr, sec = u.pn >> 3, col0 = (u.pn & 7) * 256 + wc * 32 + 4 * fq;
        if (sec == 1) {
            float* logf = (float*)(ws + V_LOGF); bf16_t* kk = (bf16_t*)(ws + V_KK);
            EPI_LOOP_COLS { const int c = col0 + bj * 128 + n * 16; const f32x4 l0 = *(const f32x4*)(lbl + c), l1 = *(const f32x4*)(lbl + 2048 + c);
                f32x4 lb;
#pragma unroll
                for (int i = 0; i < 4; ++i) lb[i] = sigmoidf_(l1[i] - l0[i]);
                EPI_LOOP_ROWS { const size_t ro = (size_t)(row0 + ai * 128 + m * 16) * 2048 + c;
                    const f32x4 z = acc[ai][bj][m][n]; f32x4 lf; float kv[4];
#pragma unroll
                    for (int i = 0; i < 4; ++i) { const float l = lb[i], sg = sigmoidf_(z[i]); const float f = l + (1.0f - l) * sg; lf[i] = __logf(fmaxf(f, 1e-30f)); kv[i] = (1.0f - l) * (1.0f - sg); }
                    *(f32x4*)(logf + ro) = lf;
                    u32x2 o; o[0] = cvt_pk_bf16(kv[0], kv[1]); o[1] = cvt_pk_bf16(kv[2], kv[3]); *(u32x2*)(kk + ro) = o; } }
            return;
        }
        const size_t doff = sec == 0 ? V_QS : (sec == 2 ? V_V : V_GS);
        bf16_t* dst = (bf16_t*)(ws + doff);
        EPI_LOOP_ROWS { bf16_t* rowp = dst + (size_t)(row0 + ai * 128 + m * 16) * 2048 + col0;
            EPI_LOOP_COLS { f32x4 z = acc[ai][bj][m][n];
                if (sec != 2) { z[0] = siluf_(z[0]); z[1] = siluf_(z[1]); z[2] = siluf_(z[2]); z[3] = siluf_(z[3]); }
                u32x2 o; o[0] = cvt_pk_bf16(z[0], z[1]); o[1] = cvt_pk_bf16(z[2], z[3]); *(u32x2*)(rowp + bj * 128 + n * 16) = o; } }
    }
};
__device__ __forceinline__ void compress_unit(const Params& p, LAS uchar* lds, int u) {
    const int tid = tid_opaque(), lane = tid & 63, wave = tid >> 6, fr = lane & 15, fq = lane >> 4;
    const int kind = u >> 5, g = (u >> 4) & 1, mt = u & 15;
    uchar* ws = p.ws;
    const bf16_t* src = (const bf16_t*)(ws + U_KB) + (size_t)(kind * 2 + g) * TP * 128;
    const bf16_t* W1 = (const bf16_t*)(ws + WS_WC1T) + (size_t)kind * 128 * 4096;
    const bf16_t* W2 = (const bf16_t*)(ws + WS_WC2T) + (size_t)kind * 128 * 128;
    LAS float* slab = (LAS float*)lds;
    LAS bf16_t* hidl = (LAS bf16_t*)(lds + 131072);
    f32x4 acc[2][8];
#pragma unroll
    for (int m = 0; m < 2; ++m)
#pragma unroll
        for (int n = 0; n < 8; ++n) acc[m][n] = (f32x4){0.f, 0.f, 0.f, 0.f};
    const int kbeg = wave * 512;
    {
        const bf16_t* ap = src + (size_t)(mt * 32 + fr) * 2048 + kbeg + 8 * fq; const bf16_t* bp = W1 + (size_t)fr * 4096 + kbeg + 8 * fq;
        bf16x8 a0[2], b0[8], a1[2], b1[8];
#define CU_LOAD(A, B, KS) do { _Pragma("unroll") for (int m = 0; m < 2; ++m) A[m] = *(const bf16x8*)(ap + (size_t)(m * 16) * 2048 + (KS) * 32); \
        _Pragma("unroll") for (int n = 0; n < 8; ++n) B[n] = *(const bf16x8*)(bp + (size_t)(n * 16) * 4096 + (KS) * 32); } while (0)
#define CU_MMA(A, B) do { _Pragma("unroll") for (int m = 0; m < 2; ++m) _Pragma("unroll") for (int n = 0; n < 8; ++n) acc[m][n] = __builtin_amdgcn_mfma_f32_16x16x32_bf16(A[m], B[n], acc[m][n], 0, 0, 0); \
        __builtin_amdgcn_sched_barrier(0); } while (0)
        CU_LOAD(a0, b0, 0);
#pragma unroll
        for (int ks = 0; ks < 16; ks += 2) {
            CU_LOAD(a1, b1, ks + 1); CU_MMA(a0, b0);
            if (ks + 2 < 16) CU_LOAD(a0, b0, ks + 2);
            CU_MMA(a1, b1);
        }
#undef CU_LOAD
#undef CU_MMA
    }
#pragma unroll
    for (int m = 0; m < 2; ++m)
#pragma unroll
        for (int n = 0; n < 8; ++n)
#pragma unroll
            for (int j = 0; j < 4; ++j) slab[(wave * 32 + m * 16 + fq * 4 + j) * 128 + n * 16 + fr] = acc[m][n][j];
    __syncthreads();
    {
        const float* pebp = (const float*)(ws + WS_PEBP);
        for (int e = tid; e < 32 * 128; e += NTHREADS) {
            const int r = e >> 7, c = e & 127;
            float s = p.in[I_CB1][kind * 128 + c];
#pragma unroll
            for (int q = 0; q < 16; ++q) s += pebp[(q * 2 + kind) * 128 + c];
#pragma unroll
            for (int w = 0; w < 8; ++w) s += slab[(w * 32 + r) * 128 + c];
            hidl[r * 136 + c] = f2bf(geluf_(s));
        }
    }
    __syncthreads();
    {
        f32x4 o[2] = {(f32x4){0.f, 0.f, 0.f, 0.f}, (f32x4){0.f, 0.f, 0.f, 0.f}};
#pragma unroll
        for (int ks = 0; ks < 4; ++ks) {
            const bf16x8 b = *(const bf16x8*)(W2 + (size_t)(wave * 16 + fr) * 128 + ks * 32 + 8 * fq);
#pragma unroll
            for (int m = 0; m < 2; ++m) { const bf16x8 a = *(const LAS bf16x8*)(hidl + (m * 16 + fr) * 136 + ks * 32 + 8 * fq); o[m] = __builtin_amdgcn_mfma_f32_16x16x32_bf16(a, b, o[m], 0, 0, 0); }
        }
        const int col = wave * 16 + fr; const float b2 = p.in[I_CB2][kind * 128 + col];
#pragma unroll
        for (int m = 0; m < 2; ++m)
#pragma unroll
            for (int j = 0; j < 4; ++j) {
                const int n = mt * 32 + m * 16 + fq * 4 + j; const float v = (n < 511) ? o[m][j] + b2 : 0.f;
                if (kind == 0) ((bf16_t*)(ws + U_KCMP))[((size_t)g * 512 + n) * 128 + col] = f2bf(v);
                else ((bf16_t*)(ws + U_VCMPT))[((size_t)g * 128 + col) * 512 + n] = f2bf(v);
            }
    }
    __syncthreads();
}

__device__ __forceinline__ void lru_xload(float (&x)[19], const uchar* ws, int u, int tid) {
    const int cc = u >> 3, nb = u & 7, tb = cc * 64 + (tid >> 7) * 16 - 3;
    const float* xbr = (const float*)(ws + U_XBR) + nb * 128 + (tid & 127);
#pragma unroll
    for (int i = 0; i < 19; ++i) { const int t = tb + i; x[i] = t >= 0 ? xbr[(size_t)t * 1024] : 0.f; }
}
__device__ __forceinline__ void lru_local_unit(const Params& p, LAS uchar* lds, int u, int unext, float (&x)[19]) {
    const int tid = tid_opaque(), lane = tid & 63, wave = tid >> 6, fr = lane & 15, fq = lane >> 4;
    const int cc = u >> 3, nb = u & 7, t0 = cc * 64, ch0 = nb * 128;
    uchar* ws = p.ws;
    LAS float* xc = (LAS float*)lds;
    LAS bf16_t* xcb = (LAS bf16_t*)(lds + 32768);
    LAS float* la = (LAS float*)(lds + 50176);
    LAS float* bb = (LAS float*)(lds + 82944);
    LAS float* segh = (LAS float*)(lds + 115712);
    LAS float* segl = (LAS float*)(lds + 117760);
    {
        const int ch = tid & 127, sg = tid >> 7;
        const float w0 = p.in[I_CONVW][0 * 1024 + ch0 + ch], w1 = p.in[I_CONVW][1 * 1024 + ch0 + ch], w2 = p.in[I_CONVW][2 * 1024 + ch0 + ch], w3 = p.in[I_CONVW][3 * 1024 + ch0 + ch];
        const float cb = p.in[I_CONVB][ch0 + ch];
#pragma unroll
        for (int i = 0; i < 16; ++i) {
            const int r = sg * 16 + i;
            const float v = x[i] * w0 + x[i + 1] * w1 + x[i + 2] * w2 + x[i + 3] * w3 + cb;
            xc[r * 128 + ch] = v; xcb[r * 136 + ch] = f2bf(v);
        }
        if (unext >= 0) lru_xload(x, ws, unext, tid);
    }
    __syncthreads();
    {
        const bf16_t* WA = (const bf16_t*)(ws + WS_WAT) + (size_t)nb * 16384, * WI = (const bf16_t*)(ws + WS_WIT) + (size_t)nb * 16384;
        f32x4 ra[4], ia[4];
#pragma unroll
        for (int m = 0; m < 4; ++m) { ra[m] = (f32x4){0.f, 0.f, 0.f, 0.f}; ia[m] = (f32x4){0.f, 0.f, 0.f, 0.f}; }
#pragma unroll
        for (int ks = 0; ks < 4; ++ks) {
            const bf16x8 ba = *(const bf16x8*)(WA + (size_t)(wave * 16 + fr) * 128 + ks * 32 + 8 * fq), bi = *(const bf16x8*)(WI + (size_t)(wave * 16 + fr) * 128 + ks * 32 + 8 * fq);
#pragma unroll
            for (int m = 0; m < 4; ++m) { const bf16x8 a = *(const LAS bf16x8*)(xcb + (m * 16 + fr) * 136 + ks * 32 + 8 * fq);
                ra[m] = __builtin_amdgcn_mfma_f32_16x16x32_bf16(a, ba, ra[m], 0, 0, 0); ia[m] = __builtin_amdgcn_mfma_f32_16x16x32_bf16(a, bi, ia[m], 0, 0, 0); }
        }
        const int e = wave * 16 + fr;
        const float bav = p.in[I_LBA][ch0 + e], biv = p.in[I_LBI][ch0 + e];
        const float sp = log1pf(__expf(-p.in[I_LAMBDA][ch0 + e]));
#pragma unroll
        for (int m = 0; m < 4; ++m)
#pragma unroll
            for (int j = 0; j < 4; ++j) {
                const int r = m * 16 + fq * 4 + j;
                const float rg = sigmoidf_(ra[m][j] + bav), ig = sigmoidf_(ia[m][j] + biv);
                const float lg = -8.0f * rg * sp;
                la[r * 128 + e] = lg;
                bb[r * 128 + e] = __builtin_amdgcn_sqrtf(fmaxf(1.0f - __expf(2.0f * lg), 0.f)) * (ig * xc[r * 128 + e]);
            }
    }
    __syncthreads();
    {
        const int ch = tid & 127, sg = tid >> 7;
        float h = 0.f, cl = 0.f;
        for (int r = sg * 16; r < sg * 16 + 16; ++r) { const float lg = la[r * 128 + ch]; h = __expf(lg) * h + bb[r * 128 + ch]; cl += lg; bb[r * 128 + ch] = h; la[r * 128 + ch] = cl; }
        segh[sg * 128 + ch] = h; segl[sg * 128 + ch] = cl;
        __syncthreads();
        float carry = 0.f, lpre = 0.f;
        for (int s = 0; s < sg; ++s) { carry = segh[s * 128 + ch] + __expf(segl[s * 128 + ch]) * carry; lpre += segl[s * 128 + ch]; }
        float* hloc = (float*)(ws + U_HLOC); float* pc = (float*)(ws + U_PC);
        float hl = 0.f, pl = 0.f;
        for (int r = sg * 16; r < sg * 16 + 16; ++r) {
            const float pw = __expf(la[r * 128 + ch]);
            hl = bb[r * 128 + ch] + pw * carry; pl = pw * __expf(lpre);
            hloc[(size_t)(t0 + r) * 1024 + ch0 + ch] = hl; pc[(size_t)(t0 + r) * 1024 + ch0 + ch] = pl;
        }
        if (sg == 3) { ((float*)(ws + U_HEND))[cc * 1024 + ch0 + ch] = hl; ((float*)(ws + U_PEND))[cc * 1024 + ch0 + ch] = pl; }
    }
    __syncthreads();
}

__device__ __forceinline__ void lru_fix_unit(const Params& p, int u) {
    const int tid = tid_opaque(), cc = u >> 1, rh = (u & 1) * 32;
    uchar* ws = p.ws;
    const float* hend = (const float*)(ws + U_HEND); const float* pend = (const float*)(ws + U_PEND);
    const int ch = 2 * tid;
    float c0 = 0.f, c1 = 0.f;
    int c = 0;
    for (; c + 8 <= cc; c += 8) {
        float2 he[8], pe[8];
#pragma unroll
        for (int i = 0; i < 8; ++i) { he[i] = *(const float2*)(hend + (c + i) * 1024 + ch); pe[i] = *(const float2*)(pend + (c + i) * 1024 + ch); }
#pragma unroll
        for (int i = 0; i < 8; ++i) { c0 = he[i].x + pe[i].x * c0; c1 = he[i].y + pe[i].y * c1; }
    }
    for (; c < cc; ++c) {
        const float2 he = *(const float2*)(hend + c * 1024 + ch), pe = *(const float2*)(pend + c * 1024 + ch);
        c0 = he.x + pe.x * c0; c1 = he.y + pe.y * c1;
    }
    const float* hloc = (const float*)(ws + U_HLOC); const float* pc = (const float*)(ws + U_PC);
    const bf16_t* y = (const bf16_t*)(ws + U_Y); bf16_t* cat = (bf16_t*)(ws + U_CAT);
#pragma unroll 1
    for (int rb = 0; rb < 32; rb += 8) {
        float2 h[8], pw[8]; unsigned yy[8];
#pragma unroll
        for (int i = 0; i < 8; ++i) { const size_t t = (size_t)cc * 64 + rh + rb + i; h[i] = *(const float2*)(hloc + t * 1024 + ch); pw[i] = *(const float2*)(pc + t * 1024 + ch); yy[i] = *(const unsigned*)(y + t * 1024 + ch); }
#pragma unroll
        for (int i = 0; i < 8; ++i) { const size_t t = (size_t)cc * 64 + rh + rb + i;
            *(unsigned*)(cat + t * 2048 + 1024 + ch) = cvt_pk_bf16(bf_lo(yy[i]) * (h[i].x + pw[i].x * c0), bf_hi(yy[i]) * (h[i].y + pw[i].y * c1)); }
    }
}
constexpr int A_STG = 33792;
constexpr int A_VOFF = 16384;
constexpr int A_Q = 67584;
constexpr int A_IMP = 100352;
constexpr int A_SEL = 116864;
constexpr int A_UNI = 117376;
constexpr int A_LUT = 117392;
constexpr int A_ML = 119504;
constexpr int A_END = 121552;
constexpr int IMP_LD = 129;
#define F16ZERO (f32x16){0.f, 0.f, 0.f, 0.f, 0.f, 0.f, 0.f, 0.f, 0.f, 0.f, 0.f, 0.f, 0.f, 0.f, 0.f, 0.f}

struct AttnPre { u32x4 k0, k1, v0, v1; };
__device__ __forceinline__ void attn_issue(AttnPre& pre, const bf16_t* krow0, const bf16_t* v0, int ldv, int tid) {
    { const int row = tid >> 4, ch = tid & 15; pre.k0 = *(const u32x4*)(krow0 + (size_t)row * 128 + ch * 8); pre.k1 = *(const u32x4*)(krow0 + (size_t)(row + 32) * 128 + ch * 8); }
    { const int d = tid >> 3, ch = tid & 7; pre.v0 = *(const u32x4*)(v0 + (size_t)d * ldv + ch * 8); pre.v1 = *(const u32x4*)(v0 + (size_t)(d + 64) * ldv + ch * 8); }
}
__device__ __forceinline__ void attn_commit(const AttnPre& pre, LAS uchar* stg, int tid) {
    { const int row = tid >> 4, ch = tid & 15;
      *(LAS u32x4*)(stg + row * 256 + ((ch ^ (row & 15)) << 4)) = pre.k0; *(LAS u32x4*)(stg + (row + 32) * 256 + ((ch ^ (row & 15)) << 4)) = pre.k1; }
    { const int d = tid >> 3, ch = tid & 7;
      LAS u32x2* q0 = (LAS u32x2*)(stg + A_VOFF + d * 136 + ch * 16); q0[0] = (u32x2){pre.v0[0], pre.v0[1]}; q0[1] = (u32x2){pre.v0[2], pre.v0[3]};
      LAS u32x2* q1 = (LAS u32x2*)(stg + A_VOFF + (d + 64) * 136 + ch * 16); q1[0] = (u32x2){pre.v1[0], pre.v1[1]}; q1[1] = (u32x2){pre.v1[2], pre.v1[3]}; }
}
#define AT_LOAD(dst, ptr) asm volatile("global_load_dwordx4 %0, %1, off" : "=&v"(dst) : "v"(ptr) : "memory")
#define AT_WAIT(P, n) asm volatile("s_waitcnt vmcnt(" #n ")" : "+v"(P.k0), "+v"(P.k1), "+v"(P.v0), "+v"(P.v1) :: "memory")
__device__ __forceinline__ void at_issue(AttnPre& pre, const bf16_t* krow0, const bf16_t* v0, int ldv, int tid) {
    { const int row = tid >> 4, ch = tid & 15; const bf16_t* p0 = krow0 + (size_t)row * 128 + ch * 8; const bf16_t* p1 = krow0 + (size_t)(row + 32) * 128 + ch * 8; AT_LOAD(pre.k0, p0); AT_LOAD(pre.k1, p1); }
    { const int d = tid >> 3, ch = tid & 7; const bf16_t* p0 = v0 + (size_t)d * ldv + ch * 8; const bf16_t* p1 = v0 + (size_t)(d + 64) * ldv + ch * 8; AT_LOAD(pre.v0, p0); AT_LOAD(pre.v1, p1); }
}
struct AttnSeq { int mode, n, base, last; unsigned long long ua, ub; };
__device__ __forceinline__ int seq_next(AttnSeq& q) {
    if (q.mode == 0) { const int j = q.base < q.last ? q.base : q.last; ++q.base; return j; }
    if ((q.ua | q.ub) == 0ull) return q.last;
    int j; if (q.ua) { j = __builtin_ctzll(q.ua); q.ua &= q.ua - 1; } else { j = 64 + __builtin_ctzll(q.ub); q.ub &= q.ub - 1; }
    q.last = j; return j;
}
#define ATTN_PIPE(seq, kb, vb, ldv, COMPUTE) do { \
    const int n_ = (seq).n; int jq0_ = seq_next(seq), jq1_ = seq_next(seq), jq2_; \
    at_issue(P0, (kb) + (size_t)jq0_ * 8192, (vb) + jq0_ * 64, ldv, tid); \
    at_issue(P1, (kb) + (size_t)jq1_ * 8192, (vb) + jq1_ * 64, ldv, tid); \
    AT_WAIT(P0, 4); \
    attn_commit(P0, lds, tid); __syncthreads(); \
    for (int i_ = 0; i_ < n_; i_ += 2) { \
        jq2_ = seq_next(seq); at_issue(P0, (kb) + (size_t)jq2_ * 8192, (vb) + jq2_ * 64, ldv, tid); \
        COMPUTE(lds, jq0_); \
        AT_WAIT(P1, 4); \
        if (i_ + 1 < n_) attn_commit(P1, lds + A_STG, tid); \
        __syncthreads(); \
        jq0_ = jq1_; jq1_ = jq2_; \
        jq2_ = seq_next(seq); at_issue(P1, (kb) + (size_t)jq2_ * 8192, (vb) + jq2_ * 64, ldv, tid); \
        if (i_ + 1 < n_) { COMPUTE(lds + A_STG, jq0_); } \
        AT_WAIT(P0, 4); \
        if (i_ + 2 < n_) attn_commit(P0, lds, tid); \
        __syncthreads(); \
        jq0_ = jq1_; jq1_ = jq2_; \
    } \
    asm volatile("s_waitcnt vmcnt(0)" ::: "memory"); } while (0)

__device__ __forceinline__ f32x16 attn_qk(const LAS uchar* stg, const LAS uchar* qimg, int qrow, int kh, int r, int hh) {
    f32x16 s = F16ZERO;
    const int row = 32 * kh + r;
#pragma unroll
    for (int ks = 0; ks < 8; ++ks) {
        const bf16x8 qf = *(const LAS bf16x8*)(qimg + qrow * 256 + (((2 * ks + hh) ^ (qrow & 15)) << 4));
        const bf16x8 kf = *(const LAS bf16x8*)(stg + row * 256 + (((2 * ks + hh) ^ (row & 15)) << 4));
        s = __builtin_amdgcn_mfma_f32_32x32x16_bf16(kf, qf, s, 0, 0, 0);
    }
    return s;
}
__device__ __forceinline__ void attn_pv(const LAS uchar* stg, const f32x16& p, f32x16 (&o)[4], int kh, int r, int hh) {
    bf16x8 pb[2];
#pragma unroll
    for (int sx = 0; sx < 2; ++sx) {
        u32x4 w;
#pragma unroll
        for (int q = 0; q < 4; ++q) w[q] = cvt_pk_bf16(p[8 * sx + 2 * q], p[8 * sx + 2 * q + 1]);
        pb[sx] = __builtin_bit_cast(bf16x8, w);
    }
#pragma unroll
    for (int dt = 0; dt < 4; ++dt) {
        const LAS uchar* vrow = stg + A_VOFF + (32 * dt + r) * 136;
#pragma unroll
        for (int sx = 0; sx < 2; ++sx) {
            const int col = 32 * kh + 16 * sx + 4 * hh;
            const u32x2 lo = *(const LAS u32x2*)(vrow + col * 2), hi = *(const LAS u32x2*)(vrow + (col + 8) * 2);
            const u32x4 w = {lo[0], lo[1], hi[0], hi[1]};
            o[dt] = __builtin_amdgcn_mfma_f32_32x32x16_bf16(__builtin_bit_cast(bf16x8, w), pb[sx], o[dt], 0, 0, 0);
        }
    }
}
__device__ __forceinline__ void attn_online(f32x16& s, f32x16 (&o)[4], float& m, float& l, float bias = 0.f) {
    float mx = -INFINITY;
#pragma unroll
    for (int i = 0; i < 16; ++i) mx = fmaxf(mx, s[i]);
    mx += bias;
    mx = fmaxf(mx, __shfl_xor(mx, 32));
    const float mn = fmaxf(m, mx), mu = (mn == -INFINITY) ? 0.f : mn;
    const float alpha = __expf(m - mu);
    const float nmu2 = 1.4426950408889634f * (bias - mu);
    float sum = 0.f;
#pragma unroll
    for (int i = 0; i < 16; ++i) { const float e = __builtin_amdgcn_exp2f(__builtin_fmaf(s[i], 1.4426950408889634f, nmu2)); s[i] = e; sum += e; }
    l = l * alpha + sum; m = mn;
    if (__any(alpha != 1.0f)) {
#pragma unroll
        for (int dt = 0; dt < 4; ++dt) o[dt] *= alpha;
    }
}
__device__ __forceinline__ float attn_merge_scale(LAS float* ml, int kh, int hl, int r, int hh, float m, float l, float gate) {
    const float lt = l + __shfl_xor(l, 32);
    if (hh == 0) { ml[((kh * 4 + hl) * 32 + r) * 2] = m; ml[((kh * 4 + hl) * 32 + r) * 2 + 1] = lt; }
    __syncthreads();
    const float m2 = ml[(((kh ^ 1) * 4 + hl) * 32 + r) * 2], l2 = ml[(((kh ^ 1) * 4 + hl) * 32 + r) * 2 + 1];
    const float ms = fmaxf(m, m2), mu = (ms == -INFINITY) ? 0.f : ms;
    const float e1 = __expf(m - mu), e2 = __expf(m2 - mu), den = lt * e1 + l2 * e2;
    return den > 0.f ? gate * e1 / den : 0.f;
}
__device__ __forceinline__ void attn_merge_o(LAS uchar* lds, int kh, int hl, int lane, f32x16 (&o)[4], float f) {
    LAS f32x4* buf = (LAS f32x4*)lds + (size_t)hl * 1024;
    __syncthreads();
    if (kh == 1) {
#pragma unroll
        for (int dt = 0; dt < 4; ++dt)
#pragma unroll
            for (int c4 = 0; c4 < 4; ++c4) buf[(dt * 4 + c4) * 64 + lane] = (f32x4){o[dt][4 * c4] * f, o[dt][4 * c4 + 1] * f, o[dt][4 * c4 + 2] * f, o[dt][4 * c4 + 3] * f};
    }
    __syncthreads();
    if (kh == 0) {
#pragma unroll
        for (int dt = 0; dt < 4; ++dt)
#pragma unroll
            for (int c4 = 0; c4 < 4; ++c4) { const f32x4 v = buf[(dt * 4 + c4) * 64 + lane];
#pragma unroll
                for (int q = 0; q < 4; ++q) o[dt][4 * c4 + q] = o[dt][4 * c4 + q] * f + v[q]; }
    }
    __syncthreads();
}
__device__ __forceinline__ void attn_park(f32x4* park, const f32x16 (&o)[4], bool first) {
#pragma unroll
    for (int dt = 0; dt < 4; ++dt)
#pragma unroll
        for (int c4 = 0; c4 < 4; ++c4) {
            f32x4 v = {o[dt][4 * c4], o[dt][4 * c4 + 1], o[dt][4 * c4 + 2], o[dt][4 * c4 + 3]};
            if (!first) v += park[dt * 4 + c4];
            park[dt * 4 + c4] = v;
        }
}

__device__ __forceinline__ void attn_unit(const Params& p, LAS uchar* lds, int g, int c32) {
    const int tid = tid_opaque(), lane = tid & 63, wave = tid >> 6, r = lane & 31, hh = lane >> 5;
    const int hl = wave & 3, kh = wave >> 2, t0 = c32 * 32, t = t0 + r, head = g * 4 + hl, cur = c32 >> 1;
    uchar* ws = p.ws;
    LAS unsigned* imp = (LAS unsigned*)(lds + A_IMP); LAS unsigned* sel = (LAS unsigned*)(lds + A_SEL); LAS unsigned* uni = (LAS unsigned*)(lds + A_UNI);
    LAS float* lut = (LAS float*)(lds + A_LUT); LAS float* ml = (LAS float*)(lds + A_ML);
    const LAS uchar* qimg = lds + A_Q;
    for (int i = tid; i < 4 * 129; i += NTHREADS) { const int h = i / 129, rel = i % 129; lut[h * 132 + rel] = p.in[I_RELB][(rel >= 128 ? 31 : t5_bucket(rel)) * 8 + g * 4 + h]; }
    for (int i = tid; i < 32 * IMP_LD; i += NTHREADS) imp[i] = 0u;
    if (tid < 4) uni[tid] = 0u;
    {
        const bf16_t* qg = (const bf16_t*)(ws + U_Q);
#pragma unroll
        for (int rep = 0; rep < 4; ++rep) {
            const int id = tid + NTHREADS * rep, row = id >> 4, ch = id & 15;
            const u32x4 v = *(const u32x4*)(qg + (size_t)(t0 + (row & 31)) * 1024 + (g * 4 + (row >> 5)) * 128 + ch * 8);
            *(LAS u32x4*)(lds + A_Q + row * 256 + ((ch ^ (row & 15)) << 4)) = v;
        }
    }
    const int qrow = hl * 32 + r;
    const float* gp = (const float*)(ws + U_GATE) + (size_t)t * 24 + head * 3;
    const float g_cmp = gp[0], g_slc = gp[1], g_win = gp[2];
    const LAS float* mylut = lut + hl * 132;
    const float b31 = p.in[I_RELB][31 * 8 + head];
    f32x16 o[4];
#pragma unroll
    for (int dt = 0; dt < 4; ++dt) o[dt] = F16ZERO;
    f32x4* park = (f32x4*)(ws + WS_PARK) + ((size_t)blockIdx.x * 256 + (tid & 255)) * 16;
    AttnPre P0, P1;

    const bf16_t* kcmp = (const bf16_t*)(ws + U_KCMP) + (size_t)g * 512 * 128;
    const bf16_t* vcmpt = (const bf16_t*)(ws + U_VCMPT) + (size_t)g * 128 * 512;
    const int ntc = (2 * c32) / 64 + 1;
    float m = -INFINITY, l = 0.f;
#define CMP1_COMPUTE(stg, nt) do { \
        f32x16 s = attn_qk(stg, qimg, qrow, kh, r, hh); \
        float mx = -INFINITY; \
        if (t0 >= 1024 * (nt) + 1167) {            \
            _Pragma("unroll") for (int i = 0; i < 16; ++i) { const float v = s[i] + b31; s[i] = v; mx = fmaxf(mx, v); } \
        } else { \
        _Pragma("unroll") for (int i = 0; i < 16; ++i) { \
            const int n = (nt) * 64 + 32 * kh + (i & 3) + 8 * (i >> 2) + 4 * hh, rel = t - (16 * n + 31); \
            const float bv = mylut[min(max(rel, 0), 128)]; const float v = rel >= 0 ? s[i] + bv : -INFINITY; \
            s[i] = v; mx = fmaxf(mx, v); } } \
        mx = fmaxf(mx, __shfl_xor(mx, 32)); \
        const float mn = fmaxf(m, mx), mu_ = (mn == -INFINITY) ? 0.f : mn; \
        float sum = 0.f; \
        const float nmu2_ = -1.4426950408889634f * mu_; \
        _Pragma("unroll") for (int i = 0; i < 16; ++i) sum += __builtin_amdgcn_exp2f(__builtin_fmaf(s[i], 1.4426950408889634f, nmu2_)); \
        l = l * __expf(m - mu_) + sum; m = mn; } while (0)
    { AttnSeq q; q.mode = 0; q.n = ntc; q.base = 0; q.last = ntc - 1; q.ua = 0; q.ub = 0; ATTN_PIPE(q, kcmp, vcmpt, 512, CMP1_COMPUTE); }
    {
        const float lt = l + __shfl_xor(l, 32);
        if (hh == 0) { ml[((kh * 4 + hl) * 32 + r) * 2] = m; ml[((kh * 4 + hl) * 32 + r) * 2 + 1] = lt; }
        __syncthreads();
        const float m2 = ml[(((kh ^ 1) * 4 + hl) * 32 + r) * 2], l2 = ml[(((kh ^ 1) * 4 + hl) * 32 + r) * 2 + 1];
        const float ms = fmaxf(m, m2), mu = (ms == -INFINITY) ? 0.f : ms;
        const float den = lt * __expf(m - mu) + l2 * __expf(m2 - mu);
        const float inv = den > 0.f ? 1.0f / den : 0.f;
#define CMP2_COMPUTE(stg, nt) do { \
            f32x16 s = attn_qk(stg, qimg, qrow, kh, r, hh); \
            if (t0 >= 1024 * (nt) + 1167) { \
                const float bm = b31 - mu; \
                const float bm2 = 1.4426950408889634f * bm; \
                _Pragma("unroll") for (int i = 0; i < 16; ++i) s[i] = __builtin_amdgcn_exp2f(__builtin_fmaf(s[i], 1.4426950408889634f, bm2)) * inv; \
            } else { \
            _Pragma("unroll") for (int i = 0; i < 16; ++i) { \
                const int n = (nt) * 64 + 32 * kh + (i & 3) + 8 * (i >> 2) + 4 * hh, rel = t - (16 * n + 31); \
                const float bv = mylut[min(max(rel, 0), 128)]; s[i] = rel >= 0 ? __expf(s[i] + bv - mu) * inv : 0.f; } } \
            _Pragma("unroll") for (int c4 = 0; c4 < 4; ++c4) { \
                const int j = (nt) * 16 + 8 * kh + 2 * c4 + hh; \
                const float s4 = s[4 * c4] + s[4 * c4 + 1] + s[4 * c4 + 2] + s[4 * c4 + 3]; \
                const unsigned q4 = (unsigned)(s4 * 67108864.f + 0.5f), q3 = (unsigned)(s[4 * c4 + 3] * 67108864.f + 0.5f); \
                (void)__hip_atomic_fetch_add(imp + r * IMP_LD + j, q4, __ATOMIC_RELAXED, __HIP_MEMORY_SCOPE_WORKGROUP); \
                (void)__hip_atomic_fetch_add(imp + r * IMP_LD + (j + 1 < 128 ? j + 1 : 128), q3, __ATOMIC_RELAXED, __HIP_MEMORY_SCOPE_WORKGROUP); } \
            _Pragma("unroll") for (int i = 0; i < 16; ++i) s[i] *= g_cmp; \
            attn_pv(stg, s, o, kh, r, hh); } while (0)
        { AttnSeq q; q.mode = 0; q.n = ntc; q.base = 0; q.last = ntc - 1; q.ua = 0; q.ub = 0; ATTN_PIPE(q, kcmp, vcmpt, 512, CMP2_COMPUTE); }
        attn_merge_o(lds, kh, hl, lane, o, 1.0f);
        if (kh == 0) attn_park(park, o, true);
    }
    {
        unsigned long long u0 = 0ull, u1 = 0ull;
        for (int tq = 0; tq < 4; ++tq) {
            const int tok = 4 * wave + tq;
            const LAS unsigned* row = imp + tok * IMP_LD;
            unsigned long long b0, b1;
            if (cur <= 15) { b0 = (2ull << cur) - 1ull; b1 = 0ull; }
            else {
                const int v0 = lane < cur ? (int)row[lane] : -1, v1 = (lane + 64 < cur) ? (int)row[lane + 64] : -1;
                int c0 = 0, c1 = 0;
                const int ja = cur < 64 ? cur : 64;
                for (int j = 0; j < ja; ++j) { const int vj = __builtin_amdgcn_readlane(v0, j); c0 += (vj > v0 || (vj == v0 && j < lane)) ? 1 : 0; c1 += (vj >= v1) ? 1 : 0; }
                for (int j = 64; j < cur; ++j) { const int vj = __builtin_amdgcn_readlane(v1, j - 64); c0 += (vj > v0) ? 1 : 0; c1 += (vj > v1 || (vj == v1 && j - 64 < lane)) ? 1 : 0; }
                b0 = __ballot(lane < cur && c0 < 15); b1 = __ballot(lane + 64 < cur && c1 < 15);
                if (cur < 64) b0 |= 1ull << cur; else b1 |= 1ull << (cur - 64);
            }
            if (lane == 0) { sel[tok * 4 + 0] = (unsigned)b0; sel[tok * 4 + 1] = (unsigned)(b0 >> 32); sel[tok * 4 + 2] = (unsigned)b1; sel[tok * 4 + 3] = (unsigned)(b1 >> 32); }
            u0 |= b0; u1 |= b1;
        }
        if (lane == 0) { (void)__hip_atomic_fetch_or(uni + 0, (unsigned)u0, __ATOMIC_RELAXED, __HIP_MEMORY_SCOPE_WORKGROUP); (void)__hip_atomic_fetch_or(uni + 1, (unsigned)(u0 >> 32), __ATOMIC_RELAXED, __HIP_MEMORY_SCOPE_WORKGROUP);
                         (void)__hip_atomic_fetch_or(uni + 2, (unsigned)u1, __ATOMIC_RELAXED, __HIP_MEMORY_SCOPE_WORKGROUP); (void)__hip_atomic_fetch_or(uni + 3, (unsigned)(u1 >> 32), __ATOMIC_RELAXED, __HIP_MEMORY_SCOPE_WORKGROUP); }
    }
    __syncthreads();
    {
        const unsigned sm0 = sel[r * 4 + 0], sm1 = sel[r * 4 + 1], sm2 = sel[r * 4 + 2], sm3 = sel[r * 4 + 3];
        const unsigned long long ua = ((unsigned long long)(unsigned)__builtin_amdgcn_readfirstlane((int)uni[1]) << 32) | (unsigned)__builtin_amdgcn_readfirstlane((int)uni[0]);
        const unsigned long long ub = ((unsigned long long)(unsigned)__builtin_amdgcn_readfirstlane((int)uni[3]) << 32) | (unsigned)__builtin_amdgcn_readfirstlane((int)uni[2]);
        const bf16_t* kslc = (const bf16_t*)(ws + U_KB) + (size_t)(2 * 2 + g) * TP * 128;
        const bf16_t* vslc = (const bf16_t*)(ws + U_VT) + (size_t)(0 * 2 + g) * 128 * TV;
#pragma unroll
        for (int dt = 0; dt < 4; ++dt) o[dt] = F16ZERO;
        m = -INFINITY; l = 0.f;
#define SLC_COMPUTE(stg, j) do { \
            f32x16 s = attn_qk(stg, qimg, qrow, kh, r, hh); \
            const unsigned mw = ((j) < 32) ? sm0 : ((j) < 64) ? sm1 : ((j) < 96) ? sm2 : sm3; \
            const bool mine = (mw >> ((j) & 31)) & 1u; \
            float bsel = 0.f; \
            if (cur - (j) >= 3) { \
                bsel = mine ? b31 : -INFINITY;                    \
            } else { \
                _Pragma("unroll") for (int i = 0; i < 16; ++i) { \
                    const int key = (j) * 64 + 32 * kh + (i & 3) + 8 * (i >> 2) + 4 * hh, rel = t - key; \
                    const float bv = mylut[min(max(rel, 0), 128)]; s[i] = (mine && rel >= 0) ? s[i] + bv : -INFINITY; } \
            } \
            attn_online(s, o, m, l, bsel); \
            attn_pv(stg, s, o, kh, r, hh); } while (0)
        { AttnSeq q; q.mode = 1; q.n = __builtin_popcountll(ua) + __builtin_popcountll(ub); q.base = 0; q.last = cur; q.ua = ua; q.ub = ub; ATTN_PIPE(q, kslc, vslc, TV, SLC_COMPUTE); }
        {
            const float f = attn_merge_scale(ml, kh, hl, r, hh, m, l, g_slc);
            attn_merge_o(lds, kh, hl, lane, o, f);
            if (kh == 0) attn_park(park, o, false);
        }
        const bf16_t* kwin = (const bf16_t*)(ws + U_KB) + (size_t)(3 * 2 + g) * TP * 128;
        const bf16_t* vwin = (const bf16_t*)(ws + U_VT) + (size_t)(1 * 2 + g) * 128 * TV;
#pragma unroll
        for (int dt = 0; dt < 4; ++dt) o[dt] = F16ZERO;
        m = -INFINITY; l = 0.f;
        const int j0 = cur >= 8 ? cur - 8 : 0;
#define WIN_COMPUTE(stg, jw) do { \
            f32x16 s = attn_qk(stg, qimg, qrow, kh, r, hh); \
            float bwin = 0.f; \
            if (cur - (jw) >= 3 && cur - (jw) <= 7) {    \
                bwin = b31; \
            } else if (cur - (jw) >= 3) {              \
                _Pragma("unroll") for (int i = 0; i < 16; ++i) { \
                    const int key = (jw) * 64 + 32 * kh + (i & 3) + 8 * (i >> 2) + 4 * hh; s[i] = (t - key < 512) ? s[i] + b31 : -INFINITY; } \
            } else { \
            _Pragma("unroll") for (int i = 0; i < 16; ++i) { \
                const int key = (jw) * 64 + 32 * kh + (i & 3) + 8 * (i >> 2) + 4 * hh, rel = t - key; \
                const float bv = mylut[min(max(rel, 0), 128)]; s[i] = (rel >= 0 && rel < 512) ? s[i] + bv : -INFINITY; } } \
            attn_online(s, o, m, l, bwin); \
            attn_pv(stg, s, o, kh, r, hh); } while (0)
        { AttnSeq q; q.mode = 0; q.n = cur - j0 + 1; q.base = j0; q.last = cur; q.ua = 0; q.ub = 0; ATTN_PIPE(q, kwin, vwin, TV, WIN_COMPUTE); }
        {
            const float f = attn_merge_scale(ml, kh, hl, r, hh, m, l, g_win);
            attn_merge_o(lds, kh, hl, lane, o, f);
        }
    }
    if (kh == 0) {
        bf16_t* op = (bf16_t*)(ws + U_CAT) + (size_t)t * 2048 + head * 128 + 4 * hh;
#pragma unroll
        for (int dt = 0; dt < 4; ++dt)
#pragma unroll
            for (int c4 = 0; c4 < 4; ++c4) {
                const f32x4 pv = park[dt * 4 + c4];
                u32x2 w; w[0] = cvt_pk_bf16(o[dt][4 * c4] + pv[0], o[dt][4 * c4 + 1] + pv[1]); w[1] = cvt_pk_bf16(o[dt][4 * c4 + 2] + pv[2], o[dt][4 * c4 + 3] + pv[3]);
                *(u32x2*)(op + 32 * dt + 8 * c4) = w;
            }
    }
    __syncthreads();
}
constexpr int H_BC = 0;
constexpr int H_QT = 32768;
constexpr int H_KT = 50176;
constexpr int H_VT = 93696;
constexpr int H_KH = 112128;
constexpr int H_ATT = 130560;
constexpr int H_SEG = 139776;
constexpr int H_END = 141824;
__device__ __forceinline__ int kt_row0(int i) { return i == 0 ? 0 : (i == 1 ? 16 : (i == 2 ? 48 : 96)); }

struct HlPre { float lf[16]; u32x4 q[2], k[2], v[2]; };
__device__ __forceinline__ void hl_load(HlPre& pre, const uchar* ws, int u, int tid) {
    const int h = u & 15, c = u >> 4, t0 = c * 64, col0 = h * 128;
    { const int d = tid & 127, sg = tid >> 7;
      const float* lf = (const float*)(ws + V_LOGF) + (size_t)(t0 + sg * 16) * 2048 + col0 + d;
#pragma unroll
      for (int r = 0; r < 16; ++r) pre.lf[r] = lf[(size_t)r * 2048]; }
#pragma unroll
    for (int rep = 0; rep < 2; ++rep) {
        const int id = tid + NTHREADS * rep, row = id >> 4, ch = id & 15;
        const size_t go = (size_t)(t0 + row) * 2048 + col0 + ch * 8;
        pre.q[rep] = *(const u32x4*)((const bf16_t*)(ws + V_QS) + go); pre.k[rep] = *(const u32x4*)((const bf16_t*)(ws + V_KK) + go); pre.v[rep] = *(const u32x4*)((const bf16_t*)(ws + V_V) + go);
    }
}
__device__ __forceinline__ void hgrn_local_unit(const Params& p, LAS uchar* lds, int u, int unext, HlPre& pre, int tid) {
    const int lane = tid & 63, wave = tid >> 6, fr = lane & 15, fq = lane >> 4;
    const int h = u & 15, c = u >> 4, t0 = c * 64, col0 = h * 128;
    uchar* ws = p.ws;
    LAS float* bc = (LAS float*)(lds + H_BC); LAS bf16_t* qt = (LAS bf16_t*)(lds + H_QT); LAS bf16_t* kt = (LAS bf16_t*)(lds + H_KT);
    LAS bf16_t* vt = (LAS bf16_t*)(lds + H_VT); LAS bf16_t* kh = (LAS bf16_t*)(lds + H_KH); LAS bf16_t* att = (LAS bf16_t*)(lds + H_ATT); LAS float* seg = (LAS float*)(lds + H_SEG);
    {
        const int d = tid & 127, sg = tid >> 7;
        float v[16];
#pragma unroll
        for (int r = 0; r < 16; ++r) v[r] = pre.lf[r];
        float a = 0.f;
#pragma unroll
        for (int r = 0; r < 16; ++r) { a += v[r]; v[r] = a; }
        seg[sg * 128 + d] = a;
        __syncthreads();
        float off = 0.f;
        for (int s = 0; s < sg; ++s) off += seg[s * 128 + d];
#pragma unroll
        for (int r = 0; r < 16; ++r) bc[(sg * 16 + r) * 128 + d] = v[r] + off;
        for (int i = tid; i < 64 * 72 / 2; i += NTHREADS) ((LAS unsigned*)att)[i] = 0u;
    }
    __syncthreads();
    {
#pragma unroll
        for (int rep = 0; rep < 2; ++rep) {
            const int id = tid + NTHREADS * rep, row = id >> 4, ch = id & 15, d0 = ch * 8, si = row >> 4;
            const size_t go = (size_t)(t0 + row) * 2048 + col0 + d0;
            const u32x4 qv = pre.q[rep], kv = pre.k[rep], vv = pre.v[rep];
            float qf[8], kf[8], bcv[8], bref[8], bl[8];
#pragma unroll
            for (int q = 0; q < 4; ++q) { qf[2 * q] = bf_lo(qv[q]); qf[2 * q + 1] = bf_hi(qv[q]); kf[2 * q] = bf_lo(kv[q]); kf[2 * q + 1] = bf_hi(kv[q]); }
            {
                const LAS f32x4* pc = (const LAS f32x4*)(bc + row * 128 + d0); const LAS f32x4* pr = (const LAS f32x4*)(bc + (si > 0 ? 16 * si - 1 : 0) * 128 + d0);
                const LAS f32x4* pl = (const LAS f32x4*)(bc + 63 * 128 + d0);
                const f32x4 c0 = pc[0], c1 = pc[1], r0 = pr[0], r1 = pr[1], l0 = pl[0], l1 = pl[1];
#pragma unroll
                for (int q = 0; q < 4; ++q) { bcv[q] = c0[q]; bcv[q + 4] = c1[q]; bref[q] = si > 0 ? r0[q] : 0.f; bref[q + 4] = si > 0 ? r1[q] : 0.f; bl[q] = l0[q]; bl[q + 4] = l1[q]; }
            }
            u32x4 w;
#pragma unroll
            for (int q = 0; q < 4; ++q) w[q] = cvt_pk_bf16(qf[2 * q] * __expf(bcv[2 * q] - bref[2 * q]), qf[2 * q + 1] * __expf(bcv[2 * q + 1] - bref[2 * q + 1]));
            *(LAS u32x4*)(qt + row * 136 + d0) = w;
#pragma unroll
            for (int q = 0; q < 4; ++q) w[q] = cvt_pk_bf16(qf[2 * q] * __expf(bcv[2 * q]), qf[2 * q + 1] * __expf(bcv[2 * q + 1]));
            *(u32x4*)((bf16_t*)(ws + V_QHAT) + go) = w;
#pragma unroll
            for (int i = 0; i < 4; ++i) {
                if (i >= si) {
                    float br[8];
#pragma unroll
                    for (int q = 0; q < 8; ++q) br[q] = i > 0 ? bc[(16 * i - 1) * 128 + d0 + q] : 0.f;
#pragma unroll
                    for (int q = 0; q < 4; ++q) w[q] = cvt_pk_bf16(kf[2 * q] * __expf(fminf(br[2 * q] - bcv[2 * q], 80.f)), kf[2 * q + 1] * __expf(fminf(br[2 * q + 1] - bcv[2 * q + 1], 80.f)));
                    *(LAS u32x4*)(kt + (kt_row0(i) + row) * 136 + d0) = w;
                }
            }
#pragma unroll
            for (int q = 0; q < 8; ++q) {
                kh[(d0 + q) * 72 + (row ^ ((ch & 7) << 3))] = f2bf(kf[q] * __expf(bl[q] - bcv[q]));
                vt[(d0 + q) * 72 + (row ^ ((ch & 7) << 3))] = (bf16_t)((q & 1) ? (vv[q >> 1] >> 16) : (vv[q >> 1] & 0xffffu));
            }
        }
        if (tid < 128) ((float*)(ws + V_DEC))[((size_t)c * 16 + h) * 128 + tid] = __expf(bc[63 * 128 + tid]);
    }
    if (unext < 2048) hl_load(pre, ws, unext, tid);
    __syncthreads();
    {
        for (int tix = wave; tix < 10; tix += 8) {
            int i = 0, j = tix;
            if (tix >= 6) { i = 3; j = tix - 6; } else if (tix >= 3) { i = 2; j = tix - 3; } else if (tix >= 1) { i = 1; j = tix - 1; }
            f32x4 a = {0.f, 0.f, 0.f, 0.f};
#pragma unroll
            for (int ks = 0; ks < 4; ++ks) {
                const bf16x8 af = *(const LAS bf16x8*)(qt + (16 * i + fr) * 136 + ks * 32 + 8 * fq);
                const bf16x8 bf = *(const LAS bf16x8*)(kt + (kt_row0(i) + 16 * j + fr) * 136 + ks * 32 + 8 * fq);
                a = __builtin_amdgcn_mfma_f32_16x16x32_bf16(af, bf, a, 0, 0, 0);
            }
#pragma unroll
            for (int q = 0; q < 4; ++q) {
                const int tq = fq * 4 + q;
                const float v = (j < i || fr <= tq) ? a[q] : 0.f;
                att[(16 * i + tq) * 72 + 16 * j + fr] = f2bf(v);
            }
        }
    }
    __syncthreads();
    {
        f32x4 oi[4];
#pragma unroll
        for (int m = 0; m < 4; ++m) oi[m] = (f32x4){0.f, 0.f, 0.f, 0.f};
#pragma unroll
        for (int ks = 0; ks < 2; ++ks) {
            const bf16x8 bv = *(const LAS bf16x8*)(vt + (wave * 16 + fr) * 72 + (((ks * 4 + fq) ^ (((wave * 16 + fr) >> 3) & 7)) << 3));
#pragma unroll
            for (int m = 0; m < 4; ++m) { const bf16x8 af = *(const LAS bf16x8*)(att + (m * 16 + fr) * 72 + ks * 32 + 8 * fq); oi[m] = __builtin_amdgcn_mfma_f32_16x16x32_bf16(bv, af, oi[m], 0, 0, 0); }
        }
        bf16_t* oint = (bf16_t*)(ws + V_OINTRA);
#pragma unroll
        for (int m = 0; m < 4; ++m) { u32x2 w; w[0] = cvt_pk_bf16(oi[m][0], oi[m][1]); w[1] = cvt_pk_bf16(oi[m][2], oi[m][3]);
            *(u32x2*)(oint + (size_t)(t0 + m * 16 + fr) * 2048 + col0 + wave * 16 + fq * 4) = w; }
        f32x4 kvv[8];
#pragma unroll
        for (int n = 0; n < 8; ++n) kvv[n] = (f32x4){0.f, 0.f, 0.f, 0.f};
#pragma unroll
        for (int ks = 0; ks < 2; ++ks) {
            const bf16x8 af = *(const LAS bf16x8*)(vt + (wave * 16 + fr) * 72 + (((ks * 4 + fq) ^ (((wave * 16 + fr) >> 3) & 7)) << 3));
#pragma unroll
            for (int n = 0; n < 8; ++n) { const int dr = (fr >> 2) * 32 + n * 4 + (fr & 3); const bf16x8 bf = *(const LAS bf16x8*)(kh + dr * 72 + (((ks * 4 + fq) ^ ((dr >> 3) & 7)) << 3)); kvv[n] = __builtin_amdgcn_mfma_f32_16x16x32_bf16(bf, af, kvv[n], 0, 0, 0); }
        }
        bf16_t* st = (bf16_t*)(ws + V_ST) + ((size_t)c * 16 + h) * 16384 + (wave * 16 + fr) * 128 + fq * 32;
#pragma unroll
        for (int g = 0; g < 4; ++g) { u32x4 w; w[0] = cvt_pk_bf16(kvv[2 * g][0], kvv[2 * g][1]); w[1] = cvt_pk_bf16(kvv[2 * g][2], kvv[2 * g][3]);
            w[2] = cvt_pk_bf16(kvv[2 * g + 1][0], kvv[2 * g + 1][1]); w[3] = cvt_pk_bf16(kvv[2 * g + 1][2], kvv[2 * g + 1][3]); *(u32x4*)(st + g * 8) = w; }
    }
    __syncthreads();
}

__device__ __forceinline__ void hgrn_local_phase(const Params& p, LAS uchar* lds) {
    const int tid = tid_opaque();
    HlPre pre;
    int u = blockIdx.x;
    if (u < 2048) hl_load(pre, p.ws, u, tid);
    for (; u < 2048; u += gridDim.x) hgrn_local_unit(p, lds, u, u + (int)gridDim.x, pre, tid);
}

__device__ __forceinline__ void hgrn_scan(const Params& p) {
    uchar* ws = p.ws;
    const int gt = blockIdx.x * NTHREADS + tid_opaque(), nthr = gridDim.x * NTHREADS;
    for (int idx = gt; idx < 16 * 128 * 64; idx += nthr) {
        const int h = idx >> 13, e = (idx >> 6) & 127, d = (idx & 63) * 2;
        const bf16_t* st = (const bf16_t*)(ws + V_ST) + (size_t)h * 16384 + e * 128 + d;
        unsigned* sb = (unsigned*)((bf16_t*)(ws + V_SB) + (size_t)h * 16384 + e * 128 + d);
        const float* dec = (const float*)(ws + V_DEC) + h * 128 + d;
        float s0 = 0.f, s1 = 0.f;
#pragma unroll 32
        for (int c = 0; c < 128; ++c) {
            const unsigned kv = *(const unsigned*)(st + (size_t)c * 16 * 16384); const float2 dc = *(const float2*)(dec + (size_t)c * 16 * 128);
            sb[(size_t)c * 16 * 8192] = cvt_pk_bf16(s0, s1);
            s0 = dc.x * s0 + bf_lo(kv); s1 = dc.y * s1 + bf_hi(kv);
        }
    }
}

struct HoStage { bf16x8 af[2]; bf16x8 bf[8]; };
__device__ __forceinline__ void hgrn_out_phase(const Params& p) {
    const int tid = tid_opaque(), lane = tid & 63, wave = tid >> 6, fr = lane & 15, fq = lane >> 4;
    uchar* ws = p.ws;
    const bf16_t* qh = (const bf16_t*)(ws + V_QHAT);
    const bf16_t* oint = (const bf16_t*)(ws + V_OINTRA);
    const bf16_t* gs = (const bf16_t*)(ws + V_GS); bf16_t* out = (bf16_t*)(ws + V_HGO);
    const int erow = (fr >> 2) * 32 + (fr & 3);
    for (int u = blockIdx.x * NWAVES + wave; u < 2048; u += gridDim.x * NWAVES) {
        const int h = u & 15, c = u >> 4, t0 = c * 64, col0 = h * 128;
        const bf16_t* sb = (const bf16_t*)(ws + V_SB) + ((size_t)c * 16 + h) * 16384;
#define HO_LOAD(S, MH, KS) do { _Pragma("unroll") for (int m = 0; m < 2; ++m) S.af[m] = *(const bf16x8*)(qh + (size_t)(t0 + ((MH) * 2 + m) * 16 + fr) * 2048 + col0 + (KS) * 32 + 8 * fq); \
            _Pragma("unroll") for (int n = 0; n < 8; ++n) S.bf[n] = *(const bf16x8*)(sb + (erow + 4 * n) * 128 + (KS) * 32 + 8 * fq); } while (0)
#define HO_MMA(S) do { _Pragma("unroll") for (int n = 0; n < 8; ++n) _Pragma("unroll") for (int m = 0; m < 2; ++m) o[m][n] = __builtin_amdgcn_mfma_f32_16x16x32_bf16(S.bf[n], S.af[m], o[m][n], 0, 0, 0); } while (0)
        HoStage s0, s1;
        HO_LOAD(s0, 0, 0);
#pragma unroll
        for (int mh = 0; mh < 2; ++mh) {
            f32x4 o[2][8];
#pragma unroll
            for (int m = 0; m < 2; ++m)
#pragma unroll
                for (int n = 0; n < 8; ++n) o[m][n] = (f32x4){0.f, 0.f, 0.f, 0.f};
            HO_LOAD(s1, mh, 1); HO_MMA(s0); __builtin_amdgcn_sched_barrier(0);
            HO_LOAD(s0, mh, 2); HO_MMA(s1); __builtin_amdgcn_sched_barrier(0);
            HO_LOAD(s1, mh, 3); HO_MMA(s0); __builtin_amdgcn_sched_barrier(0);
            u32x4 oi[4], gv[4];
            const size_t rb0 = (size_t)(t0 + (mh * 2) * 16 + fr) * 2048 + col0 + fq * 32;
#pragma unroll
            for (int g = 0; g < 4; ++g) { oi[g] = *(const u32x4*)(oint + rb0 + g * 8); gv[g] = *(const u32x4*)(gs + rb0 + g * 8); }
            if (mh == 0) HO_LOAD(s0, 1, 0);
            HO_MMA(s1); __builtin_amdgcn_sched_barrier(0);
            f32x4 ng[8];
#pragma unroll
            for (int n = 0; n < 8; ++n) ng[n] = *(const f32x4*)(p.in[I_HNG] + col0 + fq * 32 + n * 4);
#pragma unroll
            for (int m = 0; m < 2; ++m) {
                const size_t rb = (size_t)(t0 + (mh * 2 + m) * 16 + fr) * 2048 + col0 + fq * 32;
                if (m == 1) {
#pragma unroll
                    for (int g = 0; g < 4; ++g) { oi[g] = *(const u32x4*)(oint + rb + g * 8); gv[g] = *(const u32x4*)(gs + rb + g * 8); }
                }
                float ss = 0.f;
#pragma unroll
                for (int n = 0; n < 8; ++n) { const unsigned w0 = oi[n >> 1][(n & 1) * 2], w1 = oi[n >> 1][(n & 1) * 2 + 1];
                    f32x4 v = o[m][n]; v[0] += bf_lo(w0); v[1] += bf_hi(w0); v[2] += bf_lo(w1); v[3] += bf_hi(w1);
                    o[m][n] = v; ss += v[0] * v[0] + v[1] * v[1] + v[2] * v[2] + v[3] * v[3]; }
                ss += __shfl_xor(ss, 16); ss += __shfl_xor(ss, 32);
                const float inv = rsqrtf(ss * (1.0f / 128.0f) + 1e-6f);
#pragma unroll
                for (int g = 0; g < 4; ++g) { u32x4 w;
#pragma unroll
                    for (int hf = 0; hf < 2; ++hf) { const int n = 2 * g + hf; const unsigned g0 = gv[g][hf * 2], g1 = gv[g][hf * 2 + 1]; const f32x4 v = o[m][n] * inv * ng[n];
                        w[hf * 2] = cvt_pk_bf16(v[0] * bf_lo(g0), v[1] * bf_hi(g0)); w[hf * 2 + 1] = cvt_pk_bf16(v[2] * bf_lo(g1), v[3] * bf_hi(g1)); }
                    *(u32x4*)(out + rb + g * 8) = w; }
            }
        }
#undef HO_LOAD
#undef HO_MMA
    }
}
__device__ __forceinline__ void moe_route(const Params& p, int layer) {
    uchar* ws = p.ws;
    const float* logit = (const float*)(ws + WS_LOGIT);
    const float* bg = p.in[I_MBGRP] + layer * 8; const float* be = p.in[I_MBEXP] + layer * 64;
    unsigned* cnt = (unsigned*)(ws + WS_CTL + CTL_CNT_OFF) + layer * 64;
    int* toke = (int*)(ws + WS_TOKE); int* tokpos = (int*)(ws + WS_TOKPOS); float* tokw = (float*)(ws + WS_TOKW); int* etok = (int*)(ws + WS_ETOK);
    for (int t = blockIdx.x * NTHREADS + tid_opaque(); t < T; t += gridDim.x * NTHREADS) {
        const float* lr = logit + (size_t)t * LOGIT_LD;
        float gl[8]; float gm = -INFINITY; int grp = 0;
#pragma unroll
        for (int i = 0; i < 8; ++i) { float a = bg[i];
#pragma unroll
            for (int ks = 0; ks < 8; ++ks) a += lr[(size_t)ks * T * LOGIT_LD + i];
            gl[i] = a; if (a > gm) { gm = a; grp = i; } }
        float den = 0.f;
#pragma unroll
        for (int i = 0; i < 8; ++i) den += __expf(gl[i] - gm);
        const float pg = 1.0f / den;
        float v0 = -INFINITY, v1 = -INFINITY; int i0 = 0, i1 = 0;
#pragma unroll
        for (int i = 0; i < 8; ++i) {
            float v = be[grp * 8 + i];
#pragma unroll
            for (int ks = 0; ks < 8; ++ks) v += lr[(size_t)ks * T * LOGIT_LD + 8 + grp * 8 + i];
            if (v > v0) { v1 = v0; i1 = i0; v0 = v; i0 = i; } else if (v > v1) { v1 = v; i1 = i; }
        }
        const float e0 = 1.0f / (1.0f + __expf(v1 - v0));
        const int ea = grp * 8 + i0, eb = grp * 8 + i1;
        const int pa = (int)atomicAdd(cnt + ea, 1u), pb = (int)atomicAdd(cnt + eb, 1u);
        toke[2 * t] = ea; toke[2 * t + 1] = eb; tokpos[2 * t] = pa; tokpos[2 * t + 1] = pb; tokw[2 * t] = pg * e0; tokw[2 * t + 1] = pg * (1.0f - e0);
        etok[(size_t)ea * T + pa] = t; etok[(size_t)eb * T + pb] = t;
    }
}
constexpr int NR_PITCH = 4112;
__device__ __forceinline__ void moe_norm_route(const Params& p, LAS uchar* lds, int layer) {
    uchar* ws = p.ws;
    const int tid = tid_opaque(), lane = tid & 63, wave = tid >> 6, fr = lane & 15, fq = lane >> 4;
    const float* mod = (const float*)(ws + WS_MOD) + layer * 12288;
    const float* gain = p.in[I_NFG] + layer * 2048; const float* sh = mod + 3 * 2048; const float* sc = mod + 4 * 2048;
    const bf16_t* xa = (const bf16_t*)(ws + WS_XA); bf16_t* hf = (bf16_t*)(ws + WS_HMIX);
    const bf16_t* RT = (const bf16_t*)(ws + WS_ROUTET) + (size_t)layer * 256 * 2048;
    const float* bg = p.in[I_MBGRP] + layer * 8; const float* be = p.in[I_MBEXP] + layer * 64;
    unsigned* cnt = (unsigned*)(ws + WS_CTL + CTL_CNT_OFF) + layer * 64;
    int* toke = (int*)(ws + WS_TOKE); int* tokpos = (int*)(ws + WS_TOKPOS); float* tokw = (float*)(ws + WS_TOKW); int* etok = (int*)(ws + WS_ETOK);
    LAS float* rb = (LAS float*)(lds + 32 * NR_PITCH);
    if (tid < 8) rb[tid] = bg[tid]; else if (tid < 72) rb[tid] = be[tid - 8];
    LAS float* red = (LAS float*)lds;
    for (int rg = blockIdx.x; rg < T / 32; rg += gridDim.x) {
        const int row0 = rg * 32;
        for (int k = 0; k < 4; ++k) {
            const int rl = wave * 4 + k, r = row0 + rl;
            f32x4 v[8];
#pragma unroll
            for (int i = 0; i < 8; ++i) { const u32x2 w = *(const u32x2*)(xa + (size_t)r * D + (i * 64 + lane) * 4); v[i] = (f32x4){bf_lo(w[0]), bf_hi(w[0]), bf_lo(w[1]), bf_hi(w[1])}; }
            float ss = 0.f;
#pragma unroll
            for (int i = 0; i < 8; ++i) ss += v[i][0] * v[i][0] + v[i][1] * v[i][1] + v[i][2] * v[i][2] + v[i][3] * v[i][3];
            ss = wave_sum(ss);
            const float inv = rsqrtf(ss * (1.0f / D) + 1e-6f);
#pragma unroll
            for (int i = 0; i < 8; ++i) {
                const int c = (i * 64 + lane) * 4;
                const f32x4 g = *(const f32x4*)(gain + c), s1 = *(const f32x4*)(sc + c), s0 = *(const f32x4*)(sh + c);
                f32x4 y; y[0] = v[i][0] * inv * g[0]; y[1] = v[i][1] * inv * g[1]; y[2] = v[i][2] * inv * g[2]; y[3] = v[i][3] * inv * g[3];
                u32x2 o; o[0] = cvt_pk_bf16(y[0] * (1.0f + s1[0]) + s0[0], y[1] * (1.0f + s1[1]) + s0[1]); o[1] = cvt_pk_bf16(y[2] * (1.0f + s1[2]) + s0[2], y[3] * (1.0f + s1[3]) + s0[3]);
                *(u32x2*)(hf + (size_t)r * D + c) = o;
                *(LAS u32x2*)(lds + rl * NR_PITCH + c * 2) = o;
            }
        }
        __syncthreads();
        f32x4 acc[2][5];
#pragma unroll
        for (int m = 0; m < 2; ++m)
#pragma unroll
            for (int n = 0; n < 5; ++n) acc[m][n] = (f32x4){0.f, 0.f, 0.f, 0.f};
#pragma unroll
        for (int ks = 0; ks < 8; ks += 2) {
            bf16x8 b[2][5];
#pragma unroll
            for (int kk = 0; kk < 2; ++kk)
#pragma unroll
                for (int n = 0; n < 5; ++n) b[kk][n] = *(const bf16x8*)(RT + (size_t)(n * 16 + fr) * 2048 + wave * 256 + (ks + kk) * 32 + 8 * fq);
#pragma unroll
            for (int kk = 0; kk < 2; ++kk)
#pragma unroll
                for (int m = 0; m < 2; ++m) {
                    const bf16x8 a = *(const LAS bf16x8*)(lds + (m * 16 + fr) * NR_PITCH + (wave * 256 + (ks + kk) * 32 + 8 * fq) * 2);
#pragma unroll
                    for (int n = 0; n < 5; ++n) acc[m][n] = __builtin_amdgcn_mfma_f32_16x16x32_bf16(a, b[kk][n], acc[m][n], 0, 0, 0);
                }
        }
        __syncthreads();
#pragma unroll
        for (int m = 0; m < 2; ++m)
#pragma unroll
            for (int n = 0; n < 5; ++n)
#pragma unroll
                for (int q = 0; q < 4; ++q) red[(wave * 32 + m * 16 + fq * 4 + q) * 81 + n * 16 + fr] = acc[m][n][q];
        __syncthreads();
        if (tid < 32) {
            const int t = row0 + tid;
            float gl[8]; float gm = -INFINITY; int grp = 0;
#pragma unroll
            for (int i = 0; i < 8; ++i) { float a = rb[i];
#pragma unroll
                for (int ks = 0; ks < 8; ++ks) a += red[(ks * 32 + tid) * 81 + i];
                gl[i] = a; if (a > gm) { gm = a; grp = i; } }
            float den = 0.f;
#pragma unroll
            for (int i = 0; i < 8; ++i) den += __expf(gl[i] - gm);
            const float pg = 1.0f / den;
            float v0 = -INFINITY, v1 = -INFINITY; int i0 = 0, i1 = 0;
#pragma unroll
            for (int i = 0; i < 8; ++i) {
                float v = rb[8 + grp * 8 + i];
#pragma unroll
                for (int ks = 0; ks < 8; ++ks) v += red[(ks * 32 + tid) * 81 + 8 + grp * 8 + i];
                if (v > v0) { v1 = v0; i1 = i0; v0 = v; i0 = i; } else if (v > v1) { v1 = v; i1 = i; }
            }
            const float e0 = 1.0f / (1.0f + __expf(v1 - v0));
            const int ea = grp * 8 + i0, eb = grp * 8 + i1;
            const int pa = (int)atomicAdd(cnt + ea, 1u), pb = (int)atomicAdd(cnt + eb, 1u);
            toke[2 * t] = ea; toke[2 * t + 1] = eb; tokpos[2 * t] = pa; tokpos[2 * t + 1] = pb; tokw[2 * t] = pg * e0; tokw[2 * t + 1] = pg * (1.0f - e0);
            etok[(size_t)ea * T + pa] = t; etok[(size_t)eb * T + pb] = t;
        }
        __syncthreads();
    }
}
__device__ __forceinline__ int moe_tiles(const Params& p, int layer, LAS int* tab  , bool publish) {
    uchar* ws = p.ws;
    const unsigned* cnt = (const unsigned*)(ws + WS_CTL + CTL_CNT_OFF) + layer * 64;
    const int tid = tid_opaque();
    if (tid < 64) {
        const int cn = (int)cnt[tid], n = (cn + 255) >> 8;
        tab[256 + tid] = cn;
        int incl = n;
#pragma unroll
        for (int o = 1; o < 64; o <<= 1) { const int t_ = __shfl_up(incl, o); if (tid >= o) incl += t_; }
        const int first = incl - n;
        tab[128 + tid] = first;
        for (int q = 0; q < n; ++q) tab[first + q] = tid;
        if (tid == 63) tab[192] = incl;
    }
    __syncthreads();
    const int nt = tab[192];
    if (publish && blockIdx.x == 0) { int* g = (int*)(ws + WS_TILEE); for (int i = tid; i < nt; i += NTHREADS) g[i] = tab[i]; if (tid == 0) g[128] = nt; }
    return nt;
}
__device__ __forceinline__ void moe_gather(const Params& p, LAS uchar* lds, int layer) {
    uchar* ws = p.ws;
    LAS int* tab = (LAS int*)lds;
    moe_tiles(p, layer, tab, true);
    const int tid = tid_opaque(), lane = tid & 63, wave = tid >> 6;
    const int* toke = (const int*)(ws + WS_TOKE); const int* tokpos = (const int*)(ws + WS_TOKPOS); int* tokrow = (int*)(ws + WS_TOKROW);
    const bf16_t* h = (const bf16_t*)(ws + WS_HMIX); bf16_t* xg = (bf16_t*)(ws + WS_XG);
    const int stride = gridDim.x * NWAVES;
    for (int a = blockIdx.x * NWAVES + wave; a < 2 * T; a += 4 * stride) {
        int rows[4]; u32x4 v[4][4];
#pragma unroll
        for (int k = 0; k < 4; ++k) { const int ak = a + k * stride; rows[k] = ak < 2 * T ? tab[128 + toke[ak]] * 256 + tokpos[ak] : -1; }
#pragma unroll
        for (int k = 0; k < 4; ++k) { const int ak = a + k * stride; if (rows[k] >= 0) { const u32x4* src = (const u32x4*)(h + (size_t)(ak >> 1) * D);
#pragma unroll
            for (int i = 0; i < 4; ++i) v[k][i] = src[i * 64 + lane]; } }
#pragma unroll
        for (int k = 0; k < 4; ++k) { const int ak = a + k * stride; if (rows[k] >= 0) { if (lane == 0) tokrow[ak] = rows[k]; u32x4* dst = (u32x4*)(xg + (size_t)rows[k] * D);
#pragma unroll
            for (int i = 0; i < 4; ++i) dst[i * 64 + lane] = v[k][i]; } }
    }
    __syncthreads();
}
constexpr int MG_BOFF = 65536;
struct MgRegs { u32x4 a[8]; f32x4 b[8]; };
struct MgSrc { const bf16_t* A; int lda; const float* W0; const float* W1; int ldw, qs; int skip = 0; int valid = 256; unsigned aoff[4]; };

__device__ __forceinline__ void mg_issue(MgRegs& R, const MgSrc& s, int kt, int tid) {
#pragma unroll
    for (int i = 0; i < 8; ++i) { const int id = tid + NTHREADS * i, row = id >> 4, ch = id & 15; R.a[i] = *(const u32x4*)(s.A + (size_t)row * s.lda + kt * 128 + ch * 8); }
    const int kq = tid >> 5, nq = tid & 31, q = nq >> 3;
    const float* w = ((q & 1) ? s.W1 : s.W0) + s.qs * (q >> 1) + 4 * (nq & 7) + (size_t)(kt * 128 + 8 * kq) * s.ldw;
#pragma unroll
    for (int i = 0; i < 8; ++i) R.b[i] = *(const f32x4*)(w + (size_t)i * s.ldw);
}
__device__ __forceinline__ void mg_commit(const MgRegs& R, LAS uchar* stg, int tid) {
#pragma unroll
    for (int i = 0; i < 8; ++i) { const int id = tid + NTHREADS * i, row = id >> 4, ch = id & 15; *(LAS u32x4*)(stg + row * 256 + ((ch ^ (row & 15)) << 4)) = R.a[i]; }
    const int kq = tid >> 5, nq = tid & 31;
#pragma unroll
    for (int j = 0; j < 4; ++j) {
        const int n = 4 * nq + j;
        u32x4 v; v[0] = cvt_pk_bf16(R.b[0][j], R.b[1][j]); v[1] = cvt_pk_bf16(R.b[2][j], R.b[3][j]); v[2] = cvt_pk_bf16(R.b[4][j], R.b[5][j]); v[3] = cvt_pk_bf16(R.b[6][j], R.b[7][j]);
        *(LAS u32x4*)(stg + MG_BOFF + n * 256 + ((kq ^ (n & 15)) << 4)) = v;
    }
}
__device__ __forceinline__ void mg_compute(const LAS uchar* stg, f32x4 (&acc)[4][4], int wr, int wc, int fr, int fq) {
#pragma unroll
    for (int kk = 0; kk < 4; ++kk) {
        bf16x8 af[4], bfr[4];
#pragma unroll
        for (int m = 0; m < 4; ++m) { const int row = wr * 64 + m * 16 + fr; af[m] = *(const LAS bf16x8*)(stg + row * 256 + (((kk * 4 + fq) ^ (row & 15)) << 4)); }
#pragma unroll
        for (int n = 0; n < 4; ++n) { const int row = wc * 64 + n * 16 + fr; bfr[n] = *(const LAS bf16x8*)(stg + MG_BOFF + row * 256 + (((kk * 4 + fq) ^ (row & 15)) << 4)); }
#pragma unroll
        for (int m = 0; m < 4; ++m)
#pragma unroll
            for (int n = 0; n < 4; ++n) acc[m][n] = __builtin_amdgcn_mfma_f32_16x16x32_bf16(bfr[n], af[m], acc[m][n], 0, 0, 0);
    }
}
__device__ __forceinline__ void mg_tile(LAS uchar* lds, const MgSrc& s, int K, f32x4 (&acc)[4][4], int tid) {
    const int lane = tid & 63, wid = tid >> 6, wr = wid >> 1, wc = wid & 1, fr = lane & 15, fq = lane >> 4;
    const int nk = K / 128;
#pragma unroll
    for (int m = 0; m < 4; ++m)
#pragma unroll
        for (int n = 0; n < 4; ++n) acc[m][n] = (f32x4){0.f, 0.f, 0.f, 0.f};
    MgRegs R;
    mg_issue(R, s, 0, tid);
    for (int kt = 0; kt < nk; ++kt) {
        mg_commit(R, lds, tid);
        __syncthreads();
        if (kt + 1 < nk) mg_issue(R, s, kt + 1, tid);
        mg_compute(lds, acc, wr, wc, fr, fq);
        __syncthreads();
    }
}

constexpr int M64_STAGE = 49152;
constexpr int M64_BOFF = 32768;
struct M64Regs { u32x4 a[4]; f32x4 b[4]; };

__device__ __forceinline__ void m64_issue(M64Regs& R, const MgSrc& s, int kt, int tid) {
    if (!(s.skip & 1)) {
#pragma unroll
        for (int i = 0; i < 4; ++i) { const int id = tid + NTHREADS * i, row = id >> 3, ch = id & 7; R.a[i] = *(const u32x4*)(s.A + (size_t)row * s.lda + kt * 64 + ch * 8); }
    } else {
#pragma unroll
        for (int i = 0; i < 4; ++i) R.a[i] = (u32x4){0x3f803f80u, 0x3f803f80u, 0x3f803f80u, 0x3f803f80u};
    }
    const int kq = tid >> 5, nq = tid & 31, q = nq >> 3;
    const float* w = ((q & 1) ? s.W1 : s.W0) + s.qs * (q >> 1) + 4 * (nq & 7) + (size_t)(kt * 64 + 4 * kq) * s.ldw;
    if (!(s.skip & 2)) {
#pragma unroll
        for (int i = 0; i < 4; ++i) R.b[i] = *(const f32x4*)(w + (size_t)i * s.ldw);
    } else {
#pragma unroll
        for (int i = 0; i < 4; ++i) R.b[i] = (f32x4){1.f, 1.f, 1.f, 1.f};
    }
}
__device__ __forceinline__ void m64_commit(const M64Regs& R, LAS uchar* stg, int tid) {
#pragma unroll
    for (int i = 0; i < 4; ++i) { const int id = tid + NTHREADS * i, row = id >> 3, ch = id & 7; *(LAS u32x4*)(stg + row * 128 + ((ch ^ ((row >> 1) & 7)) << 4)) = R.a[i]; }
    const int kq = tid >> 5, nq = tid & 31;
#pragma unroll
    for (int j = 0; j < 4; ++j) {
        const int n = 4 * nq + j;
        u32x2 v; v[0] = cvt_pk_bf16(R.b[0][j], R.b[1][j]); v[1] = cvt_pk_bf16(R.b[2][j], R.b[3][j]);
        *(LAS u32x2*)(stg + M64_BOFF + n * 128 + (((kq >> 1) ^ (((n >> 1) ^ (n >> 4)) & 7)) << 4) + (kq & 1) * 8) = v;
    }
}
__device__ __forceinline__ void m64_compute(const LAS uchar* stg, f32x4 (&acc)[4][4], int wr, int wc, int fr, int fq) {
    bf16x8 af[2][4], bfr[2][4];
#pragma unroll
    for (int kk = 0; kk < 2; ++kk)
#pragma unroll
        for (int n = 0; n < 4; ++n) { const int row = wc * 64 + n * 16 + fr; bfr[kk][n] = *(const LAS bf16x8*)(stg + M64_BOFF + row * 128 + (((kk * 4 + fq) ^ (((row >> 1) ^ (row >> 4)) & 7)) << 4)); }
#pragma unroll
    for (int kk = 0; kk < 2; ++kk)
#pragma unroll
        for (int m = 0; m < 4; ++m) { const int row = wr * 64 + m * 16 + fr; af[kk][m] = *(const LAS bf16x8*)(stg + row * 128 + (((kk * 4 + fq) ^ ((row >> 1) & 7)) << 4)); }
#pragma unroll
    for (int kk = 0; kk < 2; ++kk)
#pragma unroll
        for (int m = 0; m < 4; ++m)
#pragma unroll
            for (int n = 0; n < 4; ++n) acc[m][n] = __builtin_amdgcn_mfma_f32_16x16x32_bf16(bfr[kk][n], af[kk][m], acc[m][n], 0, 0, 0);
}
__device__ __forceinline__ void m64_tile(LAS uchar* lds, const MgSrc& s, int K, f32x4 (&acc)[4][4], int tid) {
    const int lane = tid & 63, wid = tid >> 6, wr = wid >> 1, wc = wid & 1, fr = lane & 15, fq = lane >> 4;
    const int nk = K / 64;
#pragma unroll
    for (int m = 0; m < 4; ++m)
#pragma unroll
        for (int n = 0; n < 4; ++n) acc[m][n] = (f32x4){0.f, 0.f, 0.f, 0.f};
    M64Regs R0, R1;
    m64_issue(R0, s, 0, tid); m64_issue(R1, s, 1, tid);
    m64_commit(R0, lds, tid);
    __syncthreads();
    for (int kt = 0; kt < nk; kt += 2) {
        if (kt + 2 < nk) m64_issue(R0, s, kt + 2, tid);
        m64_compute(lds, acc, wr, wc, fr, fq);
        m64_commit(R1, lds + M64_STAGE, tid);
        __syncthreads();
        if (kt + 3 < nk) m64_issue(R1, s, kt + 3, tid);
        m64_compute(lds + M64_STAGE, acc, wr, wc, fr, fq);
        if (kt + 2 < nk) m64_commit(R0, lds, tid);
        __syncthreads();
    }
}


struct MaRegs { u32x4 a[4]; u32x4 b[4]; };
#define MA_LOAD(dst, ptr) asm volatile("global_load_dwordx4 %0, %1, off" : "=&v"(dst) : "v"(ptr) : "memory")
#define MA_LOAD_NT(dst, ptr) asm volatile("global_load_dwordx4 %0, %1, off nt" : "=&v"(dst) : "v"(ptr) : "memory")
#define MA_WAIT(R, n) asm volatile("s_waitcnt vmcnt(" #n ")" : "+v"(R.a[0]), "+v"(R.a[1]), "+v"(R.a[2]), "+v"(R.a[3]), "+v"(R.b[0]), "+v"(R.b[1]), "+v"(R.b[2]), "+v"(R.b[3]) :: "memory")
__device__ __forceinline__ void ma_issue(MaRegs& R, const MgSrc& s, int kt, int tid) {
#pragma unroll
    for (int i = 0; i < 4; ++i) { const int ch = tid & 7; const bf16_t* ptr = (const bf16_t*)((const char*)s.A + s.aoff[i]) + kt * 64 + ch * 8; MA_LOAD(R.a[i], ptr); }
    const int kq = tid >> 5, nq = tid & 31, q = nq >> 3;
    const float* w = ((q & 1) ? s.W1 : s.W0) + s.qs * (q >> 1) + 4 * (nq & 7) + (size_t)(kt * 64 + 4 * kq) * s.ldw;
#pragma unroll
    for (int i = 0; i < 4; ++i) { const float* ptr = w + (size_t)i * s.ldw; MA_LOAD(R.b[i], ptr); }
}
__device__ __forceinline__ void ma_commit(const MaRegs& R, LAS uchar* stg, int tid) {
#pragma unroll
    for (int i = 0; i < 4; ++i) { const int id = tid + NTHREADS * i, row = id >> 3, ch = id & 7; *(LAS u32x4*)(stg + row * 128 + ((ch ^ ((row >> 1) & 7)) << 4)) = R.a[i]; }
    const int kq = tid >> 5, nq = tid & 31;
#pragma unroll
    for (int j = 0; j < 4; ++j) {
        const int n = 4 * nq + j;
        u32x2 v; v[0] = cvt_pk_bf16(__uint_as_float(R.b[0][j]), __uint_as_float(R.b[1][j])); v[1] = cvt_pk_bf16(__uint_as_float(R.b[2][j]), __uint_as_float(R.b[3][j]));
        *(LAS u32x2*)(stg + M64_BOFF + n * 128 + (((kq >> 1) ^ (((n >> 1) ^ (n >> 4)) & 7)) << 4) + (kq & 1) * 8) = v;
    }
}
template <int NK>
__device__ __forceinline__ void ma_tile(LAS uchar* lds, const MgSrc& s, f32x4 (&acc)[4][4], int tid) {
    const int lane = tid & 63, wid = tid >> 6, wr = wid >> 1, wc = wid & 1, fr = lane & 15, fq = lane >> 4;
#pragma unroll
    for (int m = 0; m < 4; ++m)
#pragma unroll
        for (int n = 0; n < 4; ++n) acc[m][n] = (f32x4){0.f, 0.f, 0.f, 0.f};
    MaRegs R0, R1;
    ma_issue(R0, s, 0, tid); ma_issue(R1, s, 1, tid);
    MA_WAIT(R0, 8);
    ma_commit(R0, lds, tid);
    __syncthreads();
#pragma unroll 1
    for (int kt = 0; kt < NK - 2; kt += 2) {
        ma_issue(R0, s, kt + 2, tid);
        m64_compute(lds, acc, wr, wc, fr, fq);
        MA_WAIT(R1, 8);
        ma_commit(R1, lds + M64_STAGE, tid);
        __syncthreads();
        ma_issue(R1, s, kt + 3, tid);
        m64_compute(lds + M64_STAGE, acc, wr, wc, fr, fq);
        MA_WAIT(R0, 8);
        ma_commit(R0, lds, tid);
        __syncthreads();
    }
    {
        m64_compute(lds, acc, wr, wc, fr, fq);
        MA_WAIT(R1, 0);
        ma_commit(R1, lds + M64_STAGE, tid);
        __syncthreads();
        m64_compute(lds + M64_STAGE, acc, wr, wc, fr, fq);
        __syncthreads();
    }
    return;
#pragma unroll
    for (int kt = 0; kt < 0; kt += 2) {
        if (kt + 2 < NK) ma_issue(R0, s, kt + 2, tid);
        m64_compute(lds, acc, wr, wc, fr, fq);
        if (kt + 2 < NK) { MA_WAIT(R1, 8); } else { MA_WAIT(R1, 0); }
        ma_commit(R1, lds + M64_STAGE, tid);
        __syncthreads();
        if (kt + 3 < NK) ma_issue(R1, s, kt + 3, tid);
        m64_compute(lds + M64_STAGE, acc, wr, wc, fr, fq);
        if (kt + 2 < NK) {
            if (kt + 3 < NK) { MA_WAIT(R0, 8); } else { MA_WAIT(R0, 0); }
            ma_commit(R0, lds, tid);
        }
        __syncthreads();
    }
}

#ifndef MG2_WS
#define MG2_WS 1
#endif
#ifndef MG1_BK
#define MG1_BK 1
#endif
#ifndef MG2_BK
#define MG2_BK 64
#endif
__device__ __forceinline__ void moe_gemm1(const Params& p, LAS uchar* lds, int layer) {
    uchar* ws = p.ws;
    LAS int* tab = (LAS int*)(lds + 131072);
    const int nt = moe_tiles(p, layer, tab, false);
    const int tid = tid_opaque(), lane = tid & 63, wid = tid >> 6, wr = wid >> 1, wc = wid & 1, fr = lane & 15, fq = lane >> 4;
    bf16_t* hid = (bf16_t*)(ws + WS_HID);
    {
        const int* toke = (const int*)(ws + WS_TOKE); const int* tokpos = (const int*)(ws + WS_TOKPOS); int* tokrow = (int*)(ws + WS_TOKROW);
        for (int a = blockIdx.x * NTHREADS + tid; a < 2 * T; a += gridDim.x * NTHREADS) tokrow[a] = tab[128 + toke[a]] * 256 + tokpos[a];
    }
    const bool xg = (gridDim.x & 63) == 0; const int bx = blockIdx.x, sl = bx >> 3, tpr = gridDim.x >> 3;
    for (int L = xg ? ((bx & 7) * (tpr >> 3) + (sl >> 3)) * 8 + (sl & 7) : bx; L < nt * 8; L += xg ? tpr * 8 : gridDim.x) {
        const int tile = L >> 3, nu = L & 7, e = __builtin_amdgcn_readfirstlane(tab[tile]);
        MgSrc s; s.A = (const bf16_t*)(ws + WS_HMIX); s.lda = 2048; s.ldw = 512; s.qs = 32;
        { const int jt = tile - __builtin_amdgcn_readfirstlane(tab[128 + e]), left = __builtin_amdgcn_readfirstlane(tab[256 + e]) - jt * 256; s.valid = left < 256 ? left : 256;
          const int* et = (const int*)(ws + WS_ETOK) + (size_t)e * T + jt * 256;
#pragma unroll
          for (int i = 0; i < 4; ++i) { const int row = (tid >> 3) + 64 * i; s.aoff[i] = (unsigned)et[row < s.valid ? row : 0] * 4096u; } }
        s.W0 = p.in[I_MWG] + (size_t)(layer * 64 + e) * 2048 * 512 + nu * 64; s.W1 = p.in[I_MWU] + (size_t)(layer * 64 + e) * 2048 * 512 + nu * 64;
        f32x4 acc[4][4];
#if MG1_BK == 128
        mg_tile(lds, s, 2048, acc, tid);
#elif MG1_BK == 64
        m64_tile(lds, s, 2048, acc, tid);
#else
        ma_tile<32>(lds, s, acc, tid);
#endif
#pragma unroll
        for (int m = 0; m < 4; ++m) {
            if (wr * 64 + m * 16 + fr >= s.valid) continue;
            bf16_t* rowp = hid + (size_t)(tile * 256 + wr * 64 + m * 16 + fr) * 512 + nu * 64 + wc * 32 + 4 * fq;
#pragma unroll
            for (int n = 0; n < 2; ++n) { const f32x4 a = acc[m][n], b = acc[m][n + 2];
                u32x2 o; o[0] = cvt_pk_bf16(siluf_(a[0]) * b[0], siluf_(a[1]) * b[1]); o[1] = cvt_pk_bf16(siluf_(a[2]) * b[2], siluf_(a[3]) * b[3]); *(u32x2*)(rowp + n * 16) = o; }
        }
    }
}
template <int VAR> __device__ __forceinline__ void moe_gemm2v(const Params& p, LAS uchar* lds, int layer, bf16_t* yb) {
    uchar* ws = p.ws;
    LAS int* tab = (LAS int*)(lds + 131072);
    const int nt = moe_tiles(p, layer, tab, false);
    const int tid = tid_opaque(), lane = tid & 63, wid = tid >> 6, wr = wid >> 1, wc = wid & 1, fr = lane & 15, fq = lane >> 4;
    const bool xg = (gridDim.x & 127) == 0; const int bx = blockIdx.x, sl = bx >> 3, tpr = gridDim.x >> 4;
    for (int L = xg ? ((bx & 7) * (tpr >> 3) + (sl >> 4)) * 16 + (sl & 15) : bx; L < nt * 16; L += xg ? tpr * 16 : gridDim.x) {
        const int tile = L >> 4, nu = L & 15, e = __builtin_amdgcn_readfirstlane(tab[tile]);
        MgSrc s; s.A = (const bf16_t*)(ws + WS_HID) + (size_t)tile * 256 * 512; s.lda = 512; s.ldw = 2048; s.qs = 64; s.skip = (VAR == 65) ? 1 : (VAR == 66) ? 2 : 0;
#pragma unroll
        for (int i = 0; i < 4; ++i) s.aoff[i] = (unsigned)((tid >> 3) + 64 * i) * 1024u;
        s.W0 = p.in[I_MWD] + (size_t)(layer * 64 + e) * 512 * 2048 + nu * 128; s.W1 = s.W0 + 32;
        f32x4 acc[4][4];
        if (VAR == 128) mg_tile(lds, s, 512, acc, tid); else if (VAR >= 64 && VAR <= 66) m64_tile(lds, s, 512, acc, tid); else ma_tile<8>(lds, s, acc, tid);
#pragma unroll
        for (int m = 0; m < 4; ++m) {
            bf16_t* rowp = yb + (size_t)(tile * 256 + wr * 64 + m * 16 + fr) * 2048 + nu * 128 + wc * 64 + 4 * fq;
#pragma unroll
            for (int n = 0; n < 4; ++n) { const f32x4 v = acc[m][n]; u32x2 o; o[0] = cvt_pk_bf16(v[0], v[1]); o[1] = cvt_pk_bf16(v[2], v[3]); *(u32x2*)(rowp + n * 16) = o; }
        }
    }
}

constexpr int WS2_PITCH = 1040;
constexpr int WS2_TAB = 139264;
template <int DBG> __device__ __forceinline__ void moe_gemm2_wsv(const Params& p, LAS uchar* lds, int layer, bf16_t* yb, const XcdBarrier& gbar, bool do_gbar) {
    uchar* ws = p.ws;
    LAS int* tab = (LAS int*)(lds + WS2_TAB);
    (void)moe_tiles(p, layer, tab, false);
    const int tid = tid_opaque(), lane = tid & 63, wave = tid >> 6, fr = lane & 15, fq = lane >> 4;
    const unsigned* cnt = (const unsigned*)(ws + WS_CTL + CTL_CNT_OFF) + layer * 64;
    const bf16_t* hid = (const bf16_t*)(ws + WS_HID);
    const int kq = tid >> 5, nq = tid & 31;
    LAS uchar* wbase = lds + nq * (4 * WS2_PITCH) + kq * 8;
    const LAS uchar* rbase = lds + fr * WS2_PITCH + fq * 16;
    bool synced = false;
    for (int L = blockIdx.x; L < 64 * 16; L += gridDim.x) {
        const int e = L >> 4, nu = L & 15;
        const int count = __builtin_amdgcn_readfirstlane(tab[256 + e]), r0 = __builtin_amdgcn_readfirstlane(tab[128 + e]) * 256;
        if (count == 0) continue;
        const float* W = p.in[I_MWD] + (size_t)(layer * 64 + e) * 512 * 2048 + nu * 128 + (size_t)(4 * kq) * 2048 + 4 * nq;
#pragma unroll 1
        for (int half = 0; half < 2; ++half) {
            f32x4 b[4][4];
#pragma unroll
            for (int t4 = 0; t4 < 4; ++t4)
#pragma unroll
                for (int i = 0; i < 4; ++i) b[t4][i] = (DBG == 1) ? (f32x4){1.f, 1.f, 1.f, 1.f} : *(const f32x4*)(W + (size_t)((half * 4 + t4) * 64 + i) * 2048);
#pragma unroll
            for (int t4 = 0; t4 < 4; ++t4)
#pragma unroll
                for (int j = 0; j < 4; ++j) {
                    u32x2 v; v[0] = cvt_pk_bf16(b[t4][0][j], b[t4][1][j]); v[1] = cvt_pk_bf16(b[t4][2][j], b[t4][3][j]);
                    *(LAS u32x2*)(wbase + j * WS2_PITCH + (half * 4 + t4) * 128) = v;
                }
        }
        __syncthreads();
        if (!synced) { if (do_gbar) xcd_barrier(gbar); synced = true; }
        const int mtiles = (DBG == 2) ? 0 : ((count + 15) >> 4);
        for (int mt = wave; mt < mtiles; mt += NWAVES) {
            const bf16_t* arow = hid + (size_t)(r0 + mt * 16 + fr) * 512 + 8 * fq;
            bf16x8 af[16];
#pragma unroll
            for (int ks = 0; ks < 16; ++ks) af[ks] = *(const bf16x8*)(arow + ks * 32);
            f32x4 acc[8];
#pragma unroll
            for (int n = 0; n < 8; ++n) acc[n] = (f32x4){0.f, 0.f, 0.f, 0.f};
#pragma unroll
            for (int ks = 0; ks < 16; ++ks) {
#pragma unroll
                for (int n = 0; n < 8; ++n) {
                    const bf16x8 bf = *(const LAS bf16x8*)(rbase + n * (16 * WS2_PITCH) + ks * 64);
                    acc[n] = __builtin_amdgcn_mfma_f32_16x16x32_bf16(bf, af[ks], acc[n], 0, 0, 0);
                }
                if (ks & 1) __builtin_amdgcn_sched_barrier(0);
            }
            bf16_t* orow = yb + (size_t)(r0 + mt * 16 + fr) * 2048 + nu * 128 + 4 * fq;
#pragma unroll
            for (int n = 0; n < 8; ++n) { u32x2 o; o[0] = cvt_pk_bf16(acc[n][0], acc[n][1]); o[1] = cvt_pk_bf16(acc[n][2], acc[n][3]); *(u32x2*)(orow + n * 16) = o; }
        }
        __syncthreads();
    }
    if (!synced && do_gbar) xcd_barrier(gbar);
}

struct Ws2Unit { int e, nu, count, r0; };
__device__ __forceinline__ bool ws2_find(int& L, int step, const unsigned* cnt, const LAS int* tab, Ws2Unit& u) {
    for (; L < 64 * 16; L += step) { const int e = L >> 4, c = __builtin_amdgcn_readfirstlane((int)cnt[e]); if (c > 0) { u.e = e; u.nu = L & 15; u.count = c; u.r0 = __builtin_amdgcn_readfirstlane(tab[128 + e]) * 256; return true; } }
    return false;
}
__device__ __forceinline__ void ws2_load_w(f32x4 (&b)[2][4], const float* W, int q) {
#pragma unroll
    for (int t2 = 0; t2 < 2; ++t2)
#pragma unroll
        for (int i = 0; i < 4; ++i) b[t2][i] = *(const f32x4*)(W + (size_t)((2 * q + t2) * 64 + i) * 2048);
}
__device__ __forceinline__ void ws2_load_a(bf16x8 (&a)[2][4], const bf16_t* hid, const Ws2Unit& u, int q, int wave, int fr, int fq) {
    const int mtiles = (u.count + 15) >> 4;
#pragma unroll
    for (int t = 0; t < 2; ++t) {
        const int mt = wave + 8 * t < mtiles ? wave + 8 * t : 0;
        const bf16_t* arow = hid + (size_t)(u.r0 + mt * 16 + fr) * 512 + q * 128 + 8 * fq;
#pragma unroll
        for (int kk = 0; kk < 4; ++kk) a[t][kk] = *(const bf16x8*)(arow + kk * 32);
    }
}
__device__ __forceinline__ void moe_gemm2_wsp(const Params& p, LAS uchar* lds, int layer) {
    uchar* ws = p.ws;
    LAS int* tab = (LAS int*)(lds + WS2_TAB);
    (void)moe_tiles(p, layer, tab, false);
    const int tid = tid_opaque(), lane = tid & 63, wave = tid >> 6, fr = lane & 15, fq = lane >> 4;
    const unsigned* cnt = (const unsigned*)(ws + WS_CTL + CTL_CNT_OFF) + layer * 64;
    const bf16_t* hid = (const bf16_t*)(ws + WS_HID); bf16_t* yb = (bf16_t*)(ws + WS_YB);
    const int kq = tid >> 5, nq = tid & 31, G = gridDim.x;
    LAS uchar* wbase = lds + nq * (4 * WS2_PITCH) + kq * 8;
    const LAS uchar* rbase = lds + fr * WS2_PITCH + fq * 16;
    const float* Wall = p.in[I_MWD] + (size_t)layer * 64 * 512 * 2048 + (size_t)(4 * kq) * 2048 + 4 * nq;
    int L = blockIdx.x; Ws2Unit U, Un;
    if (!ws2_find(L, G, cnt, tab, U)) return;
    f32x4 breg[2][4]; bf16x8 afn[2][4];
    ws2_load_w(breg, Wall + (size_t)U.e * 512 * 2048 + U.nu * 128, 0);
    ws2_load_a(afn, hid, U, 0, wave, fr, fq);
    for (;;) {
        int Ln = L + G; const bool has_next = ws2_find(Ln, G, cnt, tab, Un);
        const int mtiles = (U.count + 15) >> 4;
        const float* W = Wall + (size_t)U.e * 512 * 2048 + U.nu * 128;
        f32x4 acc[2][8];
#pragma unroll
        for (int t = 0; t < 2; ++t)
#pragma unroll
            for (int n = 0; n < 8; ++n) acc[t][n] = (f32x4){0.f, 0.f, 0.f, 0.f};
#pragma unroll 1
        for (int q = 0; q < 4; ++q) {
#pragma unroll
            for (int t2 = 0; t2 < 2; ++t2)
#pragma unroll
                for (int j = 0; j < 4; ++j) {
                    u32x2 v; v[0] = cvt_pk_bf16(breg[t2][0][j], breg[t2][1][j]); v[1] = cvt_pk_bf16(breg[t2][2][j], breg[t2][3][j]);
                    *(LAS u32x2*)(wbase + j * WS2_PITCH + (2 * q + t2) * 128) = v;
                }
            bf16x8 afc[2][4];
#pragma unroll
            for (int t = 0; t < 2; ++t)
#pragma unroll
                for (int kk = 0; kk < 4; ++kk) afc[t][kk] = afn[t][kk];
            __syncthreads();
            if (q < 3) { ws2_load_w(breg, W, q + 1); ws2_load_a(afn, hid, U, q + 1, wave, fr, fq); }
            else if (has_next) { ws2_load_w(breg, Wall + (size_t)Un.e * 512 * 2048 + Un.nu * 128, 0); ws2_load_a(afn, hid, Un, 0, wave, fr, fq); }
            const LAS uchar* rq = rbase + q * 256;
#pragma unroll
            for (int kk = 0; kk < 4; ++kk) {
#pragma unroll
                for (int n = 0; n < 8; ++n) {
                    const bf16x8 bf = *(const LAS bf16x8*)(rq + n * (16 * WS2_PITCH) + kk * 64);
                    acc[0][n] = __builtin_amdgcn_mfma_f32_16x16x32_bf16(bf, afc[0][kk], acc[0][n], 0, 0, 0);
                    acc[1][n] = __builtin_amdgcn_mfma_f32_16x16x32_bf16(bf, afc[1][kk], acc[1][n], 0, 0, 0);
                }
                if (kk & 1) __builtin_amdgcn_sched_barrier(0);
            }
        }
#pragma unroll
        for (int t = 0; t < 2; ++t) {
            const int mt = wave + 8 * t;
            if (mt < mtiles) {
                bf16_t* orow = yb + (size_t)(U.r0 + mt * 16 + fr) * 2048 + U.nu * 128 + 4 * fq;
#pragma unroll
                for (int n = 0; n < 8; ++n) { u32x2 o; o[0] = cvt_pk_bf16(acc[t][n][0], acc[t][n][1]); o[1] = cvt_pk_bf16(acc[t][n][2], acc[t][n][3]); *(u32x2*)(orow + n * 16) = o; }
            }
        }
        if (mtiles > 16) {
            for (int mt = wave + 16; mt < mtiles; mt += NWAVES) {
                const bf16_t* arow = hid + (size_t)(U.r0 + mt * 16 + fr) * 512 + 8 * fq;
                f32x4 ax[8];
#pragma unroll
                for (int n = 0; n < 8; ++n) ax[n] = (f32x4){0.f, 0.f, 0.f, 0.f};
#pragma unroll 1
                for (int ks = 0; ks < 16; ++ks) {
                    const bf16x8 af = *(const bf16x8*)(arow + ks * 32);
#pragma unroll
                    for (int n = 0; n < 8; ++n) { const bf16x8 bf = *(const LAS bf16x8*)(rbase + n * (16 * WS2_PITCH) + ks * 64); ax[n] = __builtin_amdgcn_mfma_f32_16x16x32_bf16(bf, af, ax[n], 0, 0, 0); }
                }
                bf16_t* orow = yb + (size_t)(U.r0 + mt * 16 + fr) * 2048 + U.nu * 128 + 4 * fq;
#pragma unroll
                for (int n = 0; n < 8; ++n) { u32x2 o; o[0] = cvt_pk_bf16(ax[n][0], ax[n][1]); o[1] = cvt_pk_bf16(ax[n][2], ax[n][3]); *(u32x2*)(orow + n * 16) = o; }
            }
            __syncthreads();
        }
        if (!has_next) break;
        U = Un; L = Ln;
    }
    __syncthreads();
}

__device__ __forceinline__ void moe_gemm2_wsq(const Params& p, LAS uchar* lds, int layer) {
    uchar* ws = p.ws;
    LAS int* tab = (LAS int*)(lds + WS2_TAB);
    (void)moe_tiles(p, layer, tab, false);
    const int tid = tid_opaque(), lane = tid & 63, wave = tid >> 6, fr = lane & 15, fq = lane >> 4;
    const unsigned* cnt = (const unsigned*)(ws + WS_CTL + CTL_CNT_OFF) + layer * 64;
    const bf16_t* hid = (const bf16_t*)(ws + WS_HID); bf16_t* yb = (bf16_t*)(ws + WS_YB);
    const int kq = tid >> 5, nq = tid & 31, G = gridDim.x;
    LAS uchar* wbase = lds + nq * (4 * WS2_PITCH) + kq * 8;
    const LAS uchar* rbase = lds + fr * WS2_PITCH + fq * 16;
    const float* Wm = p.in[I_MWD] + (size_t)layer * 64 * 512 * 2048 + (size_t)(4 * kq) * 2048 + 4 * nq;
    Ws2Unit U, Un; int L = blockIdx.x;
    if (!ws2_find(L, G, cnt, tab, U)) return;
#define WQ_LOAD(DST, UU, T0) do { const float* w_ = Wm + (size_t)(UU).e * 512 * 2048 + (UU).nu * 128; _Pragma("unroll") for (int t4 = 0; t4 < 4; ++t4) _Pragma("unroll") for (int i = 0; i < 4; ++i) \
        DST[t4][i] = *(const f32x4*)(w_ + (size_t)(((T0) + t4) * 64 + i) * 2048); } while (0)
#define WQ_STORE(SRC, T0) do { _Pragma("unroll") for (int t4 = 0; t4 < 4; ++t4) _Pragma("unroll") for (int j = 0; j < 4; ++j) { \
        u32x2 v; v[0] = cvt_pk_bf16(SRC[t4][0][j], SRC[t4][1][j]); v[1] = cvt_pk_bf16(SRC[t4][2][j], SRC[t4][3][j]); *(LAS u32x2*)(wbase + j * WS2_PITCH + ((T0) + t4) * 128) = v; } } while (0)
#define WQ_LOADA(AF, MT) do { const bf16_t* arow_ = hid + (size_t)(U.r0 + (MT) * 16 + fr) * 512 + 8 * fq; _Pragma("unroll") for (int ks = 0; ks < 16; ++ks) AF[ks] = *(const bf16x8*)(arow_ + ks * 32); } while (0)
#define WQ_TILE(AF, MT) do { f32x4 acc[8]; _Pragma("unroll") for (int n = 0; n < 8; ++n) acc[n] = (f32x4){0.f, 0.f, 0.f, 0.f}; \
        _Pragma("unroll") for (int ks = 0; ks < 16; ++ks) { _Pragma("unroll") for (int n = 0; n < 8; ++n) { \
            const bf16x8 bf = *(const LAS bf16x8*)(rbase + n * (16 * WS2_PITCH) + ks * 64); acc[n] = __builtin_amdgcn_mfma_f32_16x16x32_bf16(bf, AF[ks], acc[n], 0, 0, 0); } \
            if (ks & 1) __builtin_amdgcn_sched_barrier(0); } \
        bf16_t* orow = yb + (size_t)(U.r0 + (MT) * 16 + fr) * 2048 + U.nu * 128 + 4 * fq; \
        _Pragma("unroll") for (int n = 0; n < 8; ++n) { u32x2 o; o[0] = cvt_pk_bf16(acc[n][0], acc[n][1]); o[1] = cvt_pk_bf16(acc[n][2], acc[n][3]); *(u32x2*)(orow + n * 16) = o; } } while (0)
    f32x4 pf[4][4];
    WQ_LOAD(pf, U, 0);
    for (;;) {
        { f32x4 b2[4][4]; WQ_LOAD(b2, U, 4); WQ_STORE(pf, 0); WQ_STORE(b2, 4); }
        __syncthreads();
        int Ln = L + G; const bool has_next = ws2_find(Ln, G, cnt, tab, Un);
        const int mtiles = (U.count + 15) >> 4;
        int mt = wave;
        if (mt < mtiles) {
            bf16x8 af[16];
            WQ_LOADA(af, mt);
            if (has_next) WQ_LOAD(pf, Un, 0);
            WQ_TILE(af, mt);
            mt += NWAVES;
        } else if (has_next) WQ_LOAD(pf, Un, 0);
        for (; mt < mtiles; mt += NWAVES) { bf16x8 af[16]; WQ_LOADA(af, mt); WQ_TILE(af, mt); }
        __syncthreads();
        if (!has_next) break;
        U = Un; L = Ln;
    }
#undef WQ_LOAD
#undef WQ_STORE
#undef WQ_LOADA
#undef WQ_TILE
}

__device__ __forceinline__ void moe_gemm2(const Params& p, LAS uchar* lds, int layer, const XcdBarrier& gbar, bool do_gbar) {
#if defined(PROBE_G2SHADOW)
    moe_gemm2v<PROBE_G2SHADOW>(p, lds, layer, (bf16_t*)(p.ws + WS_XG));
    moe_gemm2v<64>(p, lds, layer, (bf16_t*)(p.ws + WS_YB));
#elif defined(MG2_WS) && MG2_WS

#if MG2_WS == 2
    if (do_gbar) xcd_barrier(gbar);
    moe_gemm2_wsp(p, lds, layer);
#elif MG2_WS == 3
    moe_gemm2_wsq(p, lds, layer);
#else
    moe_gemm2_wsv<0>(p, lds, layer, (bf16_t*)(p.ws + WS_YB), gbar, do_gbar);
#endif
#else
    moe_gemm2v<MG2_BK>(p, lds, layer, (bf16_t*)(p.ws + WS_YB));
#endif
}
constexpr int N_PHASES = 25;
#ifndef MK_N_LAUNCHES
#define MK_N_LAUNCHES 1
#endif
#ifndef EN_MIX0
#define EN_MIX0 1
#endif
#ifndef EN_MIX1
#define EN_MIX1 1
#endif
#ifndef EN_MOE
#define EN_MOE 1
#endif
constexpr int LDS_TAB = 131072;
constexpr int LDS_XB = LDS_BYTES - 16;
typedef const __attribute__((address_space(4))) Params* KParamsPtr;
__device__ __forceinline__ KParamsPtr kparams() { KParamsPtr kp = (KParamsPtr)__builtin_amdgcn_kernarg_segment_ptr(); asm volatile("" : "+s"(kp)); return kp; }
__device__ __forceinline__ void load_params(Params& p, KParamsPtr k) {
#pragma unroll
    for (int i = 0; i < 33; ++i) p.in[i] = (const float*)(const __attribute__((address_space(1))) float*)k->in[i];
    p.out = (float*)(__attribute__((address_space(1))) float*)k->out; p.ws = (uchar*)(__attribute__((address_space(1))) uchar*)k->ws; p.ph_lo = k->ph_lo; p.ph_hi = k->ph_hi;
}
#define PHASE_FN static __device__ __forceinline__ void
#define KPARAMS Params p; load_params(p, kparams()); uchar* ws = p.ws; (void)ws
constexpr size_t TS2048 = (size_t)256 * 2048 * 2, TS512 = (size_t)256 * 512 * 2, TS2048Q = (size_t)256 * 2048;

PHASE_FN ph_prologue(LAS uchar* lds) { KPARAMS; phase_prologue(p, lds); }
PHASE_FN ph_copy(int which) {
    KPARAMS; bf16_t* dst = (bf16_t*)(ws + (which == 2 ? WS_XB : WS_XA)); const size_t n = (size_t)T * D;
    for (size_t i = (size_t)blockIdx.x * NTHREADS + tid_opaque(); i < n; i += (size_t)gridDim.x * NTHREADS)
        dst[i] = which == 0 ? f2bf(p.in[I_X][i]) : ((const bf16_t*)(ws + (which == 1 ? WS_XB : WS_XA)))[i];
}
PHASE_FN ph_norm_plain(int which) {
    KPARAMS; float* mod = (float*)(ws + WS_MOD); bf16_t* hmix = (bf16_t*)(ws + WS_HMIX);
    if (which == 0) phase_norm<false, false, true>(p.in[I_X], p.in[I_NMG], mod, mod + 2048, nullptr, nullptr, nullptr, nullptr, nullptr, nullptr, nullptr, ws + WS_HMIX, (float*)(ws + WS_SC_TOK));
    else if (which == 3) phase_norm<false, false, true, true>((const void*)(ws + WS_XA), p.in[I_NMG] + 2048, mod + 12288, mod + 12288 + 2048, nullptr, nullptr, nullptr, nullptr, nullptr, nullptr, nullptr, ws + WS_HMIX, (float*)(ws + WS_SC_TOK));
    else { const int layer = which - 1; phase_norm<false, false, false, true>((const void*)(ws + WS_XA), p.in[I_NFG] + layer * 2048, mod + layer * 12288 + 3 * 2048, mod + layer * 12288 + 4 * 2048, hmix, nullptr, nullptr, nullptr, nullptr, nullptr, nullptr); }
}
PHASE_FN ph_norm_combine() {
    KPARAMS; float* mod = (float*)(ws + WS_MOD);
    phase_norm<true, false, true, true>((const void*)(ws + WS_XA), p.in[I_NMG] + 2048, mod + 12288, mod + 12288 + 2048, nullptr, nullptr, (const bf16_t*)(ws + WS_YB), (const int*)(ws + WS_TOKROW), (const float*)(ws + WS_TOKW), mod + 5 * 2048, (bf16_t*)(ws + WS_XB), ws + WS_HMIX, (float*)(ws + WS_SC_TOK));
}
PHASE_FN ph_final(int with_moe) {
    KPARAMS; float* mod = (float*)(ws + WS_MOD);
    if (with_moe) phase_norm<true, true, false, true>((const void*)(ws + WS_XA), p.in[I_FG], nullptr, nullptr, nullptr, p.out, (const bf16_t*)(ws + WS_YB), (const int*)(ws + WS_TOKROW), (const float*)(ws + WS_TOKW), mod + 12288 + 5 * 2048, nullptr);
    else phase_norm<false, true, false, true>((const void*)(ws + WS_XA), p.in[I_FG], nullptr, nullptr, nullptr, p.out, nullptr, nullptr, nullptr, nullptr, nullptr);
}
PHASE_FN ph_win0(LAS uchar* lds) {
    KPARAMS; const char* hmix = (const char*)(ws + WS_HMIX);
    SchedDense2 S; S.A1 = hmix; S.B1 = (const char*)(ws + WS_WIN0T); S.nM1 = 32; S.nN1 = 16; S.A2 = nullptr; S.B2 = nullptr; S.nM2 = 0; S.nN2 = 0; S.G = gridDim.x; S.c = blockIdx.x; S.tstep = TS2048Q;
    EpiWin0 E{(bf16_t*)(ws + U_Q), (bf16_t*)(ws + U_KB), (bf16_t*)(ws + U_VT), (bf16_t*)(ws + U_Y), (float*)(ws + U_XBR), (float*)(ws + U_GATE), (const float*)(ws + WS_SC_TOK), (const float*)(ws + WS_SC_W0), (const float*)(ws + WS_SC_WV)};
    pg8::gemm_phase<EpiWin0, SchedDense2>(lds, 1024, S, E, nullptr);
}
PHASE_FN ph_l0_local(LAS uchar* lds) {
    KPARAMS;
    {
        const char* hmix = (const char*)(ws + WS_HMIX);
        SchedDense2 S; S.A1 = hmix; S.B1 = (const char*)(ws + WS_WIN0T) + (size_t)16 * TS2048Q; S.nM1 = 32; S.nN1 = 1; S.aux1 = 2; S.A2 = (const char*)(ws + WS_WV0T); S.B2 = hmix; S.nM2 = 2; S.nN2 = 32; S.aux2 = 1;
        S.G = gridDim.x; S.c = blockIdx.x; S.tstep = TS2048Q;
        EpiWin0 E{(bf16_t*)(ws + U_Q), (bf16_t*)(ws + U_KB), (bf16_t*)(ws + U_VT), (bf16_t*)(ws + U_Y), (float*)(ws + U_XBR), (float*)(ws + U_GATE), (const float*)(ws + WS_SC_TOK), (const float*)(ws + WS_SC_W0), (const float*)(ws + WS_SC_WV)};
        pg8::gemm_phase<EpiWin0, SchedDense2>(lds, 1024, S, E, nullptr);
    }
    const int G = gridDim.x, vb = (int)blockIdx.x >= 96 ? (int)blockIdx.x - 96 : (int)blockIdx.x + (G - 96);
    for (int u = (G > 96 ? vb : (int)blockIdx.x); u < 64; u += G) compress_unit(p, lds, u);
    unsigned* qctr = (unsigned*)(ws + WS_CTL + CTL_LRUQ_OFF);
    LAS int* qs = (LAS int*)(lds + LDS_BYTES - 64);
    const int tid = tid_opaque();
    if (tid == 0) { qs[0] = (int)atomicAdd(qctr, 1u); qs[1] = (int)atomicAdd(qctr, 1u); }
    __syncthreads();
    int u = qs[0], unext = qs[1];
    float xpre[19];
    if (u < 1024) lru_xload(xpre, ws, u, tid);
    while (u < 1024) {
        int tk = 0;
        if (tid == 0) tk = (int)atomicAdd(qctr, 1u);
        lru_local_unit(p, lds, u, unext < 1024 ? unext : -1, xpre);
        if (tid == 0) qs[0] = tk;
        __syncthreads();
        u = unext; unext = qs[0];
        __syncthreads();
    }
}
PHASE_FN ph_attn(LAS uchar* lds) {
    KPARAMS; for (int u = blockIdx.x; u < 256; u += gridDim.x) { attn_unit(p, lds, u & 1, 255 - (u >> 1)); attn_unit(p, lds, u & 1, u >> 1); } }
PHASE_FN ph_lru_fix() { KPARAMS; for (int u = blockIdx.x; u < 256; u += gridDim.x) lru_fix_unit(p, u); }
PHASE_FN ph_wout(LAS uchar* lds, int layer) {
    KPARAMS; float* mod = (float*)(ws + WS_MOD) + layer * 12288;
    SchedDense2 S; S.A1 = (const char*)(ws + (layer ? V_HGO : U_CAT)); S.B1 = (const char*)(ws + (layer ? WS_WOUT1T : WS_WOUT0T)); S.nM1 = 32; S.nN1 = 8; S.A2 = nullptr; S.B2 = nullptr; S.nM2 = 0; S.nN2 = 0; S.G = gridDim.x; S.c = blockIdx.x; S.tstep = TS2048;
    if (layer) { EpiResid<true> E{(const void*)(ws + WS_XB), mod + 2 * 2048, (bf16_t*)(ws + WS_XA)}; pg8::gemm_phase<EpiResid<true>, SchedDense2>(lds, 2048, S, E, nullptr); }
    else { EpiResid<false> E{(const void*)p.in[I_X], mod + 2 * 2048, (bf16_t*)(ws + WS_XA)}; pg8::gemm_phase<EpiResid<false>, SchedDense2>(lds, 2048, S, E, nullptr); }
}
PHASE_FN ph_win1(LAS uchar* lds) {
    KPARAMS;
    SchedDense2 S; S.A1 = (const char*)(ws + WS_HMIX); S.B1 = (const char*)(ws + WS_WIN1T); S.nM1 = 32; S.nN1 = 32; S.A2 = nullptr; S.B2 = nullptr; S.nM2 = 0; S.nN2 = 0; S.G = gridDim.x; S.c = blockIdx.x; S.tstep = TS2048Q; S.mix32 = true;
    EpiWin1 E{ws, p.in[I_LBL]};
    pg8::gemm_phase<EpiWin1, SchedDense2>(lds, 1024, S, E, nullptr);
}
PHASE_FN ph_hgrn_local(LAS uchar* lds) { KPARAMS; hgrn_local_phase(p, lds); }
PHASE_FN ph_hgrn_scan() { KPARAMS; hgrn_scan(p); }
PHASE_FN ph_hgrn_out(LAS uchar* lds) { KPARAMS; (void)lds; hgrn_out_phase(p); }
PHASE_FN ph_logit(LAS uchar* lds, int layer) {
    KPARAMS;
    SchedSplitK S; S.A = (const char*)(ws + WS_HMIX); S.B = (const char*)(ws + WS_ROUTET) + (size_t)layer * 256 * 2048 * 2; S.G = gridDim.x; S.c = blockIdx.x; S.tstep = TS2048;
    EpiLogit E{(float*)(ws + WS_LOGIT)};
    pg8::gemm_phase<EpiLogit, SchedSplitK>(lds, 2048, S, E, nullptr, 256);
}
PHASE_FN ph_route(int layer) { KPARAMS; moe_route(p, layer); }
PHASE_FN ph_ffn_route(LAS uchar* lds, int layer) { KPARAMS; moe_norm_route(p, lds, layer); }
PHASE_FN ph_gather(LAS uchar* lds, int layer) { KPARAMS; moe_gather(p, lds + LDS_TAB, layer); }
PHASE_FN ph_moe1(LAS uchar* lds, int layer) { KPARAMS; moe_gemm1(p, lds, layer); }
PHASE_FN ph_moe2(LAS uchar* lds, int layer, const XcdBarrier& gbar, int k) { KPARAMS; moe_gemm2(p, lds, layer, gbar, p.ph_lo <= k - 1 && k < p.ph_hi); }

__global__ void __launch_bounds__(NTHREADS, 2) fwd_kernel(Params p) {
    extern __shared__ __attribute__((aligned(16))) uchar smem[];
    LAS uchar* lds = (LAS uchar*)smem;
    if (threadIdx.x == 0) *(LAS u32x4*)(lds + LDS_XB) = (u32x4){0u, 0u, 0u, 0u};
    __syncthreads();
    XcdBarrier bar; bar.bar = (unsigned*)(p.ws + WS_CTL); bar.x = 0; bar.st = (volatile LAS unsigned*)(lds + LDS_XB);
    const int lo = p.ph_lo, hi = p.ph_hi;
    if (hi - lo > 1) bar = xcd_barrier_post((unsigned*)(p.ws + WS_CTL), (volatile LAS unsigned*)(lds + LDS_XB));
#define PH(k) if (kparams()->ph_lo <= (k) && (k) < kparams()->ph_hi)
#define SEAM(k) do { KParamsPtr kq_ = kparams(); if (kq_->ph_lo <= (k) && (k) + 1 < kq_->ph_hi) xcd_barrier(bar); } while (0)
#ifdef PROBE_BAR
    for (int q = 0; q < 10; ++q) xcd_barrier(bar);
#endif
    PH(0) { ph_prologue(lds);
#ifdef PROBE_PRO2
        ph_prologue(lds);
#endif
    } SEAM(0);
    PH(1) { ph_norm_plain(0);
#ifdef PROBE_NORM
        ph_norm_plain(0);
#endif
    } SEAM(1);
#if EN_MIX0
    PH(2) { ph_win0(lds);
#ifdef PROBE_DENSE
        ph_win0(lds);
#endif
    } SEAM(2);
    PH(3) { ph_l0_local(lds);
#ifdef PROBE_L0LOC
        ph_l0_local(lds);
#endif
    } SEAM(3);
    PH(4) { ph_attn(lds);
#ifdef PROBE_ATTN2
        ph_attn(lds);
#endif
        ph_lru_fix();
#ifdef PROBE_L0LOC
        ph_lru_fix();
#endif
    } SEAM(4);
    PH(5) { ph_wout(lds, 0);
#ifdef PROBE_DENSE
        ph_wout(lds, 0);
#endif
    } SEAM(5);
#else
    SEAM(2); SEAM(3); SEAM(4); PH(5) ph_copy(0); SEAM(5);
#endif
#if EN_MOE
        PH(6) ph_ffn_route(lds, 0); SEAM(6);
        PH(6 + 4) { ph_moe1(lds, 0);
#ifdef PROBE_MOE1
            ph_moe1(lds, 0);
#endif
        }
        PH(6 + 5) { ph_moe2(lds, 0, bar, 6 + 5); } SEAM(6 + 5);
#else
        SEAM(6); SEAM(6 + 1); SEAM(6 + 2); SEAM(6 + 3); SEAM(6 + 4); SEAM(6 + 5);
#endif
#if EN_MOE
            PH(12) { ph_norm_combine();
#ifdef PROBE_NORM
                ph_norm_combine();
#endif
            } SEAM(12);
#else
            PH(12) { ph_copy(2); ph_norm_plain(3); } SEAM(12);
#endif
#if EN_MIX1
            PH(13) { ph_win1(lds);
#ifdef PROBE_DENSE
                ph_win1(lds);
#endif
            } SEAM(13);
            PH(14) {
#ifdef PROBE_HL
                for (int rep = 0; rep < kparams()->ph_hi - kparams()->ph_lo - 23; ++rep)
#endif
                ph_hgrn_local(lds);
            } SEAM(14);
            PH(15) { ph_hgrn_scan();
#ifdef PROBE_HS
                ph_hgrn_scan();
#endif
            } SEAM(15);
            PH(16) {
#ifdef PROBE_HO
                for (int rep = 0; rep < kparams()->ph_hi - kparams()->ph_lo - 23; ++rep)
#endif
                ph_hgrn_out(lds);
            } SEAM(16);
            PH(17) { ph_wout(lds, 1);
#ifdef PROBE_DENSE
                ph_wout(lds, 1);
#endif
            } SEAM(17);
#else
            SEAM(13); SEAM(14); SEAM(15); SEAM(16); PH(17) ph_copy(1); SEAM(17);
#endif
#if EN_MOE
        PH(18) ph_ffn_route(lds, 1); SEAM(18);
        PH(18 + 4) { ph_moe1(lds, 1);
#ifdef PROBE_MOE1
            ph_moe1(lds, 1);
#endif
        }
        PH(18 + 5) { ph_moe2(lds, 1, bar, 18 + 5); } SEAM(18 + 5);
#else
        SEAM(18); SEAM(18 + 1); SEAM(18 + 2); SEAM(18 + 3); SEAM(18 + 4); SEAM(18 + 5);
#endif
    PH(24) { ph_final(EN_MOE);
#ifdef PROBE_NORM
        ph_final(EN_MOE);
#endif
    }
}

extern "C" void kernel_launch(void* const* d_in, const int* in_sizes, int n_in, void* d_out, int out_size, void* d_ws, size_t ws_size, hipStream_t stream) {
    static int grid = 0;
    if (grid == 0) {
        if (n_in != 33 || out_size != T * D || ws_size < WS_END) { fprintf(stderr, "kernel_launch: unexpected problem (n_in %d, out %d, ws %zu < %zu)\n", n_in, out_size, ws_size, (size_t)WS_END); grid = -1; return; }
        int dev = 0, cus = 0, per_cu = 0;
        if (hipGetDevice(&dev) != hipSuccess || hipDeviceGetAttribute(&cus, hipDeviceAttributeMultiprocessorCount, dev) != hipSuccess) { grid = -1; return; }
        if (hipFuncSetAttribute((const void*)fwd_kernel, hipFuncAttributeMaxDynamicSharedMemorySize, LDS_BYTES) != hipSuccess) { fprintf(stderr, "kernel_launch: hipFuncSetAttribute failed\n"); grid = -1; return; }
        if (hipOccupancyMaxActiveBlocksPerMultiprocessor(&per_cu, (const void*)fwd_kernel, NTHREADS, LDS_BYTES) != hipSuccess || per_cu < 1) { fprintf(stderr, "kernel_launch: occupancy query says %d blocks per CU\n", per_cu); grid = -1; (void)hipGetLastError(); return; }
        grid = cus;
    }
    if (grid < 0) return;
    (void)hipMemsetAsync((char*)d_ws + WS_CTL, 0, CTL_BYTES, stream);
    Params p{};
    for (int i = 0; i < 33; ++i) p.in[i] = (const float*)d_in[i];
    p.out = (float*)d_out; p.ws = (uchar*)d_ws;
#if MK_N_LAUNCHES == 1
    p.ph_lo = 0; p.ph_hi = N_PHASES;
    hipLaunchKernelGGL(fwd_kernel, dim3(grid), dim3(NTHREADS), LDS_BYTES, stream, p);
#else
    for (int k = 0; k < N_PHASES; ++k) { p.ph_lo = k; p.ph_hi = k + 1; hipLaunchKernelGGL(fwd_kernel, dim3(grid), dim3(NTHREADS), LDS_BYTES, stream, p); }
#endif
}
```
